# Optimizing an MI355X kernel written in HIP

```python
import jax, jax.numpy as jnp
from jax import lax
import numpy as np

D_MODEL = 1024
BATCH = 2
SEQ = 8192
DEPTH = 4
DEC_BATCH = 128
DEC_SEQ = 8
PAST_LEN = 2048
PAGE_SIZE = 128

N_A_LAYERS = DEPTH // 2
N_B_LAYERS = DEPTH - N_A_LAYERS
CONV_W = 3
D_FF = 4 * D_MODEL
N_HEADS = 16
N_KV = 4
HEAD_DIM = D_MODEL // N_HEADS
GROUP = N_HEADS // N_KV
N_BRANCH = 3
L_CMP = 32
L_SEL = 64
N_SEL = 8
WINDOW = 512
Q_BLOCK = 128
EPS = 1e-6
NEG = -1e30
FORCE = 1e4

kernel_name = 'yoco_shortconv_nsa_step'


def rmsnorm(x, g):
    xf = x.astype(jnp.float32)
    y = xf * lax.rsqrt(jnp.mean(xf * xf, axis=-1, keepdims=True) + EPS)
    return (y * g.astype(jnp.float32)).astype(x.dtype)


def masked_softmax(s, mask):
    p = jax.nn.softmax(jnp.where(mask, s.astype(jnp.float32), NEG), axis=-1)
    return jnp.where(mask, p, 0.0)


def sq_relu_mlp(h, w_up, w_down):
    return jnp.square(jax.nn.relu(h @ w_up)) @ w_down


def short_conv_mixer(h, prev, w_in, conv_w, w_out):
    bg, cg, xin = jnp.split(h @ w_in, 3, axis=-1)
    u = cg * xin
    T = u.shape[1]
    u_ext = jnp.concatenate([prev.astype(u.dtype), u], axis=1)
    z = conv_w[0] * u_ext[:, 0:T] + conv_w[1] * u_ext[:, 1:T + 1] + conv_w[2] * u_ext[:, 2:T + 2]
    return (bg * z) @ w_out, u_ext[:, -(CONV_W - 1):]


def shared_kv_rows(h, kv_norm, w_kv, ks_norm, kw_norm):
    B, T, _ = h.shape
    kv = (rmsnorm(h, kv_norm) @ w_kv).reshape(B, T, N_BRANCH, 2, N_KV, HEAD_DIM)
    cmp_rows = kv[:, :, 0]
    slc_rows = jnp.stack([rmsnorm(kv[:, :, 1, 0], ks_norm), kv[:, :, 1, 1]], axis=2)
    win_rows = jnp.stack([rmsnorm(kv[:, :, 2, 0], kw_norm), kv[:, :, 2, 1]], axis=2)
    return cmp_rows, slc_rows, win_rows


def compress(cmp_rows, kc_norm):
    B, T = cmp_rows.shape[:2]
    nbc = T // L_CMP
    blocks = cmp_rows[:, :nbc * L_CMP].reshape((B, nbc, L_CMP) + cmp_rows.shape[2:])
    blocks = blocks.astype(jnp.float32).mean(axis=2).astype(cmp_rows.dtype)
    return rmsnorm(blocks[:, :, 0], kc_norm), blocks[:, :, 1]


def nsa_attend(q, gates, kc, vc, slc_rows, win_rows, q_start, win_start):
    B, Tq = q.shape[:2]
    T = slc_rows.shape[1]
    nbc = kc.shape[1]
    nbs = -(-T // L_SEL)
    k_sel = min(N_SEL, nbs)
    n_key = k_sel * L_SEL
    qb = Q_BLOCK if Tq % Q_BLOCK == 0 else Tq
    n_chunks = Tq // qb
    scale = HEAD_DIM ** -0.5
    ks = slc_rows[:, :, 0].transpose(0, 2, 1, 3)
    vs = slc_rows[:, :, 1].transpose(0, 2, 1, 3)
    pad = jnp.zeros((B, WINDOW) + win_rows.shape[2:], win_rows.dtype)
    win_pad = jnp.concatenate([pad, win_rows], axis=1)
    cmp_end = (jnp.arange(nbc) + 1) * L_CMP - 1
    blk = jnp.arange(nbs)
    q6 = q.reshape(B, n_chunks, qb, N_KV, GROUP, HEAD_DIM).transpose(1, 0, 2, 3, 4, 5)
    g6 = gates.reshape(B, n_chunks, qb, N_KV, GROUP, N_BRANCH).transpose(1, 0, 2, 3, 4, 5)

    def chunk(args):
        qc, gc, c0 = args
        t = q_start + c0 + jnp.arange(qb)
        s_c = jnp.einsum('bqgrd,bngd->bqgrn', qc, kc) * scale
        m_c = (cmp_end[None, :] <= t[:, None])[None, :, None, None, :]
        p_c = masked_softmax(s_c, m_c)
        o_c = jnp.einsum('bqgrn,bngd->bqgrd', p_c.astype(vc.dtype), vc)
        imp = p_c.sum(axis=3)
        imp = jnp.pad(imp, ((0, 0), (0, 0), (0, 0), (0, 2 * nbs - nbc)))
        imp = imp.reshape(B, qb, N_KV, nbs, 2).sum(-1)
        cur = (t // L_SEL)[:, None]
        forced = (blk[None] == 0) | (blk[None] == cur) | (blk[None] == cur - 1)
        imp = jnp.where(forced[None, :, None, :], FORCE, imp)
        imp = jnp.where((blk[None] > cur)[None, :, None, :], NEG, imp)
        top_v, top_i = lax.top_k(imp, k_sel)
        pos5 = top_i[..., None] * L_SEL + jnp.arange(L_SEL)
        valid = (top_v > 0.5 * NEG)[..., None] & (pos5 <= t[None, :, None, None, None])
        m_s = valid.reshape(B, qb, N_KV, n_key)
        idx = jnp.minimum(pos5.reshape(B, qb, N_KV, n_key), T - 1)
        idx = idx.transpose(0, 2, 1, 3).reshape(B, N_KV, qb * n_key, 1)
        kg = jnp.take_along_axis(ks, idx, axis=2).reshape(B, N_KV, qb, n_key, HEAD_DIM)
        vg = jnp.take_along_axis(vs, idx, axis=2).reshape(B, N_KV, qb, n_key, HEAD_DIM)
        s_s = jnp.einsum('bqgrd,bgqkd->bqgrk', qc, kg) * scale
        p_s = masked_softmax(s_s, m_s[:, :, :, None, :])
        o_s = jnp.einsum('bqgrk,bgqkd->bqgrd', p_s.astype(vg.dtype), vg)
        start = q_start - win_start + c0
        wr = lax.dynamic_slice_in_dim(win_pad, start, qb + WINDOW, axis=1)
        wpos = q_start + c0 - WINDOW + jnp.arange(qb + WINDOW)
        dist = t[:, None] - wpos[None, :]
        m_w = ((wpos >= win_start)[None, :] & (dist >= 0) & (dist <= WINDOW))[None, :, None, None, :]
        s_w = jnp.einsum('bqgrd,bkgd->bqgrk', qc, wr[:, :, 0]) * scale
        p_w = masked_softmax(s_w, m_w)
        o_w = jnp.einsum('bqgrk,bkgd->bqgrd', p_w.astype(wr.dtype), wr[:, :, 1])
        return gc[..., 0:1] * o_c + gc[..., 1:2] * o_s + gc[..., 2:3] * o_w

    out = lax.map(chunk, (q6, g6, jnp.arange(n_chunks, dtype=jnp.int32) * qb))
    return out.transpose(1, 0, 2, 3, 4, 5).reshape(B, Tq, N_HEADS * HEAD_DIM)


def nsa_mixer(h, w_qg, q_norm, w_o, kc, vc, slc_rows, win_rows, q_start, win_start):
    B, T, _ = h.shape
    qg = h @ w_qg
    q = rmsnorm(qg[..., :N_HEADS * HEAD_DIM].reshape(B, T, N_HEADS, HEAD_DIM), q_norm)
    gates = jax.nn.sigmoid(qg[..., N_HEADS * HEAD_DIM:].reshape(B, T, N_HEADS, N_BRANCH))
    o = nsa_attend(q, gates, kc, vc, slc_rows, win_rows, q_start, win_start)
    return o @ w_o


def trunk(x, conv_prev, past_cmp, past_slc, past_win, win_keep,
          norm1, a_w_in, a_conv_w, a_w_out, kv_norm, w_kv, kc_norm, ks_norm, kw_norm,
          b_w_qg, b_q_norm, b_w_o, norm2, w_up, w_down):
    P = past_cmp.shape[1]
    win_start = P - past_win.shape[1]
    conv_new = []
    for l in range(DEPTH):
        h = rmsnorm(x, norm1[l])
        if l < N_A_LAYERS:
            y, st = short_conv_mixer(h, conv_prev[l], a_w_in[l], a_conv_w[l], a_w_out[l])
            conv_new.append(st)
        else:
            j = l - N_A_LAYERS
            y = nsa_mixer(h, b_w_qg[j], b_q_norm[j], b_w_o[j], kc, vc, slc_all, win_all, P, win_start)
        x = x + y
        x = x + sq_relu_mlp(rmsnorm(x, norm2[l]), w_up[l], w_down[l])
        if l == N_A_LAYERS - 1:
            cmp_new, slc_new, win_new = shared_kv_rows(x, kv_norm, w_kv, ks_norm, kw_norm)
            kc, vc = compress(jnp.concatenate([past_cmp, cmp_new], axis=1), kc_norm)
            slc_all = jnp.concatenate([past_slc, slc_new], axis=1)
            win_all = jnp.concatenate([past_win, win_new], axis=1)
    return x, cmp_new, slc_new, win_all[:, -win_keep:], jnp.stack(conv_new)


def setup_inputs(seed: int = 0) -> dict:
    key = jax.random.key(seed)
    ks = jax.random.split(key, 24)
    n_pages = PAST_LEN // PAGE_SIZE
    n_used = DEC_BATCH * n_pages
    n_pool = n_used + n_used // 4
    w_buf = min(WINDOW, PAST_LEN)
    row = (2, N_KV, HEAD_DIM)

    def w(k, shape, fan_in):
        return jax.random.normal(k, shape, jnp.float32) * fan_in ** -0.5

    def gain(k, shape):
        return 1.0 + 0.02 * jax.random.normal(k, shape, jnp.float32)

    page_table = jax.random.permutation(ks[0], n_pool)[:n_used].reshape(DEC_BATCH, n_pages).astype(jnp.int32)
    return {
        'x_prompt': jax.random.normal(ks[1], (BATCH, SEQ, D_MODEL), jnp.float32),
        'x_sample': jax.random.normal(ks[2], (DEC_BATCH, DEC_SEQ, D_MODEL), jnp.float32),
        'cache_cmp_kv': jax.random.normal(ks[3], (n_pool, PAGE_SIZE) + row, jnp.float32),
        'cache_slc_kv': jax.random.normal(ks[4], (n_pool, PAGE_SIZE) + row, jnp.float32),
        'cache_win_kv': jax.random.normal(ks[5], (DEC_BATCH, w_buf) + row, jnp.float32),
        'state_conv': jax.random.normal(ks[6], (N_A_LAYERS, DEC_BATCH, CONV_W - 1, D_MODEL), jnp.float32),
        'page_table': page_table,
        'norm1': gain(ks[7], (DEPTH, D_MODEL)),
        'a_w_in': w(ks[8], (N_A_LAYERS, D_MODEL, 3 * D_MODEL), D_MODEL),
        'a_conv_w': w(ks[9], (N_A_LAYERS, CONV_W, D_MODEL), CONV_W),
        'a_w_out': w(ks[10], (N_A_LAYERS, D_MODEL, D_MODEL), D_MODEL),
        'kv_norm': gain(ks[11], (D_MODEL,)),
        'w_kv': w(ks[12], (D_MODEL, N_BRANCH * 2 * N_KV * HEAD_DIM), D_MODEL),
        'kc_norm': gain(ks[13], (HEAD_DIM,)),
        'ks_norm': gain(ks[14], (HEAD_DIM,)),
        'kw_norm': gain(ks[15], (HEAD_DIM,)),
        'b_w_qg': w(ks[16], (N_B_LAYERS, D_MODEL, N_HEADS * HEAD_DIM + N_HEADS * N_BRANCH), D_MODEL),
        'b_q_norm': gain(ks[17], (N_B_LAYERS, HEAD_DIM)),
        'b_w_o': w(ks[18], (N_B_LAYERS, N_HEADS * HEAD_DIM, D_MODEL), N_HEADS * HEAD_DIM),
        'norm2': gain(ks[19], (DEPTH, D_MODEL)),
        'w_up': w(ks[20], (DEPTH, D_MODEL, D_FF), D_MODEL),
        'w_down': w(ks[21], (DEPTH, D_FF, D_MODEL), D_FF),
    }


def reference(x_prompt, x_sample, cache_cmp_kv, cache_slc_kv, cache_win_kv, state_conv, page_table,
              norm1, a_w_in, a_conv_w, a_w_out, kv_norm, w_kv, kc_norm, ks_norm, kw_norm,
              b_w_qg, b_q_norm, b_w_o, norm2, w_up, w_down):
    weights = (norm1, a_w_in, a_conv_w, a_w_out, kv_norm, w_kv, kc_norm, ks_norm, kw_norm,
               b_w_qg, b_q_norm, b_w_o, norm2, w_up, w_down)
    n_seq, n_pages = page_table.shape
    past_len = n_pages * PAGE_SIZE

    def gather_pages(pool):
        return pool[page_table].reshape((n_seq, past_len) + pool.shape[2:])

    b_p, t_p = x_prompt.shape[:2]
    empty = jnp.zeros((b_p, 0, 2, N_KV, HEAD_DIM), x_prompt.dtype)
    conv0 = jnp.zeros((N_A_LAYERS, b_p, CONV_W - 1, D_MODEL), x_prompt.dtype)
    y_prompt, p_cmp, p_slc, p_win, p_conv = trunk(
        x_prompt, conv0, empty, empty, empty, min(WINDOW, t_p), *weights)
    y_sample, s_cmp, s_slc, s_win, s_conv = trunk(
        x_sample, state_conv, gather_pages(cache_cmp_kv), gather_pages(cache_slc_kv),
        cache_win_kv, cache_win_kv.shape[1], *weights)
    return (y_prompt, y_sample, p_cmp, p_slc, p_win, p_conv, s_cmp, s_slc, s_win, s_conv)
```

```cpp
#include <hip/hip_runtime.h>
#include <cstdio>
#include <cstdint>
#include <cmath>
namespace pg8 {
#define PG8_LAS __attribute__((address_space(3)))
typedef unsigned short bf16_t;
typedef short bf16x8 __attribute__((ext_vector_type(8)));
typedef float f32x4 __attribute__((ext_vector_type(4)));
typedef unsigned u32x4 __attribute__((ext_vector_type(4)));
constexpr int BM = 256, BK = 64, HALF = 128, HTB = HALF * BK * 2  , STAGE_BYTES = 8 * HTB, NXCD = 8, WGM = 8;

__host__ __device__ __forceinline__ int lds_byte(int r, int c) { const int st = (r >> 4) * 2 + (c >> 5), rr = r & 15, cc = c & 31, ob = rr * 64 + cc * 2; return st * 1024 + (ob ^ (((ob >> 9) & 1) << 5)); }
__host__ __device__ __forceinline__ void stage_rc(int b, int& R, int& C) { const int st = b / 1024, sb = b % 1024, swz = sb ^ (((sb >> 9) & 1) << 5); R = (st >> 1) * 16 + swz / 64; C = (st & 1) * 32 + (swz % 64) / 2; }
__host__ __device__ __forceinline__ int perm32(int rho) { const int n = rho >> 4, i = rho & 15; return 8 * (i >> 2) + 4 * n + (i & 3); }

struct Unit { int pm, pn, kt0, nkt, kind, slab, ri; };
struct Gemm { const bf16_t* A; const bf16_t* Bt; int M, N, K, lda, ldb; };

struct StaticOrder {
    int nM, nN, nwg, G, c, nK;
    __host__ __device__ void init(int M, int N, int G_, int c_, int K = 1024) { nM = M / BM; nN = N / BM; nwg = nM * nN; G = G_; c = c_; nK = K / BK; }
    template <class A> __device__ __forceinline__ void slab_store(const A&, const Unit&, int, int) const {}
    __device__ __forceinline__ void acc_init(f32x4 (&acc)[2][2][4][2], const Unit&, int, int) const {
#pragma unroll
        for (int a = 0; a < 2; ++a)
#pragma unroll
            for (int b = 0; b < 2; ++b)
#pragma unroll
                for (int m = 0; m < 4; ++m)
#pragma unroll
                    for (int n = 0; n < 2; ++n) acc[a][b][m][n] = (f32x4){0.f, 0.f, 0.f, 0.f}; }

    __host__ __device__ bool next(int i, Unit& u) const {
        const long L = (long)i * G + c; if (L >= nwg) return false;
        int wgid = (int)L; { const int q = nwg / NXCD, r = nwg % NXCD, xcd = wgid % NXCD, off = wgid / NXCD; wgid = (xcd < r ? xcd * (q + 1) : r * (q + 1) + (xcd - r) * q) + off; }
        const int nig = WGM * nN, gid = wgid / nig, fm = gid * WGM, gsz = (nM - fm) < WGM ? (nM - fm) : WGM;
        u.pm = fm + ((wgid % nig) % gsz); u.pn = (wgid % nig) / gsz; u.kt0 = 0; u.nkt = nK; u.kind = 0; u.slab = 0; u.ri = i; return true;
    }
    __device__ __forceinline__ void a_ready(const Unit&) const {}
    __device__ __forceinline__ void done(const Unit&) const {}
};

__device__ __forceinline__ unsigned cvt_pk_bf16(float lo, float hi) { unsigned r; asm volatile("v_cvt_pk_bf16_f32 %0, %1, %2" : "=v"(r) : "v"(lo), "v"(hi)); return r; }
typedef float f32x2 __attribute__((ext_vector_type(2)));
constexpr int MPROMPT = 16384, XBLD = 1024;
#define PG8_GAS __attribute__((address_space(1)))
__device__ __forceinline__ float pg8_sum4rows(float x) {
    auto a = __builtin_amdgcn_permlane16_swap(__float_as_uint(x), __float_as_uint(x), false, false); x = __uint_as_float(a[0]) + __uint_as_float(a[1]);
    auto b = __builtin_amdgcn_permlane32_swap(__float_as_uint(x), __float_as_uint(x), false, false); return __uint_as_float(b[0]) + __uint_as_float(b[1]);
}
template <int NR>
__device__ __forceinline__ void rstd_rows(const float* ssq, int row0, int q4, float (&rs)[NR]) {
    const PG8_GAS f32x4* base = (const PG8_GAS f32x4*)ssq + 2 * q4;
    f32x4 t[NR][2];
#pragma unroll
    for (int i = 0; i < NR; ++i) { const PG8_GAS f32x4* p = base + (size_t)(row0 + 16 * i) * 8; t[i][0] = p[0]; t[i][1] = p[1]; }
#pragma unroll
    for (int i = 0; i < NR; ++i) { const f32x4 u = t[i][0] + t[i][1]; const float s = pg8_sum4rows((u[0] + u[1]) + (u[2] + u[3])); rs[i] = 1.0f / sqrtf(s * (1.0f / 1024.0f) + 1e-6f); }
}
template <class Sched>
__device__ __forceinline__ void prep_rstd(PG8_LAS float* rl, const float* ssq, const Sched& S, int wave_id) {
    int lane; asm volatile("v_mbcnt_lo_u32_b32 %0, -1, 0\n\tv_mbcnt_hi_u32_b32 %0, -1, %0" : "=v"(lane));
    const int t = wave_id * 64 + lane; Unit u;
#pragma unroll 1
    for (int i = 0; S.next(i, u); ++i) {
        if (t < 256) { const PG8_GAS f32x4* p = (const PG8_GAS f32x4*)ssq + (size_t)(u.pm * BM + t) * 8;
            f32x4 a = (p[0] + p[1]) + (p[2] + p[3]); a += (p[4] + p[5]) + (p[6] + p[7]);
            rl[i * 256 + t] = 1.0f / sqrtf(((a[0] + a[1]) + (a[2] + a[3])) * (1.0f / 1024.0f) + 1e-6f); }
    }
    __syncthreads();
}
template <class Sched> struct PreRstd { PG8_LAS float* rl; const float* ssq; const Sched* S; int wave_id;
    __device__ __forceinline__ void operator()() const { prep_rstd(rl, ssq, *S, wave_id); } };
template <int ACT> struct EpiScaleBf16 {
    static constexpr bool PERM = true, AFTER_DRAIN = false;
    bf16_t* O; int ldc; const PG8_LAS float* rl;
    __device__ __forceinline__ void operator()(const f32x4 (&acc)[2][2][4][2], const Unit& u, int wr, int wc, int fr, int fq) const {
        const int row0 = u.pm * BM + wr * 64 + fr, col0 = u.pn * BM + wc * 32 + 8 * fq;
        const PG8_LAS float* rp = rl + u.ri * 256 + wr * 64 + fr;
#pragma unroll
        for (int ai = 0; ai < 2; ++ai)
#pragma unroll
            for (int m = 0; m < 4; ++m) { const int row = row0 + ai * HALF + m * 16; const float r = rp[ai * HALF + m * 16]; PG8_GAS bf16_t* rowp = (PG8_GAS bf16_t*)O + (size_t)row * ldc + col0;
#pragma unroll
                for (int bj = 0; bj < 2; ++bj) { f32x4 v0 = acc[ai][bj][m][0] * r, v1 = acc[ai][bj][m][1] * r;
                    if (ACT == 1) {
#pragma unroll
                        for (int e = 0; e < 4; ++e) { const float a0 = fmaxf(v0[e], 0.f), a1 = fmaxf(v1[e], 0.f); v0[e] = a0 * a0; v1[e] = a1 * a1; } }
                    u32x4 w; w.x = cvt_pk_bf16(v0[0], v0[1]); w.y = cvt_pk_bf16(v0[2], v0[3]); w.z = cvt_pk_bf16(v1[0], v1[1]); w.w = cvt_pk_bf16(v1[2], v1[3]);
                    *(PG8_GAS u32x4*)(rowp + bj * HALF) = w; } }
    }
};
struct EpiScaleF32 {
    static constexpr bool PERM = false, AFTER_DRAIN = false;
    float* O; int ldc; const PG8_LAS float* rl;
    __device__ __forceinline__ void operator()(const f32x4 (&acc)[2][2][4][2], const Unit& u, int wr, int wc, int fr, int fq) const {
        const int row0 = u.pm * BM + wr * 64 + fr, col0 = u.pn * BM + wc * 32 + 4 * fq;
        const PG8_LAS float* rp = rl + u.ri * 256 + wr * 64 + fr;
#pragma unroll
        for (int ai = 0; ai < 2; ++ai)
#pragma unroll
            for (int m = 0; m < 4; ++m) { const int row = row0 + ai * HALF + m * 16; const float r = rp[ai * HALF + m * 16]; PG8_GAS float* rowp = (PG8_GAS float*)O + (size_t)row * ldc + col0;
#pragma unroll
                for (int bj = 0; bj < 2; ++bj)
#pragma unroll
                    for (int n = 0; n < 2; ++n) *(PG8_GAS f32x4*)(rowp + bj * HALF + n * 16) = acc[ai][bj][m][n] * r; }
    }
};
struct EpiRes {
    static constexpr bool PERM = false, AFTER_DRAIN = false;
    const float* base32_p; const float* base32_s; bf16_t* xb; float* out32; float* ssq_out;
    __device__ __forceinline__ void operator()(const f32x4 (&acc)[2][2][4][2], const Unit& u, int wr, int wc, int fr, int fq) const {
        typedef unsigned u32x2v __attribute__((ext_vector_type(2)));
        const int row0 = u.pm * BM + wr * 64 + fr, col0 = u.pn * BM + wc * 32 + 4 * fq;
#pragma unroll
        for (int ai = 0; ai < 2; ++ai)
            {
                f32x4 rv[4][2][2];
#pragma unroll
                for (int q = 0; q < 4; ++q) { const int row = row0 + ai * HALF + q * 16;
                    if (base32_p) { const PG8_GAS float* b = (const PG8_GAS float*)(row < MPROMPT ? base32_p + (size_t)row * 1024 : base32_s + (size_t)(row - MPROMPT) * 1024) + col0;
#pragma unroll
                        for (int bj = 0; bj < 2; ++bj)
#pragma unroll
                            for (int n = 0; n < 2; ++n) rv[q][bj][n] = *(const PG8_GAS f32x4*)(b + bj * HALF + n * 16);
                    } else { const PG8_GAS bf16_t* b = (const PG8_GAS bf16_t*)xb + (size_t)row * XBLD + col0;
#pragma unroll
                        for (int bj = 0; bj < 2; ++bj)
#pragma unroll
                            for (int n = 0; n < 2; ++n) { const u32x2v w = *(const PG8_GAS u32x2v*)(b + bj * HALF + n * 16);
                                rv[q][bj][n] = (f32x4){__uint_as_float(w.x << 16), __uint_as_float(w.x & 0xffff0000u), __uint_as_float(w.y << 16), __uint_as_float(w.y & 0xffff0000u)}; } } }
#pragma unroll
                for (int q = 0; q < 4; ++q) { const int m = q, row = row0 + ai * HALF + m * 16;
                    PG8_GAS bf16_t* xo = (PG8_GAS bf16_t*)xb + (size_t)row * XBLD + col0;
#pragma unroll
                    for (int bj = 0; bj < 2; ++bj) { float ss = 0.f;
#pragma unroll
                        for (int n = 0; n < 2; ++n) { const f32x4 x = rv[q][bj][n] + acc[ai][bj][m][n];
                            if (out32) *(PG8_GAS f32x4*)((PG8_GAS float*)out32 + (size_t)row * 1024 + col0 + bj * HALF + n * 16) = x;
                            else { ss += (x[0] * x[0] + x[1] * x[1]) + (x[2] * x[2] + x[3] * x[3]);
                                u32x2v w; w.x = cvt_pk_bf16(x[0], x[1]); w.y = cvt_pk_bf16(x[2], x[3]); *(PG8_GAS u32x2v*)(xo + bj * HALF + n * 16) = w; } }
                        if (!out32) { ss = pg8_sum4rows(ss);
                            if (fq == 0) ((PG8_GAS float*)ssq_out)[(size_t)row * 32 + u.pn * 8 + bj * 4 + wc] = ss; } } }
                asm volatile("" ::: "memory"); }
    }
};
struct StreamOrder {
    int nM, nN, nwg, np, lo, hi, u0, G, v, nstat, base;
    float* slab; unsigned* flags; unsigned* tmo; unsigned epoch;
    __device__ __forceinline__ int bound(int c) const { long b = (long)c * ((long)(nwg - base) * np) / G; const int r = (int)(b % np); if (r == 1) b -= 1; else if (r == np - 1) b += 1; return (int)b; }
    __device__ __forceinline__ void init(int M, int N, int K, int G_, int v_, float* slab_, unsigned* flags_, unsigned* tmo_, unsigned epoch_) {
        nM = M / BM; nN = N / BM; nwg = nM * nN; np = K / (2 * BK); G = G_; v = v_; nstat = nwg / G - 1; if (nstat < 0) nstat = 0; base = nstat * G;
        lo = bound(v); hi = bound(v + 1); u0 = lo / np; slab = slab_; flags = flags_; tmo = tmo_; epoch = epoch_; }
    __device__ __forceinline__ void unit_of(int L, Unit& u) const {
        const int nig = WGM * nN, gid = L / nig, fm = gid * WGM, gsz = (nM - fm) < WGM ? (nM - fm) : WGM;
        const int rem = L - gid * nig, gsh = gsz == WGM ? 3 : (gsz == 4 ? 2 : (gsz == 2 ? 1 : 0));
        u.pm = fm + (rem & (gsz - 1)); u.pn = rem >> gsh; }
    __device__ __forceinline__ bool next(int i, Unit& u) const {
        if (i < nstat) { unit_of(i * G + v, u); u.kt0 = 0; u.nkt = 2 * np; u.kind = 0; u.slab = 0; u.ri = i; return true; }
        const int Lr = u0 + (i - nstat), s0 = Lr * np, L = base + Lr; if (L >= nwg) return false;
        const int p0 = (lo > s0 ? lo : s0) - s0, p1 = (hi < s0 + np ? hi : s0 + np) - s0; if (p1 <= p0) return false;
        unit_of(L, u); u.kt0 = 2 * p0; u.nkt = 2 * (p1 - p0);
        u.kind = p0 > 0 ? 1 : (p1 < np ? 2 : 0); u.slab = p0 > 0 ? v : v + 1; u.ri = i; return true;
    }
    __device__ __forceinline__ void a_ready(const Unit&) const {}
    __device__ __forceinline__ void done(const Unit&) const {}
    __device__ __forceinline__ void slab_store(const f32x4 (&acc)[2][2][4][2], const Unit& u, int wid, int lane) const {
        const __amdgpu_buffer_rsrc_t rs = __builtin_amdgcn_make_buffer_rsrc(slab, 0, G * 8 * 32 * 1024, 0x00020000);
        const unsigned so = (unsigned)((u.slab * 8 + wid) * 32) * 1024u, vo = (unsigned)lane * 16u;
#pragma unroll
        for (int a = 0; a < 2; ++a)
#pragma unroll
            for (int b = 0; b < 2; ++b)
#pragma unroll
                for (int m = 0; m < 4; ++m)
#pragma unroll
                    for (int n = 0; n < 2; ++n) __builtin_amdgcn_raw_buffer_store_b128(__builtin_bit_cast(u32x4, acc[a][b][m][n]), rs, vo + (unsigned)(((a * 2 + b) * 4 + m) * 2 + n) * 1024u, so,   16);
        asm volatile("s_waitcnt vmcnt(0)" ::: "memory");
        if (lane == 0) __hip_atomic_store(flags + 64 * u.slab + wid, epoch, __ATOMIC_RELAXED, __HIP_MEMORY_SCOPE_AGENT);
    }
    __device__ __forceinline__ void acc_init(f32x4 (&acc)[2][2][4][2], const Unit& u, int wid, int lane) const {
#pragma unroll
        for (int a = 0; a < 2; ++a)
#pragma unroll
            for (int b = 0; b < 2; ++b)
#pragma unroll
                for (int m = 0; m < 4; ++m)
#pragma unroll
                    for (int n = 0; n < 2; ++n) acc[a][b][m][n] = (f32x4){0.f, 0.f, 0.f, 0.f};
        if (u.kind != 2) return;
        unsigned* fw = flags + 64 * u.slab + wid; unsigned sp = 0;
        while ((unsigned)__builtin_amdgcn_readfirstlane(__hip_atomic_load(fw, __ATOMIC_RELAXED, __HIP_MEMORY_SCOPE_AGENT)) < epoch) {
            __builtin_amdgcn_s_sleep(2);
            if ((++sp & 255u) == 0u) { if (__hip_atomic_load(tmo, __ATOMIC_RELAXED, __HIP_MEMORY_SCOPE_AGENT) != 0u) break; if (sp > (1u << 20)) { if (lane == 0) __hip_atomic_store(tmo, 1u, __ATOMIC_RELAXED, __HIP_MEMORY_SCOPE_AGENT); break; } }
        }
        __builtin_amdgcn_fence(__ATOMIC_ACQUIRE, "agent");
        asm volatile("s_waitcnt vmcnt(0)" ::: "memory");
        const __amdgpu_buffer_rsrc_t rs = __builtin_amdgcn_make_buffer_rsrc(slab, 0, G * 8 * 32 * 1024, 0x00020000);
        const unsigned so = (unsigned)((u.slab * 8 + wid) * 32) * 1024u, vo = (unsigned)lane * 16u;
#pragma unroll
        for (int a = 0; a < 2; ++a)
#pragma unroll
            for (int b = 0; b < 2; ++b)
#pragma unroll
                for (int m = 0; m < 4; ++m)
#pragma unroll
                    for (int n = 0; n < 2; ++n) acc[a][b][m][n] = __builtin_bit_cast(f32x4, __builtin_amdgcn_raw_buffer_load_b128(rs, vo, so + (unsigned)(((a * 2 + b) * 4 + m) * 2 + n) * 1024u, 0));
    }
};
struct SEpiScaleBf16 { bf16_t* O; int ldc; const float* ssq; int act;
    __device__ __forceinline__ void operator()(const f32x4 (&acc)[2][2], int row0, int col0, int lane) const {
        typedef unsigned u32x2v __attribute__((ext_vector_type(2)));
        float rs[2]; rstd_rows<2>(ssq, row0 + (lane & 15), lane >> 4, rs);
#pragma unroll
        for (int mi = 0; mi < 2; ++mi) { const int row = row0 + 16 * mi + (lane & 15);
#pragma unroll
            for (int ni = 0; ni < 2; ++ni) { f32x4 v = acc[mi][ni] * rs[mi];
                if (act) {
#pragma unroll
                    for (int e = 0; e < 4; ++e) { const float a = fmaxf(v[e], 0.f); v[e] = a * a; } }
                u32x2v w; w.x = cvt_pk_bf16(v[0], v[1]); w.y = cvt_pk_bf16(v[2], v[3]); *(PG8_GAS u32x2v*)((PG8_GAS bf16_t*)O + (size_t)row * ldc + col0 + 16 * ni + 4 * (lane >> 4)) = w; } }
    }
};
struct SEpiScaleF32 { float* O; int ldc; const float* ssq;
    __device__ __forceinline__ void operator()(const f32x4 (&acc)[2][2], int row0, int col0, int lane) const {
        float rs[2]; rstd_rows<2>(ssq, row0 + (lane & 15), lane >> 4, rs);
#pragma unroll
        for (int mi = 0; mi < 2; ++mi) { const int row = row0 + 16 * mi + (lane & 15);
#pragma unroll
            for (int ni = 0; ni < 2; ++ni) *(PG8_GAS f32x4*)((PG8_GAS float*)O + (size_t)row * ldc + col0 + 16 * ni + 4 * (lane >> 4)) = acc[mi][ni] * rs[mi]; }
    }
};
struct SEpiRes { const float* base32; bf16_t* xb; float* out32; float* ssq_out;
    __device__ __forceinline__ void operator()(const f32x4 (&acc)[2][2], int row0, int col0, int lane) const {
        typedef unsigned u32x2v __attribute__((ext_vector_type(2)));
        f32x4 rv[2][2];
#pragma unroll
        for (int mi = 0; mi < 2; ++mi)
#pragma unroll
            for (int ni = 0; ni < 2; ++ni) { const int row = row0 + 16 * mi + (lane & 15), col = col0 + 16 * ni + 4 * (lane >> 4);
                if (base32) rv[mi][ni] = *(const PG8_GAS f32x4*)((const PG8_GAS float*)base32 + (size_t)row * 1024 + col);
                else { const u32x2v w = *(const PG8_GAS u32x2v*)((const PG8_GAS bf16_t*)xb + (size_t)row * XBLD + col);
                    rv[mi][ni] = (f32x4){__uint_as_float(w.x << 16), __uint_as_float(w.x & 0xffff0000u), __uint_as_float(w.y << 16), __uint_as_float(w.y & 0xffff0000u)}; } }
#pragma unroll
        for (int mi = 0; mi < 2; ++mi) { const int row = row0 + 16 * mi + (lane & 15); float ss = 0.f;
#pragma unroll
            for (int ni = 0; ni < 2; ++ni) { const int col = col0 + 16 * ni + 4 * (lane >> 4);
                const f32x4 x = rv[mi][ni] + acc[mi][ni];
                if (out32) *(PG8_GAS f32x4*)((PG8_GAS float*)out32 + (size_t)row * 1024 + col) = x;
                else { ss += (x[0] * x[0] + x[1] * x[1]) + (x[2] * x[2] + x[3] * x[3]);
                    u32x2v w; w.x = cvt_pk_bf16(x[0], x[1]); w.y = cvt_pk_bf16(x[2], x[3]); *(PG8_GAS u32x2v*)((PG8_GAS bf16_t*)xb + (size_t)row * XBLD + col) = w; } }
            if (!out32) { ss = pg8_sum4rows(ss);
                if ((lane >> 4) == 0) ((PG8_GAS float*)ssq_out)[(size_t)row * 32 + (col0 >> 5)] = ss; } }
    }
};
template <class Epi>
__device__ __forceinline__ void sgemm_phase(PG8_LAS unsigned char* lds, const bf16_t* A, int lda, const bf16_t* Bt, int ldb, int K, int N, int row_base, int nrows, const Epi& E, int wave_id, int vcu, int G) {
    int lane; asm volatile("v_mbcnt_lo_u32_b32 %0, -1, 0\n\tv_mbcnt_hi_u32_b32 %0, -1, %0" : "=v"(lane));
    const int tid = wave_id * 64 + lane;
    const int wr = wave_id & 1, wc = (wave_id >> 1) & 1, wk = wave_id >> 2, m16 = lane & 15, kq = lane >> 4;
    const int tm = nrows / 64, ntile = tm * (N / 64), nch = K / 128;
    constexpr int PITCH = 272, MATB = 64 * PITCH, BUFB = 2 * MATB;
    PG8_LAS f32x4* red = (PG8_LAS f32x4*)(lds + 2 * BUFB) + (wave_id & 3) * 256 + lane;
    const int lr = tid >> 4, lc = tid & 15;
    const unsigned wofs = (unsigned)(lr * PITCH + lc * 16);
    const unsigned aofs = (unsigned)((32 * wr + m16) * PITCH + wk * 128 + kq * 16), bofs = (unsigned)(MATB + (32 * wc + m16) * PITCH + wk * 128 + kq * 16);
#pragma unroll 1
    for (int t = vcu; t < ntile; t += G) {
        const int rm = t % tm, cn = t / tm, trow = row_base + rm * 64, tcol = cn * 64;
        const PG8_GAS bf16_t* ag = (const PG8_GAS bf16_t*)A + (size_t)(trow + lr) * lda + lc * 8;
        const PG8_GAS bf16_t* bg = (const PG8_GAS bf16_t*)Bt + (size_t)(tcol + lr) * ldb + lc * 8;
        const size_t r32a = (size_t)32 * lda, r32b = (size_t)32 * ldb;
        f32x4 acc[2][2];
#pragma unroll
        for (int mi = 0; mi < 2; ++mi)
#pragma unroll
            for (int ni = 0; ni < 2; ++ni) acc[mi][ni] = (f32x4){0.f, 0.f, 0.f, 0.f};
        u32x4 ring[4][4];
#define SG_ISSUE(slot, c) do { ring[slot][0] = *(const PG8_GAS u32x4*)(ag + (c) * 128); ring[slot][1] = *(const PG8_GAS u32x4*)(ag + r32a + (c) * 128); \
                               ring[slot][2] = *(const PG8_GAS u32x4*)(bg + (c) * 128); ring[slot][3] = *(const PG8_GAS u32x4*)(bg + r32b + (c) * 128); } while (0)
        SG_ISSUE(0, 0); SG_ISSUE(1, 1); SG_ISSUE(2, 2);
#pragma unroll 1
        for (int c0 = 0; c0 < nch; c0 += 4) {
#pragma unroll
            for (int j = 0; j < 4; ++j) { const int c = c0 + j;
                if (c + 3 < nch) SG_ISSUE((j + 3) & 3, c + 3);
                PG8_LAS unsigned char* buf = lds + (j & 1) * BUFB;
                *(PG8_LAS u32x4*)(buf + wofs) = ring[j][0]; *(PG8_LAS u32x4*)(buf + wofs + 32 * PITCH) = ring[j][1];
                *(PG8_LAS u32x4*)(buf + MATB + wofs) = ring[j][2]; *(PG8_LAS u32x4*)(buf + MATB + wofs + 32 * PITCH) = ring[j][3];
                __syncthreads();
                bf16x8 af[2][2], bf[2][2];
#pragma unroll
                for (int ks = 0; ks < 2; ++ks)
#pragma unroll
                    for (int h = 0; h < 2; ++h) { af[ks][h] = *(const PG8_LAS bf16x8*)(buf + aofs + h * 16 * PITCH + ks * 64); bf[ks][h] = *(const PG8_LAS bf16x8*)(buf + bofs + h * 16 * PITCH + ks * 64); }
#pragma unroll
                for (int ks = 0; ks < 2; ++ks)
#pragma unroll
                    for (int mi = 0; mi < 2; ++mi)
#pragma unroll
                        for (int ni = 0; ni < 2; ++ni) acc[mi][ni] = __builtin_amdgcn_mfma_f32_16x16x32_bf16(bf[ks][ni], af[ks][mi], acc[mi][ni], 0, 0, 0);
            }
        }
#undef SG_ISSUE
        if (wk == 1) {
#pragma unroll
            for (int mi = 0; mi < 2; ++mi)
#pragma unroll
                for (int ni = 0; ni < 2; ++ni) red[(mi * 2 + ni) * 64] = acc[mi][ni]; }
        __syncthreads();
        if (wk == 0) {
#pragma unroll
            for (int mi = 0; mi < 2; ++mi)
#pragma unroll
                for (int ni = 0; ni < 2; ++ni) acc[mi][ni] += red[(mi * 2 + ni) * 64];
            E(acc, trow + 32 * wr, tcol + 32 * wc, lane); }
        __syncthreads();
    }
}
struct NoSide { __device__ __forceinline__ void operator()(int, int, int) const {} };
struct NoPre { __device__ __forceinline__ void operator()() const {} };
template <class Epi, class Sched, bool ALIGN_EPI = false, bool SP2 = false, class Side = NoSide, class Pre = NoPre>
__device__ __forceinline__ void gemm_phase(PG8_LAS unsigned char* lds, const Gemm g, const Sched& S, const Epi& E, int wave_id, const Side& W = Side(), const Pre& P = Pre()) {
    int tid_; asm volatile("v_mbcnt_lo_u32_b32 %0, -1, 0\n\tv_mbcnt_hi_u32_b32 %0, -1, %0" : "=v"(tid_)); tid_ += wave_id * 64;
    const int tid = tid_, wid = __builtin_amdgcn_readfirstlane(tid >> 6), lane = tid & 63, wr = wid >> 2, wc = wid & 3, fr = lane & 15, fq = lane >> 4;
    const int K = g.K; int nt;
    unsigned voffA[2], voffB[2];
#pragma unroll
    for (int i = 0; i < 2; ++i) { int R, C; stage_rc(tid * 16 + i * 8192, R, C); const int Rb = Epi::PERM ? ((R & ~31) + perm32(R & 31)) : R;
        voffA[i] = (unsigned)(R * g.lda + C) * 2u; voffB[i] = (unsigned)(Rb * g.ldb + C) * 2u; }
    const size_t kstep = (size_t)(BK * 2);
    const size_t hstepA = (size_t)HALF * g.lda * 2, hstepB = (size_t)HALF * g.ldb * 2;
    const size_t tstepA = 2 * hstepA, tstepB = 2 * hstepB;
    const unsigned ldsw = (unsigned)wid * 1024u;
    const int aoff = lds_byte(wr * 64 + fr, fq * 8), boff = lds_byte(wc * 32 + fr, fq * 8);
#define PG8_SA(b, h) (((b) * 2 + (h)) * HTB)
#define PG8_SB(b, h) ((4 + (b) * 2 + (h)) * HTB)
#define PG8_STAGE(bufoff, gbase, voff) do { _Pragma("unroll") for (int _i = 0; _i < 2; ++_i) \
        __builtin_amdgcn_global_load_lds((const unsigned*)((const char*)(gbase) + (voff)[_i]), (PG8_LAS unsigned*)(lds + (bufoff) + ldsw + _i * 8192), 16, 0, 0); } while (0)
#define PG8_LDA(dst, b, h) do { _Pragma("unroll") for (int m = 0; m < 4; ++m) _Pragma("unroll") for (int k = 0; k < 2; ++k) dst[m][k] = *(const PG8_LAS bf16x8*)(lds + PG8_SA(b, h) + aoff + m * 2048 + k * 1024); } while (0)
#define PG8_LDB(dst, b, h) do { _Pragma("unroll") for (int n = 0; n < 2; ++n) _Pragma("unroll") for (int k = 0; k < 2; ++k) dst[n][k] = *(const PG8_LAS bf16x8*)(lds + PG8_SB(b, h) + boff + n * 2048 + k * 1024); } while (0)
#define PG8_MMA(ai, bj, At, Bt) do { __builtin_amdgcn_s_setprio(1); _Pragma("unroll") for (int m = 0; m < 4; ++m) _Pragma("unroll") for (int n = 0; n < 2; ++n) _Pragma("unroll") for (int k = 0; k < 2; ++k) \
        acc[ai][bj][m][n] = __builtin_amdgcn_mfma_f32_16x16x32_bf16(Bt[n][k], At[m][k], acc[ai][bj][m][n], 0, 0, 0); __builtin_amdgcn_s_setprio(0); } while (0)
#define PG8_WAIT_V(n) asm volatile("s_waitcnt vmcnt(" #n ")" ::: "memory")
#define PG8_WAIT_L(n) asm volatile("s_waitcnt lgkmcnt(" #n ")" ::: "memory")
#define PG8_BAR __builtin_amdgcn_s_barrier()
#define PG8_SCHED __builtin_amdgcn_sched_barrier(0)
    Unit cur, nxt; int ui = 0;
    if (!S.next(0, cur)) return;
    nt = cur.nkt;
    f32x4 acc[2][2][4][2];
    S.acc_init(acc, cur, wid, lane);
    bf16x8 At[4][2], B0[2][2], B1[2][2];
    const char* cA = (const char*)g.A + (size_t)cur.pm * tstepA + (size_t)cur.kt0 * kstep; const char* cB = (const char*)g.Bt + (size_t)cur.pn * tstepB + (size_t)cur.kt0 * kstep;
    S.a_ready(cur);
    if constexpr (SP2) {
        PG8_STAGE(PG8_SB(0, 0), cB, voffB); PG8_STAGE(PG8_SB(0, 1), cB + hstepB, voffB); PG8_STAGE(PG8_SA(0, 0), cA, voffA); PG8_STAGE(PG8_SA(0, 1), cA + hstepA, voffA);
        P();
        if (wr == 1) PG8_BAR;
        PG8_WAIT_V(2); PG8_BAR;
        PG8_STAGE(PG8_SB(1, 0), cB + kstep, voffB); PG8_STAGE(PG8_SA(1, 0), cA + kstep, voffA); PG8_STAGE(PG8_SB(1, 1), cB + hstepB + kstep, voffB);
        PG8_WAIT_V(6); PG8_BAR;
    } else {
        PG8_STAGE(PG8_SB(0, 0), cB, voffB); PG8_STAGE(PG8_SA(0, 0), cA, voffA); PG8_STAGE(PG8_SB(0, 1), cB + hstepB, voffB); PG8_STAGE(PG8_SA(0, 1), cA + hstepA, voffA);
        P();
        if (wr == 1) PG8_BAR;
        PG8_WAIT_V(4); PG8_BAR;
        PG8_STAGE(PG8_SB(1, 0), cB + kstep, voffB); PG8_STAGE(PG8_SA(1, 0), cA + kstep, voffA); PG8_STAGE(PG8_SB(1, 1), cB + hstepB + kstep, voffB);
        PG8_WAIT_V(6); PG8_BAR;
    }
    for (;;) {
        const bool has_next = S.next(ui + 1, nxt);
        const char* nA = has_next ? (const char*)g.A + (size_t)nxt.pm * tstepA + (size_t)nxt.kt0 * kstep : cA; const char* nB = has_next ? (const char*)g.Bt + (size_t)nxt.pn * tstepB + (size_t)nxt.kt0 * kstep : cB;
        for (int t = 0; t < nt; t += 2) {
            const bool last = (t == nt - 2);
            const char* a1 = cA + (size_t)(t + 1) * kstep;
            const char* a2 = last ? nA : cA + (size_t)(t + 2) * kstep; const char* b2 = last ? nB : cB + (size_t)(t + 2) * kstep;
            const char* a3 = a2 + kstep; const char* b3 = b2 + kstep;
            if (last && has_next) S.a_ready(nxt);
            if constexpr (SP2) {
            PG8_LDB(B0, 0, 0); PG8_LDB(B1, 0, 1); PG8_SCHED; PG8_LDA(At, 0, 0); PG8_STAGE(PG8_SA(1, 1), a1 + hstepA, voffA);
            PG8_WAIT_V(8); PG8_WAIT_L(0); PG8_BAR; PG8_MMA(0, 0, At, B0); PG8_MMA(0, 1, At, B1); PG8_BAR; PG8_SCHED;
            PG8_LDA(At, 0, 1); PG8_STAGE(PG8_SB(0, 0), b2, voffB); PG8_STAGE(PG8_SB(0, 1), b2 + hstepB, voffB); PG8_STAGE(PG8_SA(0, 0), a2, voffA);
            PG8_WAIT_V(8); PG8_WAIT_L(0); PG8_BAR; PG8_MMA(1, 0, At, B0); PG8_MMA(1, 1, At, B1); PG8_BAR; PG8_SCHED;
            PG8_LDB(B0, 1, 0); PG8_LDB(B1, 1, 1); PG8_SCHED; PG8_LDA(At, 1, 0); PG8_STAGE(PG8_SA(0, 1), a2 + hstepA, voffA);
            PG8_WAIT_V(8); PG8_WAIT_L(0); PG8_BAR; PG8_MMA(0, 0, At, B0); PG8_MMA(0, 1, At, B1); PG8_BAR; PG8_SCHED;
            PG8_LDA(At, 1, 1); PG8_STAGE(PG8_SB(1, 0), b3, voffB); PG8_STAGE(PG8_SB(1, 1), b3 + hstepB, voffB); PG8_STAGE(PG8_SA(1, 0), a3, voffA);
            PG8_WAIT_V(8); PG8_WAIT_L(0); PG8_BAR; PG8_MMA(1, 0, At, B0); PG8_MMA(1, 1, At, B1); PG8_BAR; PG8_SCHED;
            } else {
            PG8_LDB(B0, 0, 0); PG8_SCHED; PG8_LDA(At, 0, 0); PG8_STAGE(PG8_SA(1, 1), a1 + hstepA, voffA);
            PG8_WAIT_L(8); PG8_BAR; PG8_WAIT_L(0); PG8_MMA(0, 0, At, B0); PG8_BAR; PG8_SCHED;
            PG8_LDB(B1, 0, 1); PG8_STAGE(PG8_SB(0, 0), b2, voffB);
            PG8_BAR; PG8_WAIT_L(0); PG8_MMA(0, 1, At, B1); PG8_BAR;
            PG8_LDA(At, 0, 1); PG8_STAGE(PG8_SA(0, 0), a2, voffA);
            PG8_BAR; PG8_WAIT_L(0); PG8_MMA(1, 0, At, B0); PG8_BAR; PG8_SCHED;
            PG8_STAGE(PG8_SB(0, 1), b2 + hstepB, voffB);
            PG8_WAIT_V(6); PG8_BAR; PG8_MMA(1, 1, At, B1); PG8_BAR;
            PG8_LDB(B0, 1, 0); PG8_SCHED; PG8_LDA(At, 1, 0); PG8_STAGE(PG8_SA(0, 1), a2 + hstepA, voffA);
            PG8_WAIT_L(8); PG8_BAR; PG8_WAIT_L(0); PG8_MMA(0, 0, At, B0); PG8_BAR; PG8_SCHED;
            PG8_LDB(B1, 1, 1); PG8_STAGE(PG8_SB(1, 0), b3, voffB);
            PG8_BAR; PG8_WAIT_L(0); PG8_MMA(0, 1, At, B1); PG8_BAR;
            PG8_LDA(At, 1, 1); PG8_STAGE(PG8_SA(1, 0), a3, voffA);
            PG8_BAR; PG8_WAIT_L(0); PG8_MMA(1, 0, At, B0); PG8_BAR; PG8_SCHED;
            PG8_STAGE(PG8_SB(1, 1), b3 + hstepB, voffB);
            PG8_WAIT_V(6); PG8_BAR; PG8_MMA(1, 1, At, B1); PG8_BAR;
            }
        }
        if constexpr (ALIGN_EPI) { if (wr == 0) PG8_BAR; }
        if constexpr (!Epi::AFTER_DRAIN) {
            if (cur.kind == 1) S.slab_store(acc, cur, wid, lane);
            else E(acc, cur, wr, wc, fr, fq);
#ifdef PROBE_EPI2
            if constexpr (Epi::PERM || sizeof(Epi) == 16) { asm volatile("" ::: "memory"); E(acc, cur, wr, wc, fr, fq); }
#endif
            S.done(cur); W(ui, wid, lane); }
        if (!has_next) break;
        S.acc_init(acc, nxt, wid, lane);
        cur = nxt; cA = nA; cB = nB; ++ui; nt = cur.nkt;
        if constexpr (ALIGN_EPI) { if (wr == 1) PG8_BAR; }
    }
    PG8_WAIT_V(0);
    if constexpr (!ALIGN_EPI) { if (wr == 0) PG8_BAR; }
    PG8_BAR;
    if constexpr (Epi::AFTER_DRAIN) { E.fused(acc, cur, wr, wc, fr, fq, lds, wid, lane); S.done(cur); }
#undef PG8_SA
#undef PG8_SB
#undef PG8_STAGE
#undef PG8_LDA
#undef PG8_LDB
#undef PG8_MMA
#undef PG8_WAIT_V
#undef PG8_WAIT_L
#undef PG8_BAR
#undef PG8_SCHED
}
}
constexpr int NWAVES = 8;
constexpr int GRID = 256;
constexpr int D = 1024, FF = 4096, MP = 16384, MS = 1024, M = MP + MS;
constexpr int SEQ = 8192, NSEQ_S = 128, PAST = 2048;
constexpr int XBLD = pg8::XBLD, A1LD = 1024, HLD = 4096, KVRLD = 1536, QGLD = 1280, WLD1 = 1024, WLD4 = 4096;
constexpr int BCXLD = 3072;
constexpr int NQG = 1280;
constexpr float EPS = 1e-6f;
constexpr size_t MiB = 1u << 20;
constexpr int FRAGB = 16384;

constexpr size_t WS_CTL = 0, CTL_ZERO_BYTES = 1 * MiB;
constexpr size_t WS_WIN = 2 * MiB;
constexpr size_t WS_WOUT = WS_WIN + 13 * MiB;
constexpr size_t WS_WKV = WS_WOUT + 5 * MiB;
constexpr size_t WS_WQG = WS_WKV + 4 * MiB;
constexpr size_t WS_WO = WS_WQG + 6 * MiB;
constexpr size_t WS_WUP = WS_WO + 5 * MiB;
constexpr size_t WS_WDN = WS_WUP + 35 * MiB;
constexpr size_t WS_XB = WS_WDN + 34 * MiB;
constexpr size_t WS_SSQ = WS_XB + 37 * MiB;
constexpr size_t WS_ACT1 = WS_SSQ + 6 * MiB;
constexpr size_t WS_QG = WS_ACT1 + 37 * MiB;
constexpr size_t WS_BIG = WS_QG + 46 * MiB;
constexpr size_t WS_SLCP = WS_BIG + 140 * MiB;
constexpr size_t WS_WINP = WS_SLCP + 16 * MiB;
constexpr size_t WS_CMPP = WS_WINP + 16 * MiB;
constexpr size_t WS_CMPS = WS_CMPP + 1 * MiB;
constexpr size_t WS_WINS = WS_CMPS + 8 * MiB;
constexpr size_t WS_SLCS = WS_WINS + 72 * MiB;
constexpr size_t WS_SLAB = WS_SLCS + 264 * MiB;
constexpr size_t WS_LIST = WS_SLAB + 128 * MiB;
constexpr size_t WS_PARTO = WS_LIST + 32 * MiB;
constexpr size_t WS_PARTML = WS_PARTO + 192 * MiB;
constexpr size_t WS_END = WS_PARTML + 12 * MiB;
constexpr int CW_BAR = 4096, CW_TMO = 64, CW_SLABF = 8192, CW_CNT = 65536, CW_DQ = 36864, CNT_PAD = 16;

constexpr size_t O_Y = 0, O_PCMP = 17825792, O_PSLC = 26214400, O_PWIN = 34603008, O_PCONV = 35127296, O_SCMP = 35135488, O_SSLC = 35659776, O_SWIN = 36184064, O_SCONV = 69738496, O_END = 70262784;

constexpr int RING_BYTES = 131072;
constexpr int WLDS_BYTES = 18432;
constexpr int LDSCTL_OFF = 147456, MISC_OFF = LDSCTL_OFF + 320;
constexpr int LDS_BYTES = 147456 + 1024;

#define GAS __attribute__((address_space(1)))
#define LAS __attribute__((address_space(3)))
typedef unsigned short bf16;
typedef unsigned v4u __attribute__((ext_vector_type(4)));
typedef unsigned v2u __attribute__((ext_vector_type(2)));
typedef float f32x4 __attribute__((ext_vector_type(4)));
typedef short bf16x8 __attribute__((ext_vector_type(8)));
typedef GAS unsigned gu32;
#define RLX_AGENT __ATOMIC_RELAXED, __HIP_MEMORY_SCOPE_AGENT
#define LDS_WAIT() asm volatile("s_waitcnt lgkmcnt(0)" ::: "memory")
#define VM_WAIT() asm volatile("s_waitcnt vmcnt(0)" ::: "memory")
__device__ __forceinline__ unsigned pk2(float lo, float hi) { return pg8::cvt_pk_bf16(lo, hi); }
__device__ __forceinline__ float bf2f(unsigned short h) { return __uint_as_float((unsigned)h << 16); }
__device__ __forceinline__ float bflo(unsigned w) { return __uint_as_float(w << 16); }
__device__ __forceinline__ float bfhi(unsigned w) { return __uint_as_float(w & 0xffff0000u); }


#define DPP_F(x, ctrl) __int_as_float(__builtin_amdgcn_mov_dpp(__float_as_int(x), (ctrl), 0xF, 0xF, true))
#define DPP_I(x, ctrl) __builtin_amdgcn_mov_dpp((x), (ctrl), 0xF, 0xF, true)
#define DPP_XOR1 0xB1
#define DPP_XOR2 0x4E
#define DPP_HMIRROR 0x141
#define DPP_MIRROR 0x140
__device__ __forceinline__ float sum_x16_x32(float x) {
    auto a = __builtin_amdgcn_permlane16_swap(__float_as_uint(x), __float_as_uint(x), false, false); x = __uint_as_float(a[0]) + __uint_as_float(a[1]);
    auto b = __builtin_amdgcn_permlane32_swap(__float_as_uint(x), __float_as_uint(x), false, false); return __uint_as_float(b[0]) + __uint_as_float(b[1]);
}
__device__ __forceinline__ float max_x16_x32(float x) {
    auto a = __builtin_amdgcn_permlane16_swap(__float_as_uint(x), __float_as_uint(x), false, false); x = fmaxf(__uint_as_float(a[0]), __uint_as_float(a[1]));
    auto b = __builtin_amdgcn_permlane32_swap(__float_as_uint(x), __float_as_uint(x), false, false); return fmaxf(__uint_as_float(b[0]), __uint_as_float(b[1]));
}
__device__ __forceinline__ float sum8(float x) { x += DPP_F(x, DPP_XOR1); x += DPP_F(x, DPP_XOR2); x += DPP_F(x, DPP_HMIRROR); return x; }
__device__ __forceinline__ float sum4(float x) { x += DPP_F(x, DPP_XOR1); x += DPP_F(x, DPP_XOR2); return x; }

#define XB_TMO      128
#define XB_XCNT(j)  (256  + 64 * (j))
#define XB_XSUB(j)  (1280 + 64 * (j))
#define XB_XGEN(j)  (2304 + 64 * (j))
#define XB_TOP      3328
#define XB_TOPGEN   3392
#define XCD_BAR_WORDS 3456
#define XB_SPIN_CAP (1u << 18)

__device__ __forceinline__ unsigned xb_ld(unsigned* p)              { return __hip_atomic_load(p, __ATOMIC_RELAXED, __HIP_MEMORY_SCOPE_AGENT); }
__device__ __forceinline__ unsigned xb_add(unsigned* p, unsigned v) { return __hip_atomic_fetch_add(p, v, __ATOMIC_RELAXED, __HIP_MEMORY_SCOPE_AGENT); }
__device__ __forceinline__ unsigned xb_xcc_id() { return (unsigned)__builtin_amdgcn_s_getreg((3 << 11) | 20) & 0xFu; }
#define XB_SPIN(cond, bar) do { unsigned _sp = 0; while (cond) { __builtin_amdgcn_s_sleep(1); \
    if ((++_sp & 255u) == 0u) { if (xb_ld(&(bar)[XB_TMO])) break; if (_sp > XB_SPIN_CAP) { atomicAdd(&(bar)[XB_TMO], 1u); break; } } } } while (0)

struct XcdBarrier {
    unsigned* bar; unsigned x;
    volatile LAS unsigned* st;
};

__device__ __forceinline__ XcdBarrier xcd_barrier_post(unsigned* bar, volatile LAS unsigned* st) {
    XcdBarrier b; b.bar = bar; b.x = xb_xcc_id(); b.st = st;
    if (threadIdx.x == 0) (void)xb_add(&bar[XB_XCNT(b.x)], 1u);
    return b;
}
__device__ __forceinline__ void xcd_barrier_complete(unsigned* bar, unsigned x, unsigned& nloc, unsigned& nx) {
    const unsigned G = gridDim.x * gridDim.y * gridDim.z;
    unsigned sum, cnt, mine, sp = 0u;
    for (;;) {
        sum = 0u; cnt = 0u; mine = 0u;
#pragma unroll
        for (unsigned j = 0; j < 16; ++j) { const unsigned c = xb_ld(&bar[XB_XCNT(j)]); sum += c; cnt += (c > 0u) ? 1u : 0u; mine = (j == x) ? c : mine; }
        if (sum == G) break;
        __builtin_amdgcn_s_sleep(1);
        if ((++sp & 255u) == 0u) { if (xb_ld(&bar[XB_TMO])) break; if (sp > XB_SPIN_CAP) { atomicAdd(&bar[XB_TMO], 1u); break; } }
    }
    nloc = mine > 0u ? mine : 1u; nx = cnt > 0u ? cnt : 1u;
}

__device__ __forceinline__ void xcd_barrier(const XcdBarrier& b) {
    asm volatile("s_waitcnt vmcnt(0)" ::: "memory");
    __syncthreads();
    if (threadIdx.x == 0) {
        unsigned* bar = b.bar;
        __builtin_amdgcn_s_waitcnt(0);
        unsigned nloc = b.st[0], nx = b.st[1];
        if (nloc == 0u) { xcd_barrier_complete(bar, b.x, nloc, nx); b.st[0] = nloc; b.st[1] = nx; }
        const unsigned old = xb_add(&bar[XB_XSUB(b.x)], 1u);
        const unsigned gen = old / nloc;
        if (old + 1u == (gen + 1u) * nloc) {
            __builtin_amdgcn_fence(__ATOMIC_RELEASE, "agent");
            asm volatile("s_waitcnt vmcnt(0)" ::: "memory");
            const unsigned og = xb_add(&bar[XB_TOP], 1u);
            const unsigned tg = og / nx;
            if (og + 1u == (tg + 1u) * nx) xb_add(&bar[XB_TOPGEN], 1u);
            else XB_SPIN(xb_ld(&bar[XB_TOPGEN]) == tg, bar);
            __builtin_amdgcn_fence(__ATOMIC_ACQUIRE, "agent");
            xb_add(&bar[XB_XGEN(b.x)], 1u);
            asm volatile("s_waitcnt vmcnt(0)" ::: "memory");
        } else {
            XB_SPIN(xb_ld(&bar[XB_XGEN(b.x)]) == gen, bar);
            __builtin_amdgcn_fence(__ATOMIC_ACQUIRE, "agent");
            asm volatile("s_waitcnt vmcnt(0)" ::: "memory");
        }
    }
    __syncthreads();
}

struct Frame {
    LAS unsigned char* lds;
    volatile LAS unsigned* MISC;
    gu32* ctl;
    int wave, vcu; static constexpr int G = GRID;
};

constexpr int ARGS_OFF = LDSCTL_OFF + 512;
__device__ __forceinline__ void* argp(const Frame& F, int i) { unsigned a = (unsigned)(ARGS_OFF + 8 * i); asm volatile("" : "+v"(a));
    const LAS unsigned* p = (const LAS unsigned*)(F.lds + a);
    const unsigned lo = __builtin_amdgcn_readfirstlane(p[0]), hi = __builtin_amdgcn_readfirstlane(p[1]); return (void*)(((unsigned long long)hi << 32) | lo); }
__device__ __forceinline__ int lane_id() { int l; asm volatile("v_mbcnt_lo_u32_b32 %0, -1, 0\n\tv_mbcnt_hi_u32_b32 %0, -1, %0" : "=v"(l)); return l; }
#define AIN(k) ((const float*)argp(F, (k)))
#define AOUT ((float*)argp(F, 23))
#define AWS ((unsigned char*)argp(F, 24))

__device__ __forceinline__ float wave_sum(float v) { v = sum8(v); v += DPP_F(v, DPP_MIRROR); return sum_x16_x32(v); }

__device__ __forceinline__ void p0_transpose_item(const float* W, const float* gain, int K, int N, int Npad, bf16* WT, int ldw, LAS float* scr, int item, int lane) {
    const int nblk = Npad / 64, kb = item / nblk, nb = item % nblk, k0 = 64 * kb, n0 = 64 * nb;
    const int n4 = lane & 15, kr = lane >> 4; const bool nok = n0 + 4 * n4 + 3 < N;
    f32x4 v[16];
#pragma unroll
    for (int i = 0; i < 16; ++i) { v[i] = (f32x4){0.f, 0.f, 0.f, 0.f}; if (nok) v[i] = *(const GAS f32x4*)((const GAS float*)W + (size_t)(k0 + 4 * i + kr) * N + n0 + 4 * n4); }
#pragma unroll
    for (int i = 0; i < 16; ++i) { const int kk = 4 * i + kr; const float gv = gain ? ((const GAS float*)gain)[k0 + kk] : 1.f; LAS float* d = scr + kk * 65 + 4 * n4;
        d[0] = v[i][0] * gv; d[1] = v[i][1] * gv; d[2] = v[i][2] * gv; d[3] = v[i][3] * gv; }
    LDS_WAIT(); asm volatile("" ::: "memory");
    const int c = lane & 7;
#pragma unroll
    for (int j = 0; j < 8; ++j) { const int n = (lane >> 3) + 8 * j; const LAS float* s = scr + (8 * c) * 65 + n;
        v4u o; o.x = pk2(s[0 * 65], s[1 * 65]); o.y = pk2(s[2 * 65], s[3 * 65]); o.z = pk2(s[4 * 65], s[5 * 65]); o.w = pk2(s[6 * 65], s[7 * 65]);
        *(GAS v4u*)(WT + (size_t)(n0 + n) * ldw + k0 + 8 * c) = o; }
    LDS_WAIT(); asm volatile("" ::: "memory");
}
__device__ __forceinline__ void x_rows4_to_bf16(const float* xrow, bf16* orow, int ldo, float* ssqrow, int lane) {
    const GAS f32x4* xr = (const GAS f32x4*)xrow + lane;
    f32x4 v[4][4];
#pragma unroll
    for (int r = 0; r < 4; ++r)
#pragma unroll
        for (int j = 0; j < 4; ++j) v[r][j] = xr[r * 256 + 64 * j];
#pragma unroll
    for (int r = 0; r < 4; ++r) { float s = 0.f;
#pragma unroll
        for (int j = 0; j < 4; ++j) s += (v[r][j].x * v[r][j].x + v[r][j].y * v[r][j].y) + (v[r][j].z * v[r][j].z + v[r][j].w * v[r][j].w);
        s = wave_sum(s);
        GAS unsigned long long* o8 = (GAS unsigned long long*)(orow + (size_t)r * ldo) + lane;
#pragma unroll
        for (int j = 0; j < 4; ++j) o8[64 * j] = (unsigned long long)pk2(v[r][j].x, v[r][j].y) | ((unsigned long long)pk2(v[r][j].z, v[r][j].w) << 32);
        if (lane < 32) ssqrow[r * 32 + lane] = lane == 0 ? s : 0.f; }
}

__device__ __forceinline__ int koff(int key, int c) { return ((((key >> 4) * 2 + (c >> 2)) * 4 + (c & 3)) * 16 + (key & 15)) * 16; }
__device__ __forceinline__ int voff(int d, int s, int kq) { return 8192 + (((s * 4 + (d >> 4)) * 4 + kq) * 16 + (d & 15)) * 16; }

__device__ __forceinline__ void rows32_to_frags(const float* src, size_t stride, int nvalid, const float* gain, unsigned char* frag, size_t gstride, int s, float* out, int out_lo,
                                                LAS unsigned char* tile, int lane) {
    const int kv = lane >> 5, g = (lane >> 3) & 3, c = lane & 7;
    f32x4 ga = {1.f, 1.f, 1.f, 1.f}, gb = {1.f, 1.f, 1.f, 1.f};
    if (gain) { ga = *(const f32x4*)(gain + 8 * c); gb = *(const f32x4*)(gain + 8 * c + 4); }
    LAS bf16* T = (LAS bf16*)tile;
#pragma unroll 1
    for (int r0 = 0; r0 < 32; r0 += 16) {
        f32x4 ra[16], rb[16];
#pragma unroll
        for (int q = 0; q < 16; ++q) { ra[q] = (f32x4){0.f, 0.f, 0.f, 0.f}; rb[q] = (f32x4){0.f, 0.f, 0.f, 0.f};
            if (r0 + q < nvalid) { const GAS f32x4* p = (const GAS f32x4*)(src + (size_t)(r0 + q) * stride + lane * 8); ra[q] = p[0]; rb[q] = p[1]; } }
#pragma unroll
        for (int q = 0; q < 16; ++q) { const int r = r0 + q; f32x4 a = ra[q], b = rb[q];
            float ss = (a[0] * a[0] + a[1] * a[1]) + (a[2] * a[2] + a[3] * a[3]) + (b[0] * b[0] + b[1] * b[1]) + (b[2] * b[2] + b[3] * b[3]);
            ss = sum8(ss);
            if (gain && kv == 0) { const float rs = 1.0f / sqrtf(ss * (1.0f / 64.0f) + EPS); a = a * rs * ga; b = b * rs * gb; }
            if (out && r >= out_lo && r < nvalid) { GAS f32x4* o = (GAS f32x4*)(out + (size_t)r * 512 + lane * 8); o[0] = a; o[1] = b; }
            v4u w; w.x = pk2(a[0], a[1]); w.y = pk2(a[2], a[3]); w.z = pk2(b[0], b[1]); w.w = pk2(b[2], b[3]);
            if (kv == 0) *(GAS v4u*)(frag + (size_t)g * gstride + koff(32 * s + r, c)) = w;
            else *(LAS v4u*)(T + (g * 32 + r) * 72 + 8 * c) = w; }
    }
    LDS_WAIT(); asm volatile("" ::: "memory");
#pragma unroll 2
    for (int it = 0; it < 16; ++it) {
        const int idx = it * 64 + lane, gg = idx >> 8, rem = idx & 255, dg = rem >> 6, kq = (rem >> 4) & 3, d16 = rem & 15, d = dg * 16 + d16;
        const LAS bf16* tp = T + (gg * 32 + 4 * kq) * 72 + d;
        const unsigned e0 = tp[0], e1 = tp[72], e2 = tp[144], e3 = tp[216], e4 = tp[16 * 72], e5 = tp[17 * 72], e6 = tp[18 * 72], e7 = tp[19 * 72];
        v4u w; w.x = e0 | (e1 << 16); w.y = e2 | (e3 << 16); w.z = e4 | (e5 << 16); w.w = e6 | (e7 << 16);
        *(GAS v4u*)(frag + (size_t)gg * gstride + voff(d, s, kq)) = w;
    }
    LDS_WAIT(); asm volatile("" ::: "memory");
}
__device__ __forceinline__ void rows32_compress(const float* src, size_t stride, const float* gain, unsigned char* frag, size_t gstride, int n, float* out, int lane) {
    const int kv = lane >> 5, g = (lane >> 3) & 3, c = lane & 7;
    f32x4 a = {0.f, 0.f, 0.f, 0.f}, b = {0.f, 0.f, 0.f, 0.f};
#pragma unroll 1
    for (int r0 = 0; r0 < 32; r0 += 16) {
        f32x4 rx[16], ry[16];
#pragma unroll
        for (int q = 0; q < 16; ++q) { const GAS f32x4* p = (const GAS f32x4*)(src + (size_t)(r0 + q) * stride + lane * 8); rx[q] = p[0]; ry[q] = p[1]; }
#pragma unroll
        for (int q = 0; q < 16; ++q) { a += rx[q]; b += ry[q]; if (out) { GAS f32x4* o = (GAS f32x4*)(out + (size_t)(r0 + q) * 512 + lane * 8); o[0] = rx[q]; o[1] = ry[q]; } }
    }
    a = a * (1.0f / 32.0f); b = b * (1.0f / 32.0f);
    float ss = (a[0] * a[0] + a[1] * a[1]) + (a[2] * a[2] + a[3] * a[3]) + (b[0] * b[0] + b[1] * b[1]) + (b[2] * b[2] + b[3] * b[3]);
    ss = sum8(ss);
    unsigned char* fb = frag + (size_t)g * gstride;
    if (kv == 0) { const float rs = 1.0f / sqrtf(ss * (1.0f / 64.0f) + EPS); const f32x4 ga = *(const f32x4*)(gain + 8 * c), gb = *(const f32x4*)(gain + 8 * c + 4); a = a * rs * ga; b = b * rs * gb;
        v4u w; w.x = pk2(a[0], a[1]); w.y = pk2(a[2], a[3]); w.z = pk2(b[0], b[1]); w.w = pk2(b[2], b[3]);
        *(GAS v4u*)(fb + koff(n & 63, c)) = w;
    } else {
        const int kk = n & 31, s = (n >> 5) & 1, kq = (kk & 15) >> 2, pos = (kk >> 4) * 4 + (kk & 3);
        const unsigned w0 = pk2(a[0], a[1]), w1 = pk2(a[2], a[3]), w2 = pk2(b[0], b[1]), w3 = pk2(b[2], b[3]);
        GAS bf16* vp = (GAS bf16*)(fb + voff(8 * c, s, kq)) + pos;
        vp[0] = (bf16)(w0 & 0xffff); vp[8] = (bf16)(w0 >> 16); vp[16] = (bf16)(w1 & 0xffff); vp[24] = (bf16)(w1 >> 16);
        vp[32] = (bf16)(w2 & 0xffff); vp[40] = (bf16)(w2 >> 16); vp[48] = (bf16)(w3 & 0xffff); vp[56] = (bf16)(w3 >> 16);
    }
}
struct Args { const float* in[22]; const int* page_table; float* out; unsigned char* ws; int ph_lo, ph_hi; };

#if defined(PROBE_P0)
#define P0REP(k) ((k) == PROBE_P0 ? 2 : 1)
#else
#define P0REP(k) 1
#endif
__device__ __forceinline__ void p0_prologue(Frame& F) {
    unsigned char* ws = AWS; float* aout = AOUT;
    LAS float* scr = (LAS float*)(F.lds + F.wave * WLDS_BYTES);
    LAS unsigned char* tile = F.lds + F.wave * WLDS_BYTES;
    const int lane = lane_id();
    const int gw = F.vcu * NWAVES + F.wave, NGW = F.G * NWAVES;
    const float* norm1 = AIN(7); const float* norm2 = AIN(19);
    constexpr int I_IN = 16 * 48, I_SQ = 16 * 16, I_KV = 16 * 24, I_QG = 16 * 20, I_UP = 16 * 64, I_DN = 64 * 16;
    constexpr int NITEMS = 2 * I_IN + 2 * I_SQ + I_KV + 2 * I_QG + 2 * I_SQ + 4 * I_UP + 4 * I_DN;
    for (int prep_ = 0; prep_ < P0REP(1); ++prep_)
    for (int it = gw; it < NITEMS; it += NGW) {
        int r = it;
        if (r < 2 * I_IN) { const int l = r / I_IN; p0_transpose_item(AIN(8) + (size_t)l * D * 3072, norm1 + l * D, D, 3072, 3072, (bf16*)(ws + WS_WIN) + (size_t)l * 3072 * WLD1, WLD1, scr, r % I_IN, lane); continue; } r -= 2 * I_IN;
        if (r < 2 * I_SQ) { const int l = r / I_SQ; p0_transpose_item(AIN(10) + (size_t)l * D * D, nullptr, D, D, D, (bf16*)(ws + WS_WOUT) + (size_t)l * D * WLD1, WLD1, scr, r % I_SQ, lane); continue; } r -= 2 * I_SQ;
        if (r < I_KV) { p0_transpose_item(AIN(12), AIN(11), D, 1536, 1536, (bf16*)(ws + WS_WKV), WLD1, scr, r, lane); continue; } r -= I_KV;
        if (r < 2 * I_QG) { const int l = r / I_QG; p0_transpose_item(AIN(16) + (size_t)l * D * 1072, norm1 + (2 + l) * D, D, 1072, NQG, (bf16*)(ws + WS_WQG) + (size_t)l * NQG * WLD1, WLD1, scr, r % I_QG, lane); continue; } r -= 2 * I_QG;
        if (r < 2 * I_SQ) { const int l = r / I_SQ; p0_transpose_item(AIN(18) + (size_t)l * D * D, nullptr, D, D, D, (bf16*)(ws + WS_WO) + (size_t)l * D * WLD1, WLD1, scr, r % I_SQ, lane); continue; } r -= 2 * I_SQ;
        if (r < 4 * I_UP) { const int l = r / I_UP; p0_transpose_item(AIN(20) + (size_t)l * D * FF, norm2 + l * D, D, FF, FF, (bf16*)(ws + WS_WUP) + (size_t)l * FF * WLD1, WLD1, scr, r % I_UP, lane); continue; } r -= 4 * I_UP;
        { const int l = r / I_DN; p0_transpose_item(AIN(21) + (size_t)l * FF * D, nullptr, FF, D, D, (bf16*)(ws + WS_WDN) + (size_t)l * D * WLD4, WLD4, scr, r % I_DN, lane); }
    }
    for (int prep_ = 0; prep_ < P0REP(2); ++prep_)
    for (int m = gw * 4; m < M; m += NGW * 4) {
        const float* xr = m < MP ? AIN(0) + (size_t)m * D : AIN(1) + (size_t)(m - MP) * D;
        x_rows4_to_bf16(xr, (bf16*)(ws + WS_XB) + (size_t)m * XBLD, XBLD, (float*)(ws + WS_SSQ) + (size_t)m * 32, lane);
    }
    const int* pt = (const int*)argp(F, 22);
    for (int prep_ = 0; prep_ < P0REP(3); ++prep_)
    for (int it = gw; it < NSEQ_S * 64; it += NGW) { const int seq = it >> 6, n = it & 63; const int page = pt[seq * 16 + (n >> 2)];
        rows32_compress(AIN(2) + ((size_t)page * 128 + (n & 3) * 32) * 512, 512, AIN(13), ws + WS_CMPS + (size_t)seq * 4 * FRAGB, FRAGB, n, nullptr, lane); }
    for (int prep_ = 0; prep_ < P0REP(4); ++prep_)
    for (int it = gw; it < NSEQ_S * 64; it += NGW) { const int seq = it >> 6, blk = (it >> 1) & 31, s = it & 1; const int page = pt[seq * 16 + (blk >> 1)];
        rows32_to_frags(AIN(3) + ((size_t)page * 128 + (blk & 1) * 64 + s * 32) * 512, 512, 32, nullptr, ws + WS_SLCS + ((size_t)seq * 4 * 33 + blk) * FRAGB, (size_t)33 * FRAGB, s, nullptr, 0, tile, lane); }
    for (int prep_ = 0; prep_ < P0REP(5); ++prep_)
    for (int it = gw; it < NSEQ_S * 16; it += NGW) { const int seq = it >> 4, blk = (it >> 1) & 7, s = it & 1, r0 = blk * 64 + s * 32;
        rows32_to_frags(AIN(4) + ((size_t)seq * 512 + r0) * 512, 512, 32, nullptr, ws + WS_WINS + ((size_t)seq * 4 * 9 + blk) * FRAGB, (size_t)9 * FRAGB, s,
                        aout + O_SWIN + ((long)seq * 512 + r0 - 8) * 512, r0 == 0 ? 8 : 0, tile, lane); }
}

__device__ __forceinline__ void conv_phase(Frame& F, int l) {
    unsigned char* aws = AWS; float* aout = AOUT;
    const bf16* BCX = (const bf16*)(aws + WS_BIG); bf16* V = (bf16*)(aws + WS_ACT1);
    const float* cw = AIN(9) + (size_t)l * 3 * D; const float* st = AIN(5);
    const int lane = lane_id();
    const int gw = F.vcu * NWAVES + F.wave, NGW = F.G * NWAVES;
    for (int it = gw; it < (M / 8) * 2; it += NGW) {
        const int rc = it >> 1, ch = (it & 1) * 512 + lane * 8, row0 = rc * 8;
        float u1[8], u2[8], w0[8], w1[8], w2[8];
#pragma unroll
        for (int j = 0; j < 8; ++j) { w0[j] = cw[ch + j]; w1[j] = cw[D + ch + j]; w2[j] = cw[2 * D + ch + j]; u1[j] = 0.f; u2[j] = 0.f; }
        const bool samp = rc >= MP / 8; const int t0 = row0 & (SEQ - 1);
        if (samp) { const int seq = rc - MP / 8; const float* sp = st + ((size_t)(l * NSEQ_S + seq) * 2) * D + ch;
#pragma unroll
            for (int j = 0; j < 8; ++j) { u2[j] = sp[j]; u1[j] = sp[D + j]; }
        } else if (t0 != 0) {
#pragma unroll
            for (int h = 1; h <= 2; ++h) { const GAS bf16* rp = (const GAS bf16*)BCX + (size_t)(row0 - h) * BCXLD + ch; const v4u c4 = *(const GAS v4u*)(rp + 1024), x4 = *(const GAS v4u*)(rp + 2048);
#pragma unroll
                for (int q = 0; q < 4; ++q) { const float a0 = bflo(c4[q]) * bflo(x4[q]), a1 = bfhi(c4[q]) * bfhi(x4[q]); if (h == 1) { u1[2 * q] = a0; u1[2 * q + 1] = a1; } else { u2[2 * q] = a0; u2[2 * q + 1] = a1; } } }
        }
        v4u rb4[8], rc4[8], rx4[8];
#pragma unroll
        for (int r = 0; r < 8; ++r) { const GAS bf16* rp = (const GAS bf16*)BCX + (size_t)(row0 + r) * BCXLD + ch; rb4[r] = *(const GAS v4u*)rp; rc4[r] = *(const GAS v4u*)(rp + 1024); rx4[r] = *(const GAS v4u*)(rp + 2048); }
#pragma unroll
        for (int r = 0; r < 8; ++r) { const v4u b4 = rb4[r], c4 = rc4[r], x4 = rx4[r];
            float u[8], v[8];
#pragma unroll
            for (int q = 0; q < 4; ++q) { u[2 * q] = bflo(c4[q]) * bflo(x4[q]); u[2 * q + 1] = bfhi(c4[q]) * bfhi(x4[q]); }
#pragma unroll
            for (int j = 0; j < 8; ++j) { const float z = w0[j] * u2[j] + w1[j] * u1[j] + w2[j] * u[j]; const float bgv = (j & 1) ? bfhi(b4[j >> 1]) : bflo(b4[j >> 1]); v[j] = bgv * z; }
            v4u o; o.x = pk2(v[0], v[1]); o.y = pk2(v[2], v[3]); o.z = pk2(v[4], v[5]); o.w = pk2(v[6], v[7]);
            *(GAS v4u*)((GAS bf16*)V + (size_t)(row0 + r) * A1LD + ch) = o;
            if (r >= 6) {
                float* op = nullptr;
                if (samp) op = aout + O_SCONV + ((size_t)(l * NSEQ_S + (rc - MP / 8)) * 2 + (r - 6)) * D + ch;
                else if (t0 == SEQ - 8) op = aout + O_PCONV + ((size_t)(l * 2 + row0 / SEQ) * 2 + (r - 6)) * D + ch;
                if (op) { *(GAS f32x4*)op = (f32x4){u[0], u[1], u[2], u[3]}; *(GAS f32x4*)(op + 4) = (f32x4){u[4], u[5], u[6], u[7]}; }
            }
#pragma unroll
            for (int j = 0; j < 8; ++j) { u2[j] = u1[j]; u1[j] = u[j]; }
        }
    }
}

__device__ __forceinline__ void kvfin_phase(Frame& F) {
    unsigned char* ws = AWS; float* aout = AOUT; const float* KVR = (const float*)(ws + WS_BIG);
    LAS unsigned char* tile = F.lds + F.wave * WLDS_BYTES;
    const int lane = lane_id();
    const int gw = F.vcu * NWAVES + F.wave, NGW = F.G * NWAVES;
    constexpr int N_PC = 512, N_SC = 32, N_PS = 512, N_SS = 256, N_PW = 512, N_SW = 256, NIT = N_PC + N_SC + N_PS + N_SS + N_PW + N_SW;
    for (int it = gw; it < NIT; it += NGW) {
        int r = it;
        if (r < N_PC) { const int b = r >> 8, n = r & 255; const size_t row = (size_t)b * SEQ + 32 * n;
            rows32_compress(KVR + row * KVRLD, KVRLD, AIN(13), ws + WS_CMPP + ((size_t)b * 4 * 4 + (n >> 6)) * FRAGB, (size_t)4 * FRAGB, n, aout + O_PCMP + row * 512, lane); continue; } r -= N_PC;
        if (r < N_SC) {
            for (int q = 0; q < 32; ++q) { const size_t row = (size_t)r * 32 + q; const GAS f32x4* p = (const GAS f32x4*)(KVR + (MP + row) * KVRLD + lane * 8); GAS f32x4* o = (GAS f32x4*)(aout + O_SCMP + row * 512 + lane * 8); o[0] = p[0]; o[1] = p[1]; }
            continue; } r -= N_SC;
        if (r < N_PS) { const int b = r >> 8, blk = (r >> 1) & 127, s = r & 1; const size_t row = (size_t)b * SEQ + blk * 64 + s * 32;
            rows32_to_frags(KVR + row * KVRLD + 512, KVRLD, 32, AIN(14), ws + WS_SLCP + ((size_t)b * 4 * 128 + blk) * FRAGB, (size_t)128 * FRAGB, s, aout + O_PSLC + row * 512, 0, tile, lane); continue; } r -= N_PS;
        if (r < N_SS) { const int seq = r >> 1, s = r & 1; const size_t row = (size_t)seq * 8;
            rows32_to_frags(KVR + (MP + row) * KVRLD + 512, KVRLD, s == 0 ? 8 : 0, AIN(14), ws + WS_SLCS + ((size_t)seq * 4 * 33 + 32) * FRAGB, (size_t)33 * FRAGB, s, aout + O_SSLC + row * 512, 0, tile, lane); continue; } r -= N_SS;
        if (r < N_PW) { const int b = r >> 8, blk = (r >> 1) & 127, s = r & 1; const int t = blk * 64 + s * 32; const size_t row = (size_t)b * SEQ + t;
            float* o = t >= SEQ - 512 ? aout + O_PWIN + ((size_t)b * 512 + (t - (SEQ - 512))) * 512 : nullptr;
            rows32_to_frags(KVR + row * KVRLD + 1024, KVRLD, 32, AIN(15), ws + WS_WINP + ((size_t)b * 4 * 128 + blk) * FRAGB, (size_t)128 * FRAGB, s, o, 0, tile, lane); continue; } r -= N_PW;
        { const int seq = r >> 1, s = r & 1; const size_t row = (size_t)seq * 8;
            rows32_to_frags(KVR + (MP + row) * KVRLD + 1024, KVRLD, s == 0 ? 8 : 0, AIN(15), ws + WS_WINS + ((size_t)seq * 4 * 9 + 8) * FRAGB, (size_t)9 * FRAGB, s, aout + O_SWIN + ((size_t)seq * 512 + 504) * 512, 0, tile, lane); }
    }
}
#define MFMA16(a, b, c) __builtin_amdgcn_mfma_f32_16x16x32_bf16((a), (b), (c), 0, 0, 0)
struct AttState { float m[2], l[2]; f32x4 o[4][2]; };
__device__ __forceinline__ void att_init(AttState& st) {
#pragma unroll
    for (int cg = 0; cg < 2; ++cg) { st.m[cg] = -1e30f; st.l[cg] = 0.f;
#pragma unroll
        for (int dg = 0; dg < 4; ++dg) st.o[dg][cg] = (f32x4){0.f, 0.f, 0.f, 0.f}; }
}
__device__ __forceinline__ bf16x8 pack_p(const f32x4& a, const f32x4& b) {
    v4u w; w.x = pk2(a[0], a[1]); w.y = pk2(a[2], a[3]); w.z = pk2(b[0], b[1]); w.w = pk2(b[2], b[3]); return __builtin_bit_cast(bf16x8, w);
}
typedef __amdgpu_buffer_rsrc_t rsrc_t;
__device__ __forceinline__ rsrc_t mk_rsrc(const void* p) { return __builtin_amdgcn_make_buffer_rsrc((void*)p, 0, 0x7fffff00, 0x00020000); }
__device__ __forceinline__ bf16x8 frag_ld(rsrc_t rs, int boff, int k, int lane) { return __builtin_bit_cast(bf16x8, __builtin_amdgcn_raw_buffer_load_b128(rs, lane * 16, boff + k * 1024, 0)); }
__device__ __forceinline__ void load_k(bf16x8 (&kf)[3][2], rsrc_t rs, int boff, int lane) {
#pragma unroll
    for (int kg = 0; kg < 3; ++kg)
#pragma unroll
        for (int dh = 0; dh < 2; ++dh) kf[kg][dh] = frag_ld(rs, boff, kg * 2 + dh, lane);
}
__device__ __forceinline__ void load_q_raw(const bf16* QG, int row, int hfull, int rq, v4u& r0, v4u& r1) {
    const GAS bf16* qp = (const GAS bf16*)QG + (size_t)row * QGLD + hfull * 64 + rq * 8; r0 = *(const GAS v4u*)qp; r1 = *(const GAS v4u*)(qp + 32);
}
__device__ __forceinline__ void norm_q(const v4u r0, const v4u r1, const float* qn, int rq, bf16x8 (&qf)[2]) {
    float x0[8], x1[8]; float ss = 0.f;
#pragma unroll
    for (int q = 0; q < 4; ++q) { x0[2 * q] = bflo(r0[q]); x0[2 * q + 1] = bfhi(r0[q]); x1[2 * q] = bflo(r1[q]); x1[2 * q + 1] = bfhi(r1[q]); }
#pragma unroll
    for (int j = 0; j < 8; ++j) ss += x0[j] * x0[j] + x1[j] * x1[j];
    ss = sum_x16_x32(ss);
    const float rs = (1.0f / sqrtf(ss * (1.0f / 64.0f) + EPS)) * (0.125f * 1.4426950408889634f);
    const GAS f32x4* gq = (const GAS f32x4*)(qn + rq * 8); const f32x4 g0 = gq[0], g1 = gq[1], g2 = gq[8], g3 = gq[9];
#pragma unroll
    for (int j = 0; j < 4; ++j) { x0[j] *= rs * g0[j]; x0[4 + j] *= rs * g1[j]; x1[j] *= rs * g2[j]; x1[4 + j] *= rs * g3[j]; }
    v4u w0, w1; w0.x = pk2(x0[0], x0[1]); w0.y = pk2(x0[2], x0[3]); w0.z = pk2(x0[4], x0[5]); w0.w = pk2(x0[6], x0[7]);
    w1.x = pk2(x1[0], x1[1]); w1.y = pk2(x1[2], x1[3]); w1.z = pk2(x1[4], x1[5]); w1.w = pk2(x1[6], x1[7]);
    qf[0] = __builtin_bit_cast(bf16x8, w0); qf[1] = __builtin_bit_cast(bf16x8, w1);
}
__device__ __forceinline__ void load_q(const bf16* QG, const float* qn, int row, int hfull, int rq, bf16x8 (&qf)[2]) { v4u r0, r1; load_q_raw(QG, row, hfull, rq, r0, r1); norm_q(r0, r1, qn, rq, qf); }
__device__ __forceinline__ float gate_ld(const bf16* QG, int row4, int g, int br, int lane) {
    int l2 = lane; asm volatile("" : "+v"(l2));
    const int c16 = l2 & 15; const unsigned off = (unsigned)(row4 + (c16 >> 2)) * (unsigned)QGLD + 1024u + (unsigned)((g * 4 + (c16 & 3)) * 3 + br);
    return 1.0f / (1.0f + __expf(-bf2f(((const GAS bf16*)QG)[off])));
}
__device__ __forceinline__ void stg_put(LAS unsigned char* stg, int col, int dg, int rq, v2u w) {
    *(LAS v2u*)(stg + col * 128 + (((2 * dg + (rq >> 1)) ^ (col & 7)) * 16) + (rq & 1) * 8) = w;
}
__device__ __forceinline__ v4u stg_get(const LAS unsigned char* stg, int lane, int k) { const int col = lane >> 1, ch = (lane & 1) * 4 + k;
    return *(const LAS v4u*)(stg + col * 128 + ((ch ^ (col & 7)) * 16)); }
struct SeqDesc { int qrow0, P, win_blk0, ncb; const unsigned char* slc; const unsigned char* win; const unsigned char* cmp;
    unsigned* cnt; unsigned* list; bf16* parto; float* partml; };

__device__ __forceinline__ void attn_sparse_phase(Frame& F, int j) {
    unsigned char* ws = AWS; const bf16* QG = (const bf16*)(ws + WS_QG); const float* qn = AIN(17) + j * 64;
    const GAS unsigned* cnt = (const GAS unsigned*)((unsigned*)F.ctl + CW_CNT + j * 1024 * CNT_PAD);
    const GAS unsigned* list = (const GAS unsigned*)(ws + WS_LIST);
    GAS bf16* parto = (GAS bf16*)(ws + WS_PARTO); GAS float* partml = (GAS float*)(ws + WS_PARTML);
    LAS int* P = (LAS int*)(F.lds + F.wave * WLDS_BYTES);
    const int lane = lane_id(), col16 = lane & 15, rq = lane >> 4, head = col16 & 3, tk4 = col16 >> 2;
    const int xc = F.vcu >> 5;
    unsigned* dq = (unsigned*)F.ctl + CW_DQ + 64 * (8 * j + xc);
    {
        int nch[16]; int tot = 0;
#pragma unroll
        for (int q = 0; q < 16; ++q) { const unsigned c1 = cnt[(16 * lane + q) * CNT_PAD]; nch[q] = (int)((c1 + 63u) >> 6); tot += nch[q]; }
        P[1088 + lane] = tot; LDS_WAIT(); asm volatile("" ::: "memory");
        int base = 0;
#pragma unroll 1
        for (int i = 0; i < 64; ++i) { const int v = P[1088 + i]; base += i < lane ? v : 0; }
#pragma unroll
        for (int k = 0; k < 16; ++k) { P[16 * lane + k] = base; base += nch[k]; }
        if (lane == 63) P[1024] = base;
        LDS_WAIT(); asm volatile("" ::: "memory");
    }
    const int ibase = P[128 * xc], total = P[128 * xc + 128] - ibase;
#pragma unroll 1
    for (;;) {
        unsigned it_ = 0; if (lane == 0) it_ = __hip_atomic_fetch_add(dq, 1u, __ATOMIC_RELAXED, __HIP_MEMORY_SCOPE_AGENT);
        const int itl = __builtin_amdgcn_readfirstlane(it_); if (itl >= total) break; const int item = ibase + itl;
        int lo_ = 0, hi_ = 1024;
#pragma unroll 1
        while (hi_ - lo_ > 1) { const int mid = (lo_ + hi_) >> 1; if (P[mid] <= item) lo_ = mid; else hi_ = mid; }
        const int L = __builtin_amdgcn_readfirstlane(lo_), chunk = item - __builtin_amdgcn_readfirstlane(P[lo_]);
        const int n = (int)cnt[L * CNT_PAD], e0 = chunk * 64, e1 = n < e0 + 64 ? n : e0 + 64;
        const int bg = L >> 7, g = bg & 3, b = bg >> 2;
        const GAS unsigned char* kb = (const GAS unsigned char*)(ws + WS_SLCP) + (size_t)L * FRAGB + lane * 16;
        bf16x8 kf[4][2], vf[2][4];
#pragma unroll
        for (int kg = 0; kg < 4; ++kg)
#pragma unroll
            for (int dh = 0; dh < 2; ++dh) kf[kg][dh] = *(const GAS bf16x8*)(kb + (kg * 2 + dh) * 1024);
#pragma unroll
        for (int sl = 0; sl < 2; ++sl)
#pragma unroll
            for (int dg = 0; dg < 4; ++dg) vf[sl][dg] = *(const GAS bf16x8*)(kb + 8192 + (sl * 4 + dg) * 1024);
        const GAS unsigned* le = list + (size_t)L * 8192;
        LAS unsigned* entL = (LAS unsigned*)(F.lds + F.wave * WLDS_BYTES + 8192);
        LAS unsigned char* stg = F.lds + F.wave * WLDS_BYTES + 12288;
        { const int e = e0 + lane; entL[lane] = le[e < e1 ? e : e0]; LDS_WAIT(); asm volatile("" ::: "memory"); }
        v4u raw[2][2], rawn[2][2];
#pragma unroll
        for (int cg = 0; cg < 2; ++cg) { const unsigned ent = entL[4 * cg + tk4]; load_q_raw(QG, (int)((size_t)b * SEQ + (ent & 0xffffu)), g * 4 + head, rq, raw[cg][0], raw[cg][1]); }
#pragma unroll 1
        for (int eb = e0; eb < e1; eb += 8) {
            { const int nb = eb + 8 < e1 ? eb + 8 - e0 : eb - e0;
#pragma unroll
              for (int cg = 0; cg < 2; ++cg) { const unsigned ent = entL[nb + 4 * cg + tk4]; load_q_raw(QG, (int)((size_t)b * SEQ + (ent & 0xffffu)), g * 4 + head, rq, rawn[cg][0], rawn[cg][1]); } }
            __builtin_amdgcn_sched_barrier(0);
#pragma unroll
            for (int cg = 0; cg < 2; ++cg) {
                const int e = eb + 4 * cg + tk4; const bool valid = e < e1; const unsigned ent = entL[eb - e0 + 4 * cg + tk4];
                const size_t row = (size_t)b * SEQ + (ent & 0xffffu); const int r = (int)(ent >> 16);
                bf16x8 qf[2]; norm_q(raw[cg][0], raw[cg][1], qn, rq, qf);
                f32x4 s[4];
#pragma unroll
                for (int kg = 0; kg < 4; ++kg) { s[kg] = (f32x4){0.f, 0.f, 0.f, 0.f}; s[kg] = MFMA16(kf[kg][0], qf[0], s[kg]); s[kg] = MFMA16(kf[kg][1], qf[1], s[kg]); }
                float mx = -1e30f;
#pragma unroll
                for (int kg = 0; kg < 4; ++kg)
#pragma unroll
                    for (int i = 0; i < 4; ++i) mx = fmaxf(mx, s[kg][i]);
                mx = max_x16_x32(mx);
                float ls = 0.f;
#pragma unroll
                for (int kg = 0; kg < 4; ++kg)
#pragma unroll
                    for (int i = 0; i < 4; ++i) { const float p = __builtin_amdgcn_exp2f(s[kg][i] - mx); s[kg][i] = p; ls += p; }
                ls = sum_x16_x32(ls);
                f32x4 o[4];
#pragma unroll
                for (int dg = 0; dg < 4; ++dg) o[dg] = (f32x4){0.f, 0.f, 0.f, 0.f};
#pragma unroll
                for (int sl = 0; sl < 2; ++sl) { const bf16x8 pf = pack_p(s[2 * sl], s[2 * sl + 1]);
#pragma unroll
                    for (int dg = 0; dg < 4; ++dg) o[dg] = MFMA16(vf[sl][dg], pf, o[dg]); }
                if (valid && rq == 0) { const size_t pi = ((row * 6 + r) * 16 + g * 4 + head); partml[pi * 2] = mx; partml[pi * 2 + 1] = ls; }
#pragma unroll
                for (int dg = 0; dg < 4; ++dg) { v2u w; w.x = pk2(o[dg][0], o[dg][1]); w.y = pk2(o[dg][2], o[dg][3]); stg_put(stg, cg * 16 + col16, dg, rq, w); }
            }
            LDS_WAIT(); asm volatile("" ::: "memory");
            { const int c_ = lane >> 1, e_ = eb + (c_ >> 2), hd_ = c_ & 3;
              if (e_ < e1) { const unsigned ent = entL[e_ - e0]; const size_t pi = (((size_t)b * SEQ + (ent & 0xffffu)) * 6 + (ent >> 16)) * 16 + g * 4 + hd_; GAS bf16* pp = parto + pi * 64 + (lane & 1) * 32;
#pragma unroll
                  for (int k = 0; k < 4; ++k) *(GAS v4u*)(pp + 8 * k) = stg_get(stg, lane, k); } }
            LDS_WAIT(); asm volatile("" ::: "memory");
#pragma unroll
            for (int cg = 0; cg < 2; ++cg) { raw[cg][0] = rawn[cg][0]; raw[cg][1] = rawn[cg][1]; }
        }
    }
}
__device__ __forceinline__ void attn_combine_phase(Frame& F, int j, bool dummy = false) {
    unsigned char* ws = AWS; const GAS bf16* QG = (const GAS bf16*)(ws + WS_QG); GAS bf16* O = (GAS bf16*)(ws + WS_ACT1); GAS bf16* Od = dummy ? (GAS bf16*)(ws + WS_BIG) : O;
    const GAS bf16* parto = (const GAS bf16*)(ws + WS_PARTO); const GAS float* partml = (const GAS float*)(ws + WS_PARTML);
    const int lane = lane_id(), hfull = lane >> 2, q = lane & 3;
    const int gw = F.vcu * NWAVES + F.wave, NGW = F.G * NWAVES;
#pragma unroll 1
    for (int row = gw; row < MP; row += NGW) {
        float m[6], l[6]; float M = -1e30f;
#pragma unroll
        for (int sl = 0; sl < 6; ++sl) { const GAS float* p = partml + (((size_t)row * 6 + sl) * 16 + hfull) * 2; m[sl] = p[0]; l[sl] = p[1]; M = fmaxf(M, l[sl] > 0.f ? m[sl] : -1e30f); }
        float acc[16]; float Lt = 0.f;
#pragma unroll
        for (int e = 0; e < 16; ++e) acc[e] = 0.f;
#pragma unroll
        for (int sl = 0; sl < 6; ++sl) { const GAS v4u* op = (const GAS v4u*)(parto + (((size_t)row * 6 + sl) * 16 + hfull) * 64 + q * 16); const v4u a = op[0], b = op[1];
            const float w = l[sl] > 0.f ? __builtin_amdgcn_exp2f(m[sl] - M) : 0.f; Lt += w * l[sl];
            if (l[sl] > 0.f) {
#pragma unroll
                for (int e = 0; e < 4; ++e) { acc[2 * e] += w * bflo(a[e]); acc[2 * e + 1] += w * bfhi(a[e]); acc[8 + 2 * e] += w * bflo(b[e]); acc[8 + 2 * e + 1] += w * bfhi(b[e]); } } }
        const float gl = bf2f(QG[(size_t)row * QGLD + 1024 + hfull * 3 + 1]); const float f = (1.0f / (1.0f + __expf(-gl))) / Lt;
        GAS v4u* dst = (GAS v4u*)(O + (size_t)row * A1LD + hfull * 64 + q * 16); const v4u b0 = dst[0], b1 = dst[1]; v4u r0, r1; dst = (GAS v4u*)(Od + (size_t)row * A1LD + hfull * 64 + q * 16);
#pragma unroll
        for (int e = 0; e < 4; ++e) { r0[e] = pk2(bflo(b0[e]) + acc[2 * e] * f, bfhi(b0[e]) + acc[2 * e + 1] * f); r1[e] = pk2(bflo(b1[e]) + acc[8 + 2 * e] * f, bfhi(b1[e]) + acc[8 + 2 * e + 1] * f); }
        dst[0] = r0; dst[1] = r1;
    }
}
template <int MODE>
__device__ __forceinline__ void att_block_h(bf16x8 (&kf)[3][2], rsrc_t rs, int boff, int noff, const bf16x8 (&qf)[2][2], int pos0, const int (&lo)[2], const int (&hi)[2], const bool (&on)[2], AttState& st, int lane) {
    const int rq = lane >> 4;
    bf16x8 vf[2][4];
#pragma unroll
    for (int sl = 0; sl < 2; ++sl)
#pragma unroll
        for (int dg = 0; dg < 4; ++dg) vf[sl][dg] = frag_ld(rs, boff, 8 + sl * 4 + dg, lane);
    bf16x8 k3[2]; k3[0] = frag_ld(rs, boff, 6, lane); k3[1] = frag_ld(rs, boff, 7, lane);
    __builtin_amdgcn_sched_barrier(0);
    f32x4 s[2][4];
#pragma unroll
    for (int cg = 0; cg < 2; ++cg) { const float nm = -st.m[cg];
#pragma unroll
        for (int kg = 0; kg < 3; ++kg) { s[cg][kg] = (f32x4){nm, nm, nm, nm}; s[cg][kg] = MFMA16(kf[kg][0], qf[cg][0], s[cg][kg]); s[cg][kg] = MFMA16(kf[kg][1], qf[cg][1], s[cg][kg]); }
        s[cg][3] = (f32x4){nm, nm, nm, nm}; s[cg][3] = MFMA16(k3[0], qf[cg][0], s[cg][3]); s[cg][3] = MFMA16(k3[1], qf[cg][1], s[cg][3]); }
    __builtin_amdgcn_sched_barrier(0);
    load_k(kf, rs, noff, lane);
    __builtin_amdgcn_sched_barrier(0);
#pragma unroll
    for (int cg = 0; cg < 2; ++cg) {
        if (MODE == 1) { const int rlo = lo[cg] - pos0 - 4 * rq, rhi = hi[cg] - pos0 - 4 * rq;
#pragma unroll
            for (int kg = 0; kg < 4; ++kg)
#pragma unroll
                for (int i = 0; i < 4; ++i) { const bool ok = (16 * kg + i) >= rlo && (16 * kg + i) <= rhi; s[cg][kg][i] = ok ? s[cg][kg][i] : -INFINITY; } }
        if (MODE == 2) {
#pragma unroll
            for (int kg = 0; kg < 4; ++kg)
#pragma unroll
                for (int i = 0; i < 4; ++i) s[cg][kg][i] = on[cg] ? s[cg][kg][i] : -INFINITY; }
        float mx = fmaxf(fmaxf(s[cg][0][0], s[cg][0][1]), fmaxf(s[cg][0][2], s[cg][0][3]));
#pragma unroll
        for (int kg = 1; kg < 4; ++kg) mx = fmaxf(fmaxf(mx, fmaxf(s[cg][kg][0], s[cg][kg][1])), fmaxf(s[cg][kg][2], s[cg][kg][3]));
        if (__any(mx > 8.0f || (mx < -32.0f && mx > -INFINITY))) { mx = max_x16_x32(mx); const float lc = sum_x16_x32(st.l[cg]); const float dl = lc > 0.f ? fmaxf(mx, 0.f) : (mx > -INFINITY ? mx : 0.f), alpha = __builtin_amdgcn_exp2f(-dl); st.m[cg] += dl; st.l[cg] *= alpha;
#pragma unroll
            for (int kg = 0; kg < 4; ++kg) s[cg][kg] = s[cg][kg] - dl;
#pragma unroll
            for (int dg = 0; dg < 4; ++dg) st.o[dg][cg] = st.o[dg][cg] * alpha; }
        float ls = 0.f;
#pragma unroll
        for (int kg = 0; kg < 4; ++kg)
#pragma unroll
            for (int i = 0; i < 4; ++i) { const float p = __builtin_amdgcn_exp2f(s[cg][kg][i]); s[cg][kg][i] = p; ls += p; }
        st.l[cg] += ls;
#pragma unroll
        for (int sl = 0; sl < 2; ++sl) { const bf16x8 pf = pack_p(s[cg][2 * sl], s[cg][2 * sl + 1]);
#pragma unroll
            for (int dg = 0; dg < 4; ++dg) st.o[dg][cg] = MFMA16(vf[sl][dg], pf, st.o[dg][cg]); }
    }
}
__device__ __forceinline__ void att_init0h(AttState& st) {
#pragma unroll
    for (int cg = 0; cg < 2; ++cg) { st.m[cg] = 0.f; st.l[cg] = 0.f;
#pragma unroll
        for (int dg = 0; dg < 4; ++dg) st.o[dg][cg] = (f32x4){0.f, 0.f, 0.f, 0.f}; }
}
__device__ __forceinline__ void attn_full_task(const bf16* QG, const float* qn, bf16* O, const SeqDesc sd, int g, LAS unsigned char* wl, int lane) {
    const int col16 = lane & 15, rq = lane >> 4, head = col16 & 3, tk4 = col16 >> 2;
    const int t0 = sd.P, cur = t0 >> 6, qrow = sd.qrow0;
    LAS float* impL = (LAS float*)wl;
    LAS int* selL = (LAS int*)(wl + 4096);
    LAS int* prog = (LAS int*)(wl + 4352);
    LAS f32x4* oL = (LAS f32x4*)(wl + 4608) + lane;
    bf16x8 qf[2][2]; int tcol[2]; float glg[2][3];
#pragma unroll
    for (int cg = 0; cg < 2; ++cg) { tcol[cg] = t0 + 4 * cg + tk4; load_q(QG, qn, qrow + 4 * cg + tk4, g * 4 + head, rq, qf[cg]);
        const GAS bf16* gp = (const GAS bf16*)QG + (size_t)(qrow + 4 * cg + tk4) * QGLD + 1024 + (g * 4 + head) * 3;
#pragma unroll
        for (int br = 0; br < 3; ++br) glg[cg][br] = bf2f(gp[br]); }
    {
        int hic[2]; hic[0] = ((tcol[0] + 1) >> 5) - 1; hic[1] = ((tcol[1] + 1) >> 5) - 1;
        int cbmax = (2 * cur + 1) >> 6; if (cbmax > sd.ncb - 1) cbmax = sd.ncb - 1;
        float m[2] = {0.f, 0.f}, l[2] = {0.f, 0.f};
#pragma unroll 1
        for (int cb = 0; cb <= cbmax; ++cb) {
            const GAS unsigned char* kb = (const GAS unsigned char*)sd.cmp + (size_t)cb * FRAGB + lane * 16;
            bf16x8 kf[4][2];
#pragma unroll
            for (int kg = 0; kg < 4; ++kg) { kf[kg][0] = *(const GAS bf16x8*)(kb + (kg * 2) * 1024); kf[kg][1] = *(const GAS bf16x8*)(kb + (kg * 2 + 1) * 1024); }
#pragma unroll
            for (int cg = 0; cg < 2; ++cg) {
                f32x4 sc[4]; const float nm = -m[cg]; float mx = -INFINITY;
#pragma unroll
                for (int kg = 0; kg < 4; ++kg) { sc[kg] = (f32x4){nm, nm, nm, nm}; sc[kg] = MFMA16(kf[kg][0], qf[cg][0], sc[kg]); sc[kg] = MFMA16(kf[kg][1], qf[cg][1], sc[kg]); }
#pragma unroll
                for (int kg = 0; kg < 4; ++kg)
#pragma unroll
                    for (int i = 0; i < 4; ++i) { sc[kg][i] = (16 * kg + i) <= hic[cg] - 64 * cb - 4 * rq ? sc[kg][i] : -INFINITY; mx = fmaxf(mx, sc[kg][i]); }
                if (__any(mx > 8.0f || (mx < -32.0f && mx > -INFINITY))) { mx = max_x16_x32(mx); const float lc = sum_x16_x32(l[cg]); const float dl = lc > 0.f ? fmaxf(mx, 0.f) : (mx > -INFINITY ? mx : 0.f); m[cg] += dl; l[cg] *= __builtin_amdgcn_exp2f(-dl);
#pragma unroll
                    for (int kg = 0; kg < 4; ++kg) sc[kg] = sc[kg] - dl; }
#pragma unroll
                for (int kg = 0; kg < 4; ++kg)
#pragma unroll
                    for (int i = 0; i < 4; ++i) l[cg] += __builtin_amdgcn_exp2f(sc[kg][i]);
            }
        }
        float linv[2];
#pragma unroll
        for (int cg = 0; cg < 2; ++cg) { const float lt = sum_x16_x32(l[cg]); linv[cg] = lt > 0.f ? 1.0f / lt : 0.f; }
        f32x4 oc4[4][2];
#pragma unroll
        for (int dg = 0; dg < 4; ++dg) { oc4[dg][0] = (f32x4){0.f, 0.f, 0.f, 0.f}; oc4[dg][1] = (f32x4){0.f, 0.f, 0.f, 0.f}; }
#pragma unroll 1
        for (int cb = 0; cb <= cbmax; ++cb) {
            const GAS unsigned char* kb = (const GAS unsigned char*)sd.cmp + (size_t)cb * FRAGB + lane * 16;
            bf16x8 kf[4][2], vf[2][4];
#pragma unroll
            for (int kg = 0; kg < 4; ++kg) { kf[kg][0] = *(const GAS bf16x8*)(kb + (kg * 2) * 1024); kf[kg][1] = *(const GAS bf16x8*)(kb + (kg * 2 + 1) * 1024); }
#pragma unroll
            for (int sl = 0; sl < 2; ++sl)
#pragma unroll
                for (int dg = 0; dg < 4; ++dg) vf[sl][dg] = *(const GAS bf16x8*)(kb + 8192 + (sl * 4 + dg) * 1024);
#pragma unroll
            for (int cg = 0; cg < 2; ++cg) {
                f32x4 sc[4]; const float nm = -m[cg];
#pragma unroll
                for (int kg = 0; kg < 4; ++kg) { sc[kg] = (f32x4){nm, nm, nm, nm}; sc[kg] = MFMA16(kf[kg][0], qf[cg][0], sc[kg]); sc[kg] = MFMA16(kf[kg][1], qf[cg][1], sc[kg]); }
#pragma unroll
                for (int kg = 0; kg < 4; ++kg) {
#pragma unroll
                    for (int i = 0; i < 4; ++i) sc[kg][i] = (16 * kg + i) <= hic[cg] - 64 * cb - 4 * rq ? __builtin_amdgcn_exp2f(sc[kg][i]) * linv[cg] : 0.f;
                    float e0 = sc[kg][0] + sc[kg][1], e1 = sc[kg][2] + sc[kg][3];
                    e0 = sum4(e0); e1 = sum4(e1);
                    if (head == 0) { LAS float* ip = impL + (4 * cg + tk4) * 128 + 32 * cb + 8 * kg + 2 * rq; ip[0] = e0; ip[1] = e1; }
                }
#pragma unroll
                for (int sl = 0; sl < 2; ++sl) { const bf16x8 pf = pack_p(sc[2 * sl], sc[2 * sl + 1]);
#pragma unroll
                    for (int dg = 0; dg < 4; ++dg) oc4[dg][cg] = MFMA16(vf[sl][dg], pf, oc4[dg][cg]); }
            }
        }
#pragma unroll
        for (int cg = 0; cg < 2; ++cg) { const float gt = 1.0f / (1.0f + __expf(-glg[cg][0]));
#pragma unroll
            for (int dg = 0; dg < 4; ++dg) oL[(dg * 2 + cg) * 64] = oc4[dg][cg] * gt; }
    }
    LDS_WAIT(); asm volatile("" ::: "memory");
    {
        const int tok = lane >> 3, j8 = lane & 7; float v[16];
#pragma unroll
        for (int k = 0; k < 16; ++k) { const int bb = 16 * j8 + k; const float x = impL[tok * 128 + bb]; v[k] = (bb >= 1 && bb <= cur - 2) ? x : -1.f; }
#pragma unroll
        for (int r = 0; r < 5; ++r) {
            float best = v[0]; int bi = 0;
#pragma unroll
            for (int k = 1; k < 16; ++k) if (v[k] > best) { best = v[k]; bi = k; }
            int gi = 16 * j8 + bi;
#pragma unroll
            for (int st_ = 0; st_ < 3; ++st_) { const float ov = st_ == 0 ? DPP_F(best, DPP_XOR1) : st_ == 1 ? DPP_F(best, DPP_XOR2) : DPP_F(best, DPP_HMIRROR);
                const int oi = st_ == 0 ? DPP_I(gi, DPP_XOR1) : st_ == 1 ? DPP_I(gi, DPP_XOR2) : DPP_I(gi, DPP_HMIRROR); if (ov > best || (ov == best && oi < gi)) { best = ov; gi = oi; } }
            if (j8 == 0) selL[tok * 8 + r] = best >= 0.f ? gi : -1;
            if ((gi >> 4) == j8) {
#pragma unroll
                for (int k = 0; k < 16; ++k) if ((gi & 15) == k) v[k] = -1.f; }
        }
    }
    LDS_WAIT(); asm volatile("" ::: "memory");
    {
        AttState st; att_init0h(st);
        int lo[2] = {0, 0}, hi[2] = {tcol[0], tcol[1]};
        int nprog;
        {
            int fm = 1 << 16; asm volatile("" : "+s"(fm));
            if (lane == 0) { int n = 0; prog[n++] = 0 | fm; if (cur >= 2) prog[n++] = (cur - 1) | fm; if (cur >= 1) prog[n++] = cur | fm; prog[63] = n; }
            LDS_WAIT(); asm volatile("" ::: "memory");
            int n = __builtin_amdgcn_readfirstlane(prog[63]);
#pragma unroll 1
            for (int half = 0; half < 2; ++half) { const int b = lane + 64 * half; int tm = 0;
#pragma unroll 1
                for (int tok = 0; tok < 8; ++tok)
#pragma unroll
                    for (int r = 0; r < 5; ++r) tm |= (selL[tok * 8 + r] == b) ? (1 << tok) : 0;
                const unsigned long long bal = __ballot(tm != 0); const int pre = __popcll(bal & ((1ull << lane) - 1ull));
                if (tm != 0) prog[n + pre] = b | (tm << 8);
                n += __popcll(bal); }
            if (lane == 0) { prog[n] = prog[n - 1]; prog[63] = n; }
            LDS_WAIT(); asm volatile("" ::: "memory"); nprog = __builtin_amdgcn_readfirstlane(prog[63]); }
        const rsrc_t rs = mk_rsrc(sd.slc);
        bf16x8 kf[3][2]; load_k(kf, rs, 0, lane);
#pragma unroll 1
        for (int i = 0; i < nprog; ++i) {
            const int e = __builtin_amdgcn_readfirstlane(prog[i]), en = __builtin_amdgcn_readfirstlane(prog[i + 1]);
            const int b = e & 255, tm = (e >> 8) & 255, bp = b * FRAGB, np = (en & 255) * FRAGB;
            bool on[2]; on[0] = (tm >> tk4) & 1; on[1] = (tm >> (4 + tk4)) & 1;
            if (e >> 16) { if (b == cur) att_block_h<1>(kf, rs, bp, np, qf, 64 * b, lo, hi, on, st, lane); else att_block_h<0>(kf, rs, bp, np, qf, 64 * b, lo, hi, on, st, lane); }
            else att_block_h<2>(kf, rs, bp, np, qf, 64 * b, lo, hi, on, st, lane);
        }
#pragma unroll
        for (int cg = 0; cg < 2; ++cg) { const float lt = sum_x16_x32(st.l[cg]), f = (1.0f / (1.0f + __expf(-glg[cg][1]))) / lt;
#pragma unroll
            for (int dg = 0; dg < 4; ++dg) oL[(dg * 2 + cg) * 64] = oL[(dg * 2 + cg) * 64] + st.o[dg][cg] * f; }
    }
    asm volatile("" ::: "memory");
    {
        AttState st; att_init0h(st);
        int lo[2] = {tcol[0] - 512, tcol[1] - 512}, hi[2] = {tcol[0], tcol[1]}; bool on[2] = {true, true};
        int b0 = cur - 8; if (b0 < sd.win_blk0) b0 = sd.win_blk0;
        const rsrc_t rs = mk_rsrc(sd.win);
        bf16x8 kf[3][2]; load_k(kf, rs, (b0 - sd.win_blk0) * FRAGB, lane);
#pragma unroll 1
        for (int b = b0; b <= cur; ++b) { const int bn = b < cur ? b + 1 : b; const bool edge = b == cur || b == cur - 8;
            if (edge) att_block_h<1>(kf, rs, (b - sd.win_blk0) * FRAGB, (bn - sd.win_blk0) * FRAGB, qf, 64 * b, lo, hi, on, st, lane);
            else att_block_h<0>(kf, rs, (b - sd.win_blk0) * FRAGB, (bn - sd.win_blk0) * FRAGB, qf, 64 * b, lo, hi, on, st, lane); }
#pragma unroll
        for (int cg = 0; cg < 2; ++cg) { const float lt = sum_x16_x32(st.l[cg]), f = (1.0f / (1.0f + __expf(-glg[cg][2]))) / lt;
            int l3 = lane; asm volatile("" : "+v"(l3)); const unsigned ooff = (unsigned)(qrow + 4 * cg + ((l3 & 15) >> 2)) * (unsigned)A1LD + (unsigned)((g * 4 + (l3 & 3)) * 64 + 4 * (l3 >> 4)); GAS bf16* op = (GAS bf16*)O + ooff;
#pragma unroll
            for (int dg = 0; dg < 4; ++dg) { const f32x4 ov = oL[(dg * 2 + cg) * 64] + st.o[dg][cg] * f; v2u w; w.x = pk2(ov[0], ov[1]); w.y = pk2(ov[2], ov[3]); *(GAS v2u*)(op + 16 * dg) = w; } }
    }
    LDS_WAIT(); asm volatile("" ::: "memory");
}
__device__ __forceinline__ void attn_sample_part(Frame& F, int j) {
    unsigned char* ws = AWS; const bf16* QG = (const bf16*)(ws + WS_QG); const float* qn = AIN(17) + j * 64;
    LAS unsigned* ctr2 = (LAS unsigned*)(F.lds + LDSCTL_OFF + 128) + 2 + j; unsigned si = 0; const int l0 = lane_id();
    if (l0 == 0) si = __hip_atomic_fetch_add(ctr2, 1u, __ATOMIC_RELAXED, __HIP_MEMORY_SCOPE_WORKGROUP);
    const int sidx = __builtin_amdgcn_readfirstlane(si);
    if (sidx < 2) { const int t = F.vcu * 2 + sidx, seq = t >> 2; SeqDesc sd;
        sd.qrow0 = MP + seq * 8; sd.P = PAST; sd.win_blk0 = 24; sd.ncb = 1;
        sd.slc = ws + WS_SLCS + (size_t)t * 33 * FRAGB; sd.win = ws + WS_WINS + (size_t)t * 9 * FRAGB; sd.cmp = ws + WS_CMPS + (size_t)t * FRAGB;
        sd.cnt = nullptr; sd.list = nullptr; sd.parto = nullptr; sd.partml = nullptr;
        attn_full_task(QG, qn, (bf16*)(ws + WS_ACT1), sd, t & 3, F.lds + F.wave * WLDS_BYTES, lane_id());
#if defined(PROBE_SAMP2)
        attn_full_task(QG, qn, (bf16*)(ws + WS_ACT1), sd, t & 3, F.lds + F.wave * WLDS_BYTES, lane_id());
#endif
    }
}
__device__ __forceinline__ void glds16(const void* gsrc, unsigned lds_dst) { unsigned keep;
    asm volatile("s_mov_b32 %0, m0\n\ts_mov_b32 m0, %2\n\ts_nop 0\n\tglobal_load_lds_dwordx4 %1, off\n\ts_mov_b32 m0, %0" : "=&s"(keep) : "v"(gsrc), "s"(lds_dst) : "memory"); }
__device__ __forceinline__ bf16x8 lfrag(const LAS unsigned char* buf, int k, int lane) { return *(const LAS bf16x8*)(buf + k * 1024 + lane * 16); }
template <int MODE>
__device__ __forceinline__ void att_block_lds(const LAS unsigned char* buf, const bf16x8 (&qf)[2][2], int pos0, const int (&lo)[2], const int (&hi)[2], AttState& st, int lane) {
    const int rq = lane >> 4; constexpr float THR = 8.0f;
    typedef float f32x2v __attribute__((ext_vector_type(2)));
    f32x4 s[2][4];
    {
        bf16x8 kf[4][2];
#pragma unroll
        for (int kg = 0; kg < 4; ++kg) { kf[kg][0] = lfrag(buf, kg * 2, lane); kf[kg][1] = lfrag(buf, kg * 2 + 1, lane); }
        if (__all(st.m[0] == 0.f && st.m[1] == 0.f)) {
#pragma unroll
            for (int cg = 0; cg < 2; ++cg)
#pragma unroll
                for (int kg = 0; kg < 4; ++kg) { s[cg][kg] = MFMA16(kf[kg][0], qf[cg][0], ((f32x4){0.f, 0.f, 0.f, 0.f})); s[cg][kg] = MFMA16(kf[kg][1], qf[cg][1], s[cg][kg]); }
        } else {
#pragma unroll
            for (int cg = 0; cg < 2; ++cg) { const float nm = -st.m[cg];
#pragma unroll
                for (int kg = 0; kg < 4; ++kg) { s[cg][kg] = (f32x4){nm, nm, nm, nm}; s[cg][kg] = MFMA16(kf[kg][0], qf[cg][0], s[cg][kg]); s[cg][kg] = MFMA16(kf[kg][1], qf[cg][1], s[cg][kg]); } }
        }
    }
    bf16x8 vf[2][4];
#pragma unroll
    for (int sl = 0; sl < 2; ++sl)
#pragma unroll
        for (int dg = 0; dg < 4; ++dg) vf[sl][dg] = lfrag(buf, 8 + sl * 4 + dg, lane);
#pragma unroll
    for (int cg = 0; cg < 2; ++cg) {
        const int rb = (MODE == 2 ? lo[cg] : hi[cg]) - pos0 - 4 * rq;
        const bool has = MODE == 0 ? true : MODE == 1 ? rb >= 0 : rb <= 51;
        float ls;
        {
            f32x2v a2 = (f32x2v){0.f, 0.f};
#pragma unroll
            for (int kg = 0; kg < 4; ++kg) { f32x4 pv;
#pragma unroll
                for (int i = 0; i < 4; ++i) { pv[i] = __builtin_amdgcn_exp2f(s[cg][kg][i]);
                    if (MODE == 1) pv[i] = (16 * kg + i) <= rb ? pv[i] : 0.f;
                    if (MODE == 2) pv[i] = (16 * kg + i) >= rb ? pv[i] : 0.f; }
                a2 += (f32x2v){pv[0], pv[1]}; a2 += (f32x2v){pv[2], pv[3]}; s[cg][kg] = pv; }
            ls = a2.x + a2.y;
        }
#if defined(PROBE_RARE)
        if (__any(ls >= 0.f)) {
#else
        if (__any(!(ls <= 4096.0f) || (has && ls < 0x1p-30f))) {
#endif
            const float nm = -st.m[cg];
#pragma unroll
            for (int kg = 0; kg < 4; ++kg) { const bf16x8 k0 = lfrag(buf, kg * 2, lane), k1 = lfrag(buf, kg * 2 + 1, lane); s[cg][kg] = (f32x4){nm, nm, nm, nm}; s[cg][kg] = MFMA16(k0, qf[cg][0], s[cg][kg]); s[cg][kg] = MFMA16(k1, qf[cg][1], s[cg][kg]); }
            if (MODE != 0) {
#pragma unroll
                for (int kg = 0; kg < 4; ++kg)
#pragma unroll
                    for (int i = 0; i < 4; ++i) { const bool ok = MODE == 1 ? (16 * kg + i) <= rb : (16 * kg + i) >= rb; s[cg][kg][i] = ok ? s[cg][kg][i] : -INFINITY; } }
            float mx = fmaxf(fmaxf(s[cg][0][0], s[cg][0][1]), fmaxf(s[cg][0][2], s[cg][0][3]));
#pragma unroll
            for (int kg = 1; kg < 4; ++kg) mx = fmaxf(fmaxf(mx, fmaxf(s[cg][kg][0], s[cg][kg][1])), fmaxf(s[cg][kg][2], s[cg][kg][3]));
            if (__any(mx > THR || (mx < -32.0f && mx > -INFINITY))) {
                mx = max_x16_x32(mx); const float lc = sum_x16_x32(st.l[cg]); const float dl = lc > 0.f ? fmaxf(mx, 0.f) : (mx > -INFINITY ? mx : 0.f), alpha = __builtin_amdgcn_exp2f(-dl); st.m[cg] += dl; st.l[cg] *= alpha;
#pragma unroll
                for (int kg = 0; kg < 4; ++kg) s[cg][kg] = s[cg][kg] - dl;
#pragma unroll
                for (int dg = 0; dg < 4; ++dg) st.o[dg][cg] = st.o[dg][cg] * alpha;
            }
            ls = 0.f;
#pragma unroll
            for (int kg = 0; kg < 4; ++kg)
#pragma unroll
                for (int i = 0; i < 4; ++i) { const float p = __builtin_amdgcn_exp2f(s[cg][kg][i]); s[cg][kg][i] = p; ls += p; }
        }
        st.l[cg] += ls;
#pragma unroll
        for (int sl = 0; sl < 2; ++sl) { const bf16x8 pf = pack_p(s[cg][2 * sl], s[cg][2 * sl + 1]);
#pragma unroll
            for (int dg = 0; dg < 4; ++dg) st.o[dg][cg] = MFMA16(vf[sl][dg], pf, st.o[dg][cg]); }
    }
}
__device__ __forceinline__ void att_init0(AttState& st) {
#pragma unroll
    for (int cg = 0; cg < 2; ++cg) { st.m[cg] = 0.f; st.l[cg] = 0.f;
#pragma unroll
        for (int dg = 0; dg < 4; ++dg) st.o[dg][cg] = (f32x4){0.f, 0.f, 0.f, 0.f}; }
}

__device__ __forceinline__ void attn_tile_phase(Frame& F, int j) {
    unsigned char* ws = AWS; const bf16* QG = (const bf16*)(ws + WS_QG); bf16* O = (bf16*)(ws + WS_ACT1); const float* qn = AIN(17) + j * 64;
    const int w = F.wave, bg = F.vcu >> 5, c5 = F.vcu & 31, b = bg >> 2, g = bg & 3;
    const unsigned char* cmpb = ws + WS_CMPP + (size_t)bg * 4 * FRAGB; const unsigned char* slcb = ws + WS_SLCP + (size_t)bg * 128 * FRAGB; const unsigned char* winb = ws + WS_WINP + (size_t)bg * 128 * FRAGB;
    unsigned* cnt = (unsigned*)F.ctl + CW_CNT + (j * 1024 + bg * 128) * CNT_PAD; GAS unsigned* list = (GAS unsigned*)(ws + WS_LIST) + (size_t)bg * 128 * 8192;
    GAS bf16* parto = (GAS bf16*)(ws + WS_PARTO); GAS float* partml = (GAS float*)(ws + WS_PARTML);
    const LAS unsigned char* ring = F.lds; const unsigned lds0 = (unsigned)(unsigned long long)(const LAS void*)F.lds;
    LAS unsigned char* wl = F.lds + 65536 + w * 8448; LAS float* impL = (LAS float*)wl; LAS int* selL = (LAS int*)(wl + 4096);
    int pend_b = -1; unsigned pend_idx = 0u, pend_val = 0u;
#pragma unroll 1
    for (int tile = 0; tile < 4; ++tile) {
        const int lane = lane_id(), col16 = lane & 15, rq = lane >> 4, head = col16 & 3, tk4 = col16 >> 2;
        const int cur = tile == 0 ? c5 : tile == 1 ? 63 - c5 : tile == 2 ? 64 + c5 : 127 - c5;
        const int oc = 8 * cur + w, t0 = 8 * oc, qrow = b * SEQ + t0;
        const int n1 = ((2 * cur + 1) >> 6) + 1, nf = cur >= 2 ? 3 : cur + 1, wb0 = cur > 8 ? cur - 8 : 0, nw = cur - wb0 + 1, nsteps = 2 * n1 + nf + nw;
#define STEP_PTR(s_) ((s_) < 2 * n1 ? cmpb + (size_t)((s_) < n1 ? (s_) : (s_) - n1) * FRAGB : (s_) < 2 * n1 + nf ? slcb + (size_t)((s_) == 2 * n1 ? 0 : ((s_) == 2 * n1 + nf - 1 ? cur : cur - 1)) * FRAGB : winb + (size_t)(wb0 + (s_) - 2 * n1 - nf) * FRAGB)
#define ISSUE(s_) do { const unsigned char* gp_ = STEP_PTR(s_) + (size_t)(2 * w) * 1024 + lane * 16; const unsigned ld_ = lds0 + (unsigned)(((s_) & 3) * 16384 + 2 * w * 1024); glds16(gp_, ld_); glds16(gp_ + 1024, ld_ + 1024); } while (0)
        bf16x8 qf[2][2]; int tcol[2];
        v4u qr[2][2];
#pragma unroll
        for (int cg = 0; cg < 2; ++cg) { tcol[cg] = t0 + 4 * cg + tk4; load_q_raw(QG, qrow + 4 * cg + tk4, g * 4 + head, rq, qr[cg][0], qr[cg][1]); }
        float gl[2][3];
#pragma unroll
        for (int cg = 0; cg < 2; ++cg) { const GAS bf16* gp = (const GAS bf16*)QG + (size_t)(qrow + 4 * cg + tk4) * QGLD + 1024 + (g * 4 + head) * 3;
#pragma unroll
            for (int br = 0; br < 3; ++br) gl[cg][br] = bf2f(gp[br]); }
#pragma unroll
        for (int cg = 0; cg < 2; ++cg) norm_q(qr[cg][0], qr[cg][1], qn, rq, qf[cg]);
        asm volatile("s_waitcnt vmcnt(0) lgkmcnt(0)\n\ts_barrier" ::: "memory");
        if (pend_b >= 0) list[(size_t)pend_b * 8192 + pend_idx] = pend_val;
        ISSUE(0); if (1 < nsteps) ISSUE(1); if (2 < nsteps) ISSUE(2);
        int hic[2]; hic[0] = ((tcol[0] + 1) >> 5) - 1; hic[1] = ((tcol[1] + 1) >> 5) - 1;
        float m[2] = {0.f, 0.f}, l[2] = {0.f, 0.f}, linv[2] = {0.f, 0.f};
        const int hmin = ((t0 + 1) >> 5) - 1;
        bool atom_out = false;
        LAS v2u* oLp = (LAS v2u*)(wl + 4352) + lane;
#if defined(PROBE_V0)
#define STEP_HEAD(s_) do { asm volatile("s_waitcnt vmcnt(0)\n\ts_barrier" ::: "memory"); if ((s_) + 3 < nsteps) ISSUE((s_) + 3); } while (0)
#else
#define STEP_HEAD(s_) do { if ((s_) + 2 < nsteps) asm volatile("s_waitcnt vmcnt(4)\n\ts_barrier" ::: "memory"); \
            else if ((s_) + 1 < nsteps) asm volatile("s_waitcnt vmcnt(2)\n\ts_barrier" ::: "memory"); \
            else if (atom_out) asm volatile("s_waitcnt vmcnt(1)\n\ts_barrier" ::: "memory"); else asm volatile("s_waitcnt vmcnt(0)\n\ts_barrier" ::: "memory"); \
            if ((s_) + 3 < nsteps) ISSUE((s_) + 3); } while (0)
#endif
#if defined(PROBE_SK)
        { for (int s2 = 0; s2 < nsteps; ++s2) { STEP_HEAD(s2); }
          asm volatile("s_waitcnt vmcnt(0) lgkmcnt(0)\n\ts_barrier" ::: "memory"); ISSUE(0); if (1 < nsteps) ISSUE(1); if (2 < nsteps) ISSUE(2); }
#endif
        int s = 0;
#pragma unroll 1
        for (; s < n1; ++s) {
            STEP_HEAD(s); const LAS unsigned char* buf = ring + (s & 3) * 16384;
            const int cb = s; bf16x8 kf[4][2];
#pragma unroll
            for (int kg = 0; kg < 4; ++kg) { kf[kg][0] = lfrag(buf, kg * 2, lane); kf[kg][1] = lfrag(buf, kg * 2 + 1, lane); }
            const bool full = 64 * cb + 63 <= hmin;
            const bool mz = __all(m[0] == 0.f && m[1] == 0.f);
#pragma unroll
            for (int cg = 0; cg < 2; ++cg) {
                typedef float f32x2v __attribute__((ext_vector_type(2)));
                f32x4 sc[4]; const float nm = -m[cg];
                if (mz) {
#pragma unroll
                    for (int kg = 0; kg < 4; ++kg) { sc[kg] = MFMA16(kf[kg][0], qf[cg][0], ((f32x4){0.f, 0.f, 0.f, 0.f})); sc[kg] = MFMA16(kf[kg][1], qf[cg][1], sc[kg]); }
                } else {
#pragma unroll
                    for (int kg = 0; kg < 4; ++kg) { sc[kg] = (f32x4){nm, nm, nm, nm}; sc[kg] = MFMA16(kf[kg][0], qf[cg][0], sc[kg]); sc[kg] = MFMA16(kf[kg][1], qf[cg][1], sc[kg]); } }
                const int rb = hic[cg] - 64 * cb - 4 * rq; const bool has = full || rb >= 0;
                f32x2v a2 = (f32x2v){0.f, 0.f};
                if (full) {
#pragma unroll
                    for (int kg = 0; kg < 4; ++kg) { f32x4 pv;
#pragma unroll
                        for (int i = 0; i < 4; ++i) pv[i] = __builtin_amdgcn_exp2f(sc[kg][i]);
                        a2 += (f32x2v){pv[0], pv[1]}; a2 += (f32x2v){pv[2], pv[3]}; }
                } else {
#pragma unroll
                    for (int kg = 0; kg < 4; ++kg) { f32x4 pv;
#pragma unroll
                        for (int i = 0; i < 4; ++i) { pv[i] = __builtin_amdgcn_exp2f(sc[kg][i]); pv[i] = (16 * kg + i) <= rb ? pv[i] : 0.f; }
                        a2 += (f32x2v){pv[0], pv[1]}; a2 += (f32x2v){pv[2], pv[3]}; } }
                float ls = a2.x + a2.y;
#if defined(PROBE_RARE)
                if (__any(ls >= 0.f)) {
#else
                if (__any(!(ls <= 4096.0f) || (has && ls < 0x1p-30f))) {
#endif
#pragma unroll
                    for (int kg = 0; kg < 4; ++kg) { sc[kg] = (f32x4){nm, nm, nm, nm}; sc[kg] = MFMA16(kf[kg][0], qf[cg][0], sc[kg]); sc[kg] = MFMA16(kf[kg][1], qf[cg][1], sc[kg]); }
#pragma unroll
                    for (int kg = 0; kg < 4; ++kg)
#pragma unroll
                        for (int i = 0; i < 4; ++i) sc[kg][i] = (16 * kg + i) <= rb ? sc[kg][i] : -INFINITY;
                    float mx = fmaxf(fmaxf(sc[0][0], sc[0][1]), fmaxf(sc[0][2], sc[0][3]));
#pragma unroll
                    for (int kg = 1; kg < 4; ++kg) mx = fmaxf(fmaxf(mx, fmaxf(sc[kg][0], sc[kg][1])), fmaxf(sc[kg][2], sc[kg][3]));
                    if (__any(mx > 8.0f || (mx < -32.0f && mx > -INFINITY))) { mx = max_x16_x32(mx); const float lc = sum_x16_x32(l[cg]); const float dl = lc > 0.f ? fmaxf(mx, 0.f) : (mx > -INFINITY ? mx : 0.f); m[cg] += dl; l[cg] *= __builtin_amdgcn_exp2f(-dl);
#pragma unroll
                        for (int kg = 0; kg < 4; ++kg) sc[kg] = sc[kg] - dl; }
                    ls = 0.f;
#pragma unroll
                    for (int kg = 0; kg < 4; ++kg)
#pragma unroll
                        for (int i = 0; i < 4; ++i) ls += __builtin_amdgcn_exp2f(sc[kg][i]);
                }
                l[cg] += ls;
            }
        }
#pragma unroll
        for (int cg = 0; cg < 2; ++cg) { float lt = l[cg]; lt = sum_x16_x32(lt); linv[cg] = lt > 0.f ? 1.0f / lt : 0.f; }
        {
            f32x4 outv[4][2];
#pragma unroll
            for (int dg = 0; dg < 4; ++dg) { outv[dg][0] = (f32x4){0.f, 0.f, 0.f, 0.f}; outv[dg][1] = (f32x4){0.f, 0.f, 0.f, 0.f}; }
#pragma unroll 1
            for (; s < 2 * n1; ++s) {
                STEP_HEAD(s); const LAS unsigned char* buf = ring + (s & 3) * 16384;
                const int cb = s - n1; bf16x8 kf[4][2], vf[2][4];
                const bool mz2 = __all(m[0] == 0.f && m[1] == 0.f);
#pragma unroll
                for (int kg = 0; kg < 4; ++kg) { kf[kg][0] = lfrag(buf, kg * 2, lane); kf[kg][1] = lfrag(buf, kg * 2 + 1, lane); }
#pragma unroll
                for (int sl = 0; sl < 2; ++sl)
#pragma unroll
                    for (int dg = 0; dg < 4; ++dg) vf[sl][dg] = lfrag(buf, 8 + sl * 4 + dg, lane);
#pragma unroll
                for (int cg = 0; cg < 2; ++cg) {
                    f32x4 sc[4];
#pragma unroll
                    for (int kg = 0; kg < 4; ++kg) { const float nm = -m[cg];
                        if (mz2) sc[kg] = MFMA16(kf[kg][0], qf[cg][0], ((f32x4){0.f, 0.f, 0.f, 0.f})); else { sc[kg] = (f32x4){nm, nm, nm, nm}; sc[kg] = MFMA16(kf[kg][0], qf[cg][0], sc[kg]); }
                        sc[kg] = MFMA16(kf[kg][1], qf[cg][1], sc[kg]); }
                    if (64 * cb + 63 > hmin) {
#pragma unroll
                        for (int kg = 0; kg < 4; ++kg)
#pragma unroll
                            for (int i = 0; i < 4; ++i) sc[kg][i] = (16 * kg + i) <= hic[cg] - 64 * cb - 4 * rq ? sc[kg][i] : -INFINITY; }
#pragma unroll
                    for (int kg = 0; kg < 4; ++kg) {
#pragma unroll
                        for (int i = 0; i < 4; ++i) sc[kg][i] = __builtin_amdgcn_exp2f(sc[kg][i]) * linv[cg];
                        float e0 = sc[kg][0] + sc[kg][1], e1 = sc[kg][2] + sc[kg][3];
                        e0 = sum4(e0); e1 = sum4(e1);
                        if (head == 0) { LAS float* ip = impL + (4 * cg + tk4) * 128 + 32 * cb + 8 * kg + 2 * rq; ip[0] = e0; ip[1] = e1; }
                    }
#pragma unroll
                    for (int sl = 0; sl < 2; ++sl) { const bf16x8 pf = pack_p(sc[2 * sl], sc[2 * sl + 1]);
#pragma unroll
                        for (int dg = 0; dg < 4; ++dg) outv[dg][cg] = MFMA16(vf[sl][dg], pf, outv[dg][cg]); }
                }
            }
#pragma unroll
            for (int cg = 0; cg < 2; ++cg) { const float gt = 1.0f / (1.0f + __expf(-gl[cg][0]));
#pragma unroll
                for (int dg = 0; dg < 4; ++dg) { const f32x4 ov = outv[dg][cg] * gt; v2u wv; wv.x = pk2(ov[0], ov[1]); wv.y = pk2(ov[2], ov[3]); oLp[(dg * 2 + cg) * 64] = wv; } }
        }
        LDS_WAIT(); asm volatile("" ::: "memory");
#if defined(PROBE_TK)
        for (int rep_ = 0; rep_ < 3; ++rep_)
#endif
        {
            const int tok = lane >> 3, j8 = lane & 7; float v[16];
#pragma unroll
            for (int k = 0; k < 16; ++k) { const int bb = 16 * j8 + k; const float x = impL[tok * 128 + bb]; v[k] = (bb >= 1 && bb <= cur - 2) ? x : -1.f; }
#pragma unroll
            for (int r = 0; r < 5; ++r) {
                float best = v[0]; int bi = 0;
#pragma unroll
                for (int k = 1; k < 16; ++k) if (v[k] > best) { best = v[k]; bi = k; }
                int gi = 16 * j8 + bi;
#pragma unroll
                for (int st_ = 0; st_ < 3; ++st_) { const float ov = st_ == 0 ? DPP_F(best, DPP_XOR1) : st_ == 1 ? DPP_F(best, DPP_XOR2) : DPP_F(best, DPP_HMIRROR);
                    const int oi = st_ == 0 ? DPP_I(gi, DPP_XOR1) : st_ == 1 ? DPP_I(gi, DPP_XOR2) : DPP_I(gi, DPP_HMIRROR); if (ov > best || (ov == best && oi < gi)) { best = ov; gi = oi; } }
                if (j8 == 0) selL[tok * 8 + r] = best >= 0.f ? gi : -1;
                if ((gi >> 4) == j8) {
#pragma unroll
                    for (int k = 0; k < 16; ++k) if ((gi & 15) == k) v[k] = -1.f; }
            }
        }
        LDS_WAIT(); asm volatile("" ::: "memory");
        int ent_b = -1; unsigned ent_idx = 0u, ent_val = 0u;
        if (lane < 40) { const int tok = lane / 5, r = lane - tok * 5, bb = selL[tok * 8 + r]; const size_t row = (size_t)(qrow + tok);
            if (bb >= 0) { ent_b = bb; ent_val = (unsigned)(t0 + tok) | ((unsigned)r << 16); }
            else {
#pragma unroll
                for (int h = 0; h < 4; ++h) { GAS float* mlp = partml + ((row * 6 + r) * 16 + g * 4 + h) * 2; mlp[0] = -1e30f; mlp[1] = 0.f; } } }
        {
            AttState st; att_init0(st);
            int lo[2] = {0, 0}, hi[2] = {tcol[0], tcol[1]};
            const int sw = 2 * n1 + nf;
            const int sa = nsteps - 3 > 2 * n1 ? nsteps - 3 : 2 * n1;
            const bool anyv = __any(ent_b >= 0);
#pragma unroll 1
            for (; s < nsteps; ++s) {
                if (s == sw) {
#pragma unroll
                    for (int cg = 0; cg < 2; ++cg) { float lt = st.l[cg]; lt = sum_x16_x32(lt); const size_t pi = ((size_t)(qrow + 4 * cg + tk4) * 6 + 5) * 16 + g * 4 + head;
                        if (rq == 0) { GAS float* mlp = partml + pi * 2; mlp[0] = st.m[cg]; mlp[1] = lt; }
#pragma unroll
                        for (int dg = 0; dg < 4; ++dg) { v2u wv; wv.x = pk2(st.o[dg][cg][0], st.o[dg][cg][1]); wv.y = pk2(st.o[dg][cg][2], st.o[dg][cg][3]); stg_put(wl, cg * 16 + col16, dg, rq, wv); } }
                    LDS_WAIT(); asm volatile("" ::: "memory");
                    { const int c_ = lane >> 1, tk_ = 4 * (c_ >> 4) + ((c_ & 15) >> 2), hd_ = c_ & 3; GAS bf16* pp = parto + ((((size_t)(qrow + tk_) * 6 + 5) * 16 + g * 4 + hd_) * 64) + (lane & 1) * 32;
#pragma unroll
                      for (int k = 0; k < 4; ++k) *(GAS v4u*)(pp + 8 * k) = stg_get(wl, lane, k); }
                    LDS_WAIT(); asm volatile("" ::: "memory");
                    att_init0(st); lo[0] = tcol[0] - 512; lo[1] = tcol[1] - 512;
                }
                STEP_HEAD(s); const LAS unsigned char* buf = ring + (s & 3) * 16384;
                if (s == sa && anyv) { if (ent_b >= 0) ent_idx = atomicAdd(cnt + ent_b * CNT_PAD, 1u); atom_out = true; }
                int blk, mode;
                if (s < sw) { const int fs = s - 2 * n1; blk = fs == 0 ? 0 : (fs == nf - 1 ? cur : cur - 1); mode = (blk == cur || blk == 0) ? 1 : 0; }
                else { blk = wb0 + (s - sw); mode = blk == cur ? 1 : (cur >= 8 && blk == wb0) ? 2 : 0; }
                if (mode == 1) att_block_lds<1>(buf, qf, 64 * blk, lo, hi, st, lane); else if (mode == 2) att_block_lds<2>(buf, qf, 64 * blk, lo, hi, st, lane); else att_block_lds<0>(buf, qf, 64 * blk, lo, hi, st, lane);
            }
            v2u ow[2][4];
#pragma unroll
            for (int cg = 0; cg < 2; ++cg) { float lt = st.l[cg]; lt = sum_x16_x32(lt); const float f = (1.0f / (1.0f + __expf(-gl[cg][2]))) / lt;
#pragma unroll
                for (int dg = 0; dg < 4; ++dg) { const v2u pv = oLp[(dg * 2 + cg) * 64]; const f32x4 ov = (f32x4){bflo(pv.x), bfhi(pv.x), bflo(pv.y), bfhi(pv.y)} + st.o[dg][cg] * f;
                    ow[cg][dg].x = pk2(ov[0], ov[1]); ow[cg][dg].y = pk2(ov[2], ov[3]); } }
            LDS_WAIT(); asm volatile("" ::: "memory");
#pragma unroll
            for (int cg = 0; cg < 2; ++cg)
#pragma unroll
                for (int dg = 0; dg < 4; ++dg) stg_put(wl, cg * 16 + col16, dg, rq, ow[cg][dg]);
            LDS_WAIT(); asm volatile("" ::: "memory");
            { const int c_ = lane >> 1, tk_ = 4 * (c_ >> 4) + ((c_ & 15) >> 2), hd_ = c_ & 3; GAS bf16* op = (GAS bf16*)O + (size_t)(qrow + tk_) * A1LD + (g * 4 + hd_) * 64 + (lane & 1) * 32;
#pragma unroll
              for (int k = 0; k < 4; ++k) *(GAS v4u*)(op + 8 * k) = stg_get(wl, lane, k); }
            LDS_WAIT(); asm volatile("" ::: "memory");
        }
        pend_b = ent_b; pend_idx = ent_idx; pend_val = ent_val;
#undef STEP_HEAD
#undef STEP_PTR
#undef ISSUE
    }
    if (pend_b >= 0) list[(size_t)pend_b * 8192 + pend_idx] = pend_val;
    asm volatile("s_waitcnt vmcnt(0) lgkmcnt(0)\n\ts_barrier" ::: "memory");
}
#ifndef MK_FUSED
#define MK_FUSED 1
#endif
constexpr int NPHASE = 26;
#ifndef MK_STREAMK
#define MK_STREAMK 0
#endif
#if MK_STREAMK
#define ORDER_T pg8::StreamOrder
#define ORDER_INIT(M_, N_, K_, G_, v_, slab_, fl_, tmo_, ep_) S.init(M_, N_, K_, G_, v_, slab_, fl_, tmo_, ep_)
#else
#define ORDER_T pg8::StaticOrder
#define ORDER_INIT(M_, N_, K_, G_, v_, slab_, fl_, tmo_, ep_) S.init(M_, N_, G_, (int)blockIdx.x, K_)
#endif
__global__ void __launch_bounds__(NWAVES * 64, 2) yoco_fwd(Args args) {
    extern __shared__ __attribute__((aligned(16))) unsigned char lds[];
    Frame F;
    F.lds = (LAS unsigned char*)lds;
    F.MISC = (volatile LAS unsigned*)(F.lds + MISC_OFF);
    const int tid0 = threadIdx.x; F.wave = __builtin_amdgcn_readfirstlane(tid0 >> 6);
    { const int bx = blockIdx.x; F.vcu = (bx % 8) * (GRID / 8) + bx / 8; }

    if (tid0 < 25) { const unsigned long long* ka = (const unsigned long long*)__builtin_amdgcn_kernarg_segment_ptr();
        *(LAS unsigned long long*)(F.lds + ARGS_OFF + 8 * tid0) = ka[tid0]; }
    if (tid0 < 128) ((LAS unsigned*)(F.lds + LDSCTL_OFF))[tid0] = 0u;
    __syncthreads();
    F.ctl = (gu32*)(AWS + WS_CTL);
    XcdBarrier bar; bar.bar = (unsigned*)(F.ctl + CW_BAR); bar.x = 0; bar.st = nullptr;
    if (MK_FUSED) bar = xcd_barrier_post((unsigned*)(F.ctl + CW_BAR), F.MISC + 8);
#if MK_FUSED
    constexpr int lo = 0, hi = NPHASE;
#else
    const int lo = args.ph_lo, hi = args.ph_hi;
#endif
#if MK_FUSED && !defined(MK_PHMASK)
#define IN(k) ((k) < NPHASE)
#else
#ifndef MK_PHMASK
#define MK_PHMASK 0x3ffffff
#endif
#define IN(k) (((MK_PHMASK >> ((k) < NPHASE ? (k) : 0)) & 1) && lo <= (k) && (k) < hi)
#endif
#ifndef PROBE_REP
#define PROBE_REP -1
#endif
#define NREP(k) ((k) == PROBE_REP ? 2 : 1)
#define NREP_S(k) ((k) + 100 == PROBE_REP ? 4 : 1)
#define SEAM(k) do { if (IN(k) && IN((k) + 1)) { XcdBarrier b2_ = bar; asm volatile("" : "+s"(b2_.bar), "+s"(b2_.x)); xcd_barrier(b2_); } } while (0)
#define PHASE_PTRS unsigned char* ws = AWS; float* Y = AOUT; \
    bf16* XB = (bf16*)(ws + WS_XB); float* SSQ0 = (float*)(ws + WS_SSQ); float* SSQ1 = SSQ0 + (size_t)M * 32; \
    bf16* ACT1 = (bf16*)(ws + WS_ACT1); bf16* BIG16 = (bf16*)(ws + WS_BIG); bf16* QGB = (bf16*)(ws + WS_QG); \
    (void)XB; (void)SSQ0; (void)SSQ1; (void)ACT1; (void)BIG16; (void)QGB; (void)Y;
    typedef pg8::EpiScaleBf16<0> EpiS0; typedef pg8::EpiScaleBf16<1> EpiS1;

    if (IN(0)) { for (int rep = 0; rep < NREP(0); ++rep) { p0_prologue(F); __syncthreads(); } } SEAM(0);

    for (int l = 0; l < 2; ++l) {
        const int pb = 1 + 5 * l;
        if (IN(pb)) { PHASE_PTRS const int EPOCH = 2 * (pb) + 1;
            pg8::Gemm g{XB, (const bf16*)(ws + WS_WIN) + (size_t)l * 3072 * WLD1, MP, 3072, D, XBLD, WLD1}; ORDER_T S; ORDER_INIT(MP, 3072, D, F.G, F.vcu, (float*)(ws + WS_SLAB + (size_t)(EPOCH & 1) * 64 * MiB), (unsigned*)F.ctl + CW_SLABF, (unsigned*)F.ctl + CW_TMO, (unsigned)(EPOCH));
            pg8::PreRstd<ORDER_T> PR{(LAS float*)(F.lds + RING_BYTES), SSQ0, &S, F.wave}; EpiS0 E{BIG16, BCXLD, (const LAS float*)(F.lds + RING_BYTES)};
            for (int rep = 0; rep < NREP(pb); ++rep) pg8::gemm_phase<EpiS0, ORDER_T, true, true, pg8::NoSide, pg8::PreRstd<ORDER_T>>(F.lds, g, S, E, F.wave, pg8::NoSide(), PR);
            { pg8::SEpiScaleBf16 SE{BIG16, BCXLD, SSQ0, 0}; pg8::sgemm_phase(F.lds, g.A, g.lda, g.Bt, g.ldb, D, 3072, MP, MS, SE, F.wave, F.vcu, F.G); }
        } SEAM(pb);
        if (IN(pb + 1)) { for (int rep = 0; rep < NREP(pb + 1); ++rep) conv_phase(F, l); } SEAM(pb + 1);
        if (IN(pb + 2)) { PHASE_PTRS const int EPOCH = 2 * (pb + 2) + 1;
            pg8::Gemm g{ACT1, (const bf16*)(ws + WS_WOUT) + (size_t)l * D * WLD1, MP, D, D, A1LD, WLD1}; ORDER_T S; ORDER_INIT(MP, D, D, F.G, F.vcu, (float*)(ws + WS_SLAB + (size_t)(EPOCH & 1) * 64 * MiB), (unsigned*)F.ctl + CW_SLABF, (unsigned*)F.ctl + CW_TMO, (unsigned)(EPOCH));
            pg8::EpiRes E{l == 0 ? AIN(0) : nullptr, l == 0 ? AIN(1) : nullptr, XB, nullptr, SSQ1};
            pg8::gemm_phase<pg8::EpiRes, ORDER_T, true, true>(F.lds, g, S, E, F.wave);
            { pg8::SEpiRes SE{l == 0 ? AIN(1) - (size_t)MP * D : nullptr, XB, nullptr, SSQ1}; pg8::sgemm_phase(F.lds, g.A, g.lda, g.Bt, g.ldb, D, D, MP, MS, SE, F.wave, F.vcu, F.G); }
        } SEAM(pb + 2);
        if (IN(pb + 3)) { PHASE_PTRS const int EPOCH = 2 * (pb + 3) + 1;
            pg8::Gemm g{XB, (const bf16*)(ws + WS_WUP) + (size_t)l * FF * WLD1, MP, FF, D, XBLD, WLD1}; ORDER_T S; ORDER_INIT(MP, FF, D, F.G, F.vcu, (float*)(ws + WS_SLAB + (size_t)(EPOCH & 1) * 64 * MiB), (unsigned*)F.ctl + CW_SLABF, (unsigned*)F.ctl + CW_TMO, (unsigned)(EPOCH));
            pg8::PreRstd<ORDER_T> PR{(LAS float*)(F.lds + RING_BYTES), SSQ1, &S, F.wave}; EpiS1 E{BIG16, HLD, (const LAS float*)(F.lds + RING_BYTES)};
            for (int rep = 0; rep < NREP(pb + 3); ++rep) pg8::gemm_phase<EpiS1, ORDER_T, true, true, pg8::NoSide, pg8::PreRstd<ORDER_T>>(F.lds, g, S, E, F.wave, pg8::NoSide(), PR);
            { pg8::SEpiScaleBf16 SE{BIG16, HLD, SSQ1, 1}; for (int rep = 0; rep < NREP_S(pb + 3); ++rep) pg8::sgemm_phase(F.lds, g.A, g.lda, g.Bt, g.ldb, D, FF, MP, MS, SE, F.wave, F.vcu, F.G); }
        } SEAM(pb + 3);
        if (IN(pb + 4)) { PHASE_PTRS const int EPOCH = 2 * (pb + 4) + 1;
            pg8::Gemm g{BIG16, (const bf16*)(ws + WS_WDN) + (size_t)l * D * WLD4, MP, D, FF, HLD, WLD4}; ORDER_T S; ORDER_INIT(MP, D, FF, F.G, F.vcu, (float*)(ws + WS_SLAB + (size_t)(EPOCH & 1) * 64 * MiB), (unsigned*)F.ctl + CW_SLABF, (unsigned*)F.ctl + CW_TMO, (unsigned)(EPOCH));
            pg8::EpiRes E{nullptr, nullptr, XB, nullptr, SSQ0};
            pg8::gemm_phase<pg8::EpiRes, ORDER_T, true, true>(F.lds, g, S, E, F.wave);
            { pg8::SEpiRes SE{nullptr, XB, nullptr, SSQ0}; pg8::sgemm_phase(F.lds, g.A, g.lda, g.Bt, g.ldb, FF, D, MP, MS, SE, F.wave, F.vcu, F.G); }
        } SEAM(pb + 4);
    }
    if (IN(11)) { PHASE_PTRS
        const int sv = (int)blockIdx.x >= 128 ? (int)blockIdx.x - 128 : (1 << 28), sG = 128;
        { const int EPOCH = 23; pg8::Gemm g{XB, (const bf16*)(ws + WS_WKV), MP, 1536, D, XBLD, WLD1}; ORDER_T S; ORDER_INIT(MP, 1536, D, F.G, F.vcu, (float*)(ws + WS_SLAB + (size_t)(EPOCH & 1) * 64 * MiB), (unsigned*)F.ctl + CW_SLABF, (unsigned*)F.ctl + CW_TMO, (unsigned)(EPOCH));
          pg8::PreRstd<ORDER_T> PR{(LAS float*)(F.lds + RING_BYTES), SSQ0, &S, F.wave}; pg8::EpiScaleF32 E{(float*)(ws + WS_BIG), KVRLD, (const LAS float*)(F.lds + RING_BYTES)};
          pg8::gemm_phase<pg8::EpiScaleF32, ORDER_T, true, true, pg8::NoSide, pg8::PreRstd<ORDER_T>>(F.lds, g, S, E, F.wave, pg8::NoSide(), PR);
          pg8::SEpiScaleF32 SE{(float*)(ws + WS_BIG), KVRLD, SSQ0}; pg8::sgemm_phase(F.lds, g.A, g.lda, g.Bt, g.ldb, D, 1536, MP, MS, SE, F.wave, sv, sG); }
        { const int EPOCH = 24; pg8::Gemm g{XB, (const bf16*)(ws + WS_WQG), MP, D, D, XBLD, WLD1}; ORDER_T S; ORDER_INIT(MP, D, D, F.G, F.vcu, (float*)(ws + WS_SLAB + (size_t)(EPOCH & 1) * 64 * MiB), (unsigned*)F.ctl + CW_SLABF, (unsigned*)F.ctl + CW_TMO, (unsigned)(EPOCH));
          pg8::PreRstd<ORDER_T> PR{(LAS float*)(F.lds + RING_BYTES), SSQ0, &S, F.wave}; EpiS0 E{QGB, QGLD, (const LAS float*)(F.lds + RING_BYTES)};
          pg8::gemm_phase<EpiS0, ORDER_T, true, true, pg8::NoSide, pg8::PreRstd<ORDER_T>>(F.lds, g, S, E, F.wave, pg8::NoSide(), PR);
          pg8::SEpiScaleBf16 SE{QGB, QGLD, SSQ0, 0}; pg8::sgemm_phase(F.lds, g.A, g.lda, g.Bt, g.ldb, D, D, MP, MS, SE, F.wave, sv, sG);
          pg8::SEpiScaleBf16 SG{QGB + 1024, QGLD, SSQ0, 0}; pg8::sgemm_phase(F.lds, g.A, g.lda, g.Bt + (size_t)1024 * WLD1, g.ldb, D, 64, 0, M, SG, F.wave, sv, sG); }
    } SEAM(11);
    if (IN(12)) { for (int rep = 0; rep < NREP(12); ++rep) kvfin_phase(F); } SEAM(12);
    for (int j = 0; j < 2; ++j) {
        const int pb = 13 + 7 * j;
        if (j == 1) {
            if (IN(19)) { PHASE_PTRS const int EPOCH = 2 * (19) + 1; pg8::Gemm g{XB, (const bf16*)(ws + WS_WQG) + (size_t)NQG * WLD1, MP, D, D, XBLD, WLD1}; ORDER_T S; ORDER_INIT(MP, D, D, F.G, F.vcu, (float*)(ws + WS_SLAB + (size_t)(EPOCH & 1) * 64 * MiB), (unsigned*)F.ctl + CW_SLABF, (unsigned*)F.ctl + CW_TMO, (unsigned)(EPOCH));
                pg8::PreRstd<ORDER_T> PR{(LAS float*)(F.lds + RING_BYTES), SSQ0, &S, F.wave}; EpiS0 E{QGB, QGLD, (const LAS float*)(F.lds + RING_BYTES)};
                pg8::gemm_phase<EpiS0, ORDER_T, true, true, pg8::NoSide, pg8::PreRstd<ORDER_T>>(F.lds, g, S, E, F.wave, pg8::NoSide(), PR);
                pg8::SEpiScaleBf16 SE{QGB, QGLD, SSQ0, 0}; pg8::sgemm_phase(F.lds, g.A, g.lda, g.Bt, g.ldb, D, D, MP, MS, SE, F.wave, F.vcu, F.G);
          pg8::SEpiScaleBf16 SG{QGB + 1024, QGLD, SSQ0, 0}; pg8::sgemm_phase(F.lds, g.A, g.lda, g.Bt + (size_t)1024 * WLD1, g.ldb, D, 64, 0, M, SG, F.wave, F.vcu, F.G); }
            SEAM(19);
        }
        const int pa = pb;
        if (IN(pa)) {
#if defined(PROBE_A1)
            attn_tile_phase(F, j);
            { XcdBarrier b2_ = bar; asm volatile("" : "+s"(b2_.bar), "+s"(b2_.x)); xcd_barrier(b2_); }
            { const int t_ = (int)blockIdx.x * 512 + F.wave * 64 + lane_id(); if (t_ < 1024) ((unsigned*)F.ctl + CW_CNT + j * 1024 * CNT_PAD)[t_ * CNT_PAD] = 0u; }
            { XcdBarrier b2_ = bar; asm volatile("" : "+s"(b2_.bar), "+s"(b2_.x)); xcd_barrier(b2_); }
#endif
            attn_tile_phase(F, j); } SEAM(pa);
        if (IN(pa + 1)) {
#if defined(PROBE_A2)
#if PROBE_A2 == 2
            attn_sparse_phase(F, j);
#else
            attn_sample_part(F, j); attn_sparse_phase(F, j);
#endif
            { XcdBarrier b2_ = bar; asm volatile("" : "+s"(b2_.bar), "+s"(b2_.x)); xcd_barrier(b2_); }
            { const int t_ = F.wave * 64 + lane_id(); if (blockIdx.x == 0 && t_ < 8) ((unsigned*)F.ctl + CW_DQ)[64 * (8 * j + t_)] = 0u; if (t_ == 0) ((LAS unsigned*)(F.lds + LDSCTL_OFF + 128))[2 + j] = 0u; }
            { XcdBarrier b2_ = bar; asm volatile("" : "+s"(b2_.bar), "+s"(b2_.x)); xcd_barrier(b2_); }
#endif
            attn_sample_part(F, j); attn_sparse_phase(F, j); } SEAM(pa + 1);
        if (IN(pa + 2)) {
#if defined(PROBE_ATT) && PROBE_ATT == 2
            attn_combine_phase(F, j, true);
#endif
            attn_combine_phase(F, j); } SEAM(pa + 2);
        const int l = 2 + j;
        if (IN(pa + 3)) { PHASE_PTRS const int EPOCH = 2 * (pa + 3) + 1;
            pg8::Gemm g{ACT1, (const bf16*)(ws + WS_WO) + (size_t)j * D * WLD1, MP, D, D, A1LD, WLD1}; ORDER_T S; ORDER_INIT(MP, D, D, F.G, F.vcu, (float*)(ws + WS_SLAB + (size_t)(EPOCH & 1) * 64 * MiB), (unsigned*)F.ctl + CW_SLABF, (unsigned*)F.ctl + CW_TMO, (unsigned)(EPOCH));
            pg8::EpiRes E{nullptr, nullptr, XB, nullptr, SSQ1};
            pg8::gemm_phase<pg8::EpiRes, ORDER_T, true, true>(F.lds, g, S, E, F.wave);
            { pg8::SEpiRes SE{nullptr, XB, nullptr, SSQ1}; pg8::sgemm_phase(F.lds, g.A, g.lda, g.Bt, g.ldb, D, D, MP, MS, SE, F.wave, F.vcu, F.G); }
        } SEAM(pa + 3);
        if (IN(pa + 4)) { PHASE_PTRS const int EPOCH = 2 * (pa + 4) + 1;
            pg8::Gemm g{XB, (const bf16*)(ws + WS_WUP) + (size_t)l * FF * WLD1, MP, FF, D, XBLD, WLD1}; ORDER_T S; ORDER_INIT(MP, FF, D, F.G, F.vcu, (float*)(ws + WS_SLAB + (size_t)(EPOCH & 1) * 64 * MiB), (unsigned*)F.ctl + CW_SLABF, (unsigned*)F.ctl + CW_TMO, (unsigned)(EPOCH));
            pg8::PreRstd<ORDER_T> PR{(LAS float*)(F.lds + RING_BYTES), SSQ1, &S, F.wave}; EpiS1 E{BIG16, HLD, (const LAS float*)(F.lds + RING_BYTES)};
            pg8::gemm_phase<EpiS1, ORDER_T, true, true, pg8::NoSide, pg8::PreRstd<ORDER_T>>(F.lds, g, S, E, F.wave, pg8::NoSide(), PR);
            { pg8::SEpiScaleBf16 SE{BIG16, HLD, SSQ1, 1}; pg8::sgemm_phase(F.lds, g.A, g.lda, g.Bt, g.ldb, D, FF, MP, MS, SE, F.wave, F.vcu, F.G); }
        } SEAM(pa + 4);
        if (IN(pa + 5)) { PHASE_PTRS const int EPOCH = 2 * (pa + 5) + 1;
            pg8::Gemm g{BIG16, (const bf16*)(ws + WS_WDN) + (size_t)l * D * WLD4, MP, D, FF, HLD, WLD4}; ORDER_T S; ORDER_INIT(MP, D, FF, F.G, F.vcu, (float*)(ws + WS_SLAB + (size_t)(EPOCH & 1) * 64 * MiB), (unsigned*)F.ctl + CW_SLABF, (unsigned*)F.ctl + CW_TMO, (unsigned)(EPOCH));
            pg8::EpiRes E{nullptr, nullptr, XB, j == 1 ? Y : nullptr, SSQ0};
            pg8::gemm_phase<pg8::EpiRes, ORDER_T, true, true>(F.lds, g, S, E, F.wave);
            { pg8::SEpiRes SE{nullptr, XB, j == 1 ? Y : nullptr, SSQ0}; pg8::sgemm_phase(F.lds, g.A, g.lda, g.Bt, g.ldb, FF, D, MP, MS, SE, F.wave, F.vcu, F.G); }
        } SEAM(pa + 5);
    }
#if defined(PROBE_BARS)
    for (int pbi = 0; pbi < PROBE_BARS; ++pbi) { XcdBarrier b2_ = bar; asm volatile("" : "+s"(b2_.bar), "+s"(b2_.x)); xcd_barrier(b2_); }
#endif
#undef IN
#undef SEAM
}

extern "C" void kernel_launch(void* const* d_in, const int* in_sizes, int n_in, void* d_out, int out_size, void* d_ws, size_t ws_size, hipStream_t stream) {
    static int grid = 0;
    if (grid == 0) {
        if (n_in != 22 || out_size != (int)O_END || ws_size < WS_END) { fprintf(stderr, "kernel_launch: unexpected shapes (n_in %d, out %d, ws %zu)\n", n_in, out_size, ws_size); grid = -1; return; }
        int dev = 0, cus = 0, per_cu = 0;
        if (hipGetDevice(&dev) != hipSuccess || hipDeviceGetAttribute(&cus, hipDeviceAttributeMultiprocessorCount, dev) != hipSuccess) { grid = -1; return; }
        if (hipFuncSetAttribute((const void*)yoco_fwd, hipFuncAttributeMaxDynamicSharedMemorySize, LDS_BYTES) != hipSuccess) { fprintf(stderr, "kernel_launch: hipFuncSetAttribute failed\n"); grid = -1; return; }
        if (hipOccupancyMaxActiveBlocksPerMultiprocessor(&per_cu, (const void*)yoco_fwd, NWAVES * 64, LDS_BYTES) != hipSuccess || per_cu < 1) fprintf(stderr, "kernel_launch: occupancy query reports %d blocks per CU\n", per_cu);
        (void)hipGetLastError();
        if (cus < GRID) { fprintf(stderr, "kernel_launch: needs %d CUs, device has %d\n", GRID, cus); grid = -1; return; }
        grid = GRID;
    }
    if (grid < 0) return;
    (void)hipMemsetAsync((char*)d_ws + WS_CTL, 0, CTL_ZERO_BYTES, stream);
    Args a{};
    for (int i = 0; i < 22; ++i) a.in[i] = (const float*)d_in[i];
    a.page_table = (const int*)d_in[6];
    a.out = (float*)d_out; a.ws = (unsigned char*)d_ws;
#if MK_FUSED
    a.ph_lo = 0; a.ph_hi = NPHASE;
    hipLaunchKernelGGL(yoco_fwd, dim3(grid), dim3(NWAVES * 64), LDS_BYTES, stream, a);
#else
    for (int p = 0; p < NPHASE; ++p) { a.ph_lo = p; a.ph_hi = p + 1; hipLaunchKernelGGL(yoco_fwd, dim3(grid), dim3(NWAVES * 64), LDS_BYTES, stream, a); }
#endif
}
```

```cpp
#include <hip/hip_runtime.h>
#include <cstdio>
#include <cstdint>
#include <cmath>
namespace pg8 {
#define PG8_LAS __attribute__((address_space(3)))
typedef unsigned short bf16_t;
typedef short bf16x8 __attribute__((ext_vector_type(8)));
typedef float f32x4 __attribute__((ext_vector_type(4)));
typedef unsigned u32x4 __attribute__((ext_vector_type(4)));
constexpr int BM = 256, BK = 64, HALF = 128, HTB = HALF * BK * 2  , STAGE_BYTES = 8 * HTB, NXCD = 8, WGM = 8;

__host__ __device__ __forceinline__ int lds_byte(int r, int c) { const int st = (r >> 4) * 2 + (c >> 5), rr = r & 15, cc = c & 31, ob = rr * 64 + cc * 2; return st * 1024 + (ob ^ (((ob >> 9) & 1) << 5)); }
__host__ __device__ __forceinline__ void stage_rc(int b, int& R, int& C) { const int st = b / 1024, sb = b % 1024, swz = sb ^ (((sb >> 9) & 1) << 5); R = (st >> 1) * 16 + swz / 64; C = (st & 1) * 32 + (swz % 64) / 2; }
__host__ __device__ __forceinline__ int perm32(int rho) { const int n = rho >> 4, i = rho & 15; return 8 * (i >> 2) + 4 * n + (i & 3); }

struct Unit { int pm, pn, kt0, nkt, kind, slab, ri; };
struct Gemm { const bf16_t* A; const bf16_t* Bt; int M, N, K, lda, ldb; };

struct StaticOrder {
    int nM, nN, nwg, G, c, nK;
    __host__ __device__ void init(int M, int N, int G_, int c_, int K = 1024) { nM = M / BM; nN = N / BM; nwg = nM * nN; G = G_; c = c_; nK = K / BK; }
    template <class A> __device__ __forceinline__ void slab_store(const A&, const Unit&, int, int) const {}
    __device__ __forceinline__ void acc_init(f32x4 (&acc)[2][2][4][2], const Unit&, int, int) const {
#pragma unroll
        for (int a = 0; a < 2; ++a)
#pragma unroll
            for (int b = 0; b < 2; ++b)
#pragma unroll
                for (int m = 0; m < 4; ++m)
#pragma unroll
                    for (int n = 0; n < 2; ++n) acc[a][b][m][n] = (f32x4){0.f, 0.f, 0.f, 0.f}; }

    __host__ __device__ bool next(int i, Unit& u) const {
        const long L = (long)i * G + c; if (L >= nwg) return false;
        int wgid = (int)L; { const int q = nwg / NXCD, r = nwg % NXCD, xcd = wgid % NXCD, off = wgid / NXCD; wgid = (xcd < r ? xcd * (q + 1) : r * (q + 1) + (xcd - r) * q) + off; }
        const int nig = WGM * nN, gid = wgid / nig, fm = gid * WGM, gsz = (nM - fm) < WGM ? (nM - fm) : WGM;
        u.pm = fm + ((wgid % nig) % gsz); u.pn = (wgid % nig) / gsz; u.kt0 = 0; u.nkt = nK; u.kind = 0; u.slab = 0; u.ri = i; return true;
    }
    __device__ __forceinline__ void a_ready(const Unit&) const {}
    __device__ __forceinline__ void done(const Unit&) const {}
};

__device__ __forceinline__ unsigned cvt_pk_bf16(float lo, float hi) { unsigned r; asm volatile("v_cvt_pk_bf16_f32 %0, %1, %2" : "=v"(r) : "v"(lo), "v"(hi)); return r; }
typedef float f32x2 __attribute__((ext_vector_type(2)));
constexpr int MPROMPT = 16384, XBLD = 1024;
#define PG8_GAS __attribute__((address_space(1)))
__device__ __forceinline__ float pg8_sum4rows(float x) {
    auto a = __builtin_amdgcn_permlane16_swap(__float_as_uint(x), __float_as_uint(x), false, false); x = __uint_as_float(a[0]) + __uint_as_float(a[1]);
    auto b = __builtin_amdgcn_permlane32_swap(__float_as_uint(x), __float_as_uint(x), false, false); return __uint_as_float(b[0]) + __uint_as_float(b[1]);
}
template <int NR>
__device__ __forceinline__ void rstd_rows(const float* ssq, int row0, int q4, float (&rs)[NR]) {
    const PG8_GAS f32x4* base = (const PG8_GAS f32x4*)ssq + 2 * q4;
    f32x4 t[NR][2];
#pragma unroll
    for (int i = 0; i < NR; ++i) { const PG8_GAS f32x4* p = base + (size_t)(row0 + 16 * i) * 8; t[i][0] = p[0]; t[i][1] = p[1]; }
#pragma unroll
    for (int i = 0; i < NR; ++i) { const f32x4 u = t[i][0] + t[i][1]; const float s = pg8_sum4rows((u[0] + u[1]) + (u[2] + u[3])); rs[i] = 1.0f / sqrtf(s * (1.0f / 1024.0f) + 1e-6f); }
}
template <class Sched>
__device__ __forceinline__ void prep_rstd(PG8_LAS float* rl, const float* ssq, const Sched& S, int wave_id) {
    int lane; asm volatile("v_mbcnt_lo_u32_b32 %0, -1, 0\n\tv_mbcnt_hi_u32_b32 %0, -1, %0" : "=v"(lane));
    const int t = wave_id * 64 + lane; Unit u;
#pragma unroll 1
    for (int i = 0; S.next(i, u); ++i) {
        if (t < 256) { const PG8_GAS f32x4* p = (const PG8_GAS f32x4*)ssq + (size_t)(u.pm * BM + t) * 8;
            f32x4 a = (p[0] + p[1]) + (p[2] + p[3]); a += (p[4] + p[5]) + (p[6] + p[7]);
            rl[i * 256 + t] = 1.0f / sqrtf(((a[0] + a[1]) + (a[2] + a[3])) * (1.0f / 1024.0f) + 1e-6f); }
    }
    __syncthreads();
}
template <class Sched> struct PreRstd { PG8_LAS float* rl; const float* ssq; const Sched* S; int wave_id;
    __device__ __forceinline__ void operator()() const { prep_rstd(rl, ssq, *S, wave_id); } };
template <int ACT> struct EpiScaleBf16 {
    static constexpr bool PERM = true, AFTER_DRAIN = false;
    bf16_t* O; int ldc; const PG8_LAS float* rl;
    __device__ __forceinline__ void operator()(const f32x4 (&acc)[2][2][4][2], const Unit& u, int wr, int wc, int fr, int fq) const {
        const int row0 = u.pm * BM + wr * 64 + fr, col0 = u.pn * BM + wc * 32 + 8 * fq;
        const PG8_LAS float* rp = rl + u.ri * 256 + wr * 64 + fr;
#pragma unroll
        for (int ai = 0; ai < 2; ++ai)
#pragma unroll
            for (int m = 0; m < 4; ++m) { const int row = row0 + ai * HALF + m * 16; const float r = rp[ai * HALF + m * 16]; PG8_GAS bf16_t* rowp = (PG8_GAS bf16_t*)O + (size_t)row * ldc + col0;
#pragma unroll
                for (int bj = 0; bj < 2; ++bj) { f32x4 v0 = acc[ai][bj][m][0] * r, v1 = acc[ai][bj][m][1] * r;
                    if (ACT == 1) {
#pragma unroll
                        for (int e = 0; e < 4; ++e) { const float a0 = fmaxf(v0[e], 0.f), a1 = fmaxf(v1[e], 0.f); v0[e] = a0 * a0; v1[e] = a1 * a1; } }
                    u32x4 w; w.x = cvt_pk_bf16(v0[0], v0[1]); w.y = cvt_pk_bf16(v0[2], v0[3]); w.z = cvt_pk_bf16(v1[0], v1[1]); w.w = cvt_pk_bf16(v1[2], v1[3]);
                    *(PG8_GAS u32x4*)(rowp + bj * HALF) = w; } }
    }
};
struct EpiScaleF32 {
    static constexpr bool PERM = false, AFTER_DRAIN = false;
    float* O; int ldc; const PG8_LAS float* rl;
    __device__ __forceinline__ void operator()(const f32x4 (&acc)[2][2][4][2], const Unit& u, int wr, int wc, int fr, int fq) const {
        const int row0 = u.pm * BM + wr * 64 + fr, col0 = u.pn * BM + wc * 32 + 4 * fq;
        const PG8_LAS float* rp = rl + u.ri * 256 + wr * 64 + fr;
#pragma unroll
        for (int ai = 0; ai < 2; ++ai)
#pragma unroll
            for (int m = 0; m < 4; ++m) { const int row = row0 + ai * HALF + m * 16; const float r = rp[ai * HALF + m * 16]; PG8_GAS float* rowp = (PG8_GAS float*)O + (size_t)row * ldc + col0;
#pragma unroll
                for (int bj = 0; bj < 2; ++bj)
#pragma unroll
                    for (int n = 0; n < 2; ++n) *(PG8_GAS f32x4*)(rowp + bj * HALF + n * 16) = acc[ai][bj][m][n] * r; }
    }
};
struct EpiRes {
    static constexpr bool PERM = false, AFTER_DRAIN = false;
    const float* base32_p; const float* base32_s; bf16_t* xb; float* out32; float* ssq_out;
    __device__ __forceinline__ void operator()(const f32x4 (&acc)[2][2][4][2], const Unit& u, int wr, int wc, int fr, int fq) const {
        typedef unsigned u32x2v __attribute__((ext_vector_type(2)));
        const int row0 = u.pm * BM + wr * 64 + fr, col0 = u.pn * BM + wc * 32 + 4 * fq;
#pragma unroll
        for (int ai = 0; ai < 2; ++ai)
            {
                f32x4 rv[4][2][2];
#pragma unroll
                for (int q = 0; q < 4; ++q) { const int row = row0 + ai * HALF + q * 16;
                    if (base32_p) { const PG8_GAS float* b = (const PG8_GAS float*)(row < MPROMPT ? base32_p + (size_t)row * 1024 : base32_s + (size_t)(row - MPROMPT) * 1024) + col0;
#pragma unroll
                        for (int bj = 0; bj < 2; ++bj)
#pragma unroll
                            for (int n = 0; n < 2; ++n) rv[q][bj][n] = *(const PG8_GAS f32x4*)(b + bj * HALF + n * 16);
                    } else { const PG8_GAS bf16_t* b = (const PG8_GAS bf16_t*)xb + (size_t)row * XBLD + col0;
#pragma unroll
                        for (int bj = 0; bj < 2; ++bj)
#pragma unroll
                            for (int n = 0; n < 2; ++n) { const u32x2v w = *(const PG8_GAS u32x2v*)(b + bj * HALF + n * 16);
                                rv[q][bj][n] = (f32x4){__uint_as_float(w.x << 16), __uint_as_float(w.x & 0xffff0000u), __uint_as_float(w.y << 16), __uint_as_float(w.y & 0xffff0000u)}; } } }
#pragma unroll
                for (int q = 0; q < 4; ++q) { const int m = q, row = row0 + ai * HALF + m * 16;
                    PG8_GAS bf16_t* xo = (PG8_GAS bf16_t*)xb + (size_t)row * XBLD + col0;
#pragma unroll
                    for (int bj = 0; bj < 2; ++bj) { float ss = 0.f;
#pragma unroll
                        for (int n = 0; n < 2; ++n) { const f32x4 x = rv[q][bj][n] + acc[ai][bj][m][n];
                            if (out32) *(PG8_GAS f32x4*)((PG8_GAS float*)out32 + (size_t)row * 1024 + col0 + bj * HALF + n * 16) = x;
                            else { ss += (x[0] * x[0] + x[1] * x[1]) + (x[2] * x[2] + x[3] * x[3]);
                                u32x2v w; w.x = cvt_pk_bf16(x[0], x[1]); w.y = cvt_pk_bf16(x[2], x[3]); *(PG8_GAS u32x2v*)(xo + bj * HALF + n * 16) = w; } }
                        if (!out32) { ss = pg8_sum4rows(ss);
                            if (fq == 0) ((PG8_GAS float*)ssq_out)[(size_t)row * 32 + u.pn * 8 + bj * 4 + wc] = ss; } } }
                asm volatile("" ::: "memory"); }
    }
};
struct StreamOrder {
    int nM, nN, nwg, np, lo, hi, u0, G, v, nstat, base;
    float* slab; unsigned* flags; unsigned* tmo; unsigned epoch;
    __device__ __forceinline__ int bound(int c) const { long b = (long)c * ((long)(nwg - base) * np) / G; const int r = (int)(b % np); if (r == 1) b -= 1; else if (r == np - 1) b += 1; return (int)b; }
    __device__ __forceinline__ void init(int M, int N, int K, int G_, int v_, float* slab_, unsigned* flags_, unsigned* tmo_, unsigned epoch_) {
        nM = M / BM; nN = N / BM; nwg = nM * nN; np = K / (2 * BK); G = G_; v = v_; nstat = nwg / G - 1; if (nstat < 0) nstat = 0; base = nstat * G;
        lo = bound(v); hi = bound(v + 1); u0 = lo / np; slab = slab_; flags = flags_; tmo = tmo_; epoch = epoch_; }
    __device__ __forceinline__ void unit_of(int L, Unit& u) const {
        const int nig = WGM * nN, gid = L / nig, fm = gid * WGM, gsz = (nM - fm) < WGM ? (nM - fm) : WGM;
        const int rem = L - gid * nig, gsh = gsz == WGM ? 3 : (gsz == 4 ? 2 : (gsz == 2 ? 1 : 0));
        u.pm = fm + (rem & (gsz - 1)); u.pn = rem >> gsh; }
    __device__ __forceinline__ bool next(int i, Unit& u) const {
        if (i < nstat) { unit_of(i * G + v, u); u.kt0 = 0; u.nkt = 2 * np; u.kind = 0; u.slab = 0; u.ri = i; return true; }
        const int Lr = u0 + (i - nstat), s0 = Lr * np, L = base + Lr; if (L >= nwg) return false;
        const int p0 = (lo > s0 ? lo : s0) - s0, p1 = (hi < s0 + np ? hi : s0 + np) - s0; if (p1 <= p0) return false;
        unit_of(L, u); u.kt0 = 2 * p0; u.nkt = 2 * (p1 - p0);
        u.kind = p0 > 0 ? 1 : (p1 < np ? 2 : 0); u.slab = p0 > 0 ? v : v + 1; u.ri = i; return true;
    }
    __device__ __forceinline__ void a_ready(const Unit&) const {}
    __device__ __forceinline__ void done(const Unit&) const {}
    __device__ __forceinline__ void slab_store(const f32x4 (&acc)[2][2][4][2], const Unit& u, int wid, int lane) const {
        const __amdgpu_buffer_rsrc_t rs = __builtin_amdgcn_make_buffer_rsrc(slab, 0, G * 8 * 32 * 1024, 0x00020000);
        const unsigned so = (unsigned)((u.slab * 8 + wid) * 32) * 1024u, vo = (unsigned)lane * 16u;
#pragma unroll
        for (int a = 0; a < 2; ++a)
#pragma unroll
            for (int b = 0; b < 2; ++b)
#pragma unroll
                for (int m = 0; m < 4; ++m)
#pragma unroll
                    for (int n = 0; n < 2; ++n) __builtin_amdgcn_raw_buffer_store_b128(__builtin_bit_cast(u32x4, acc[a][b][m][n]), rs, vo + (unsigned)(((a * 2 + b) * 4 + m) * 2 + n) * 1024u, so,   16);
        asm volatile("s_waitcnt vmcnt(0)" ::: "memory");
        if (lane == 0) __hip_atomic_store(flags + 64 * u.slab + wid, epoch, __ATOMIC_RELAXED, __HIP_MEMORY_SCOPE_AGENT);
    }
    __device__ __forceinline__ void acc_init(f32x4 (&acc)[2][2][4][2], const Unit& u, int wid, int lane) const {
#pragma unroll
        for (int a = 0; a < 2; ++a)
#pragma unroll
            for (int b = 0; b < 2; ++b)
#pragma unroll
                for (int m = 0; m < 4; ++m)
#pragma unroll
                    for (int n = 0; n < 2; ++n) acc[a][b][m][n] = (f32x4){0.f, 0.f, 0.f, 0.f};
        if (u.kind != 2) return;
        unsigned* fw = flags + 64 * u.slab + wid; unsigned sp = 0;
        while ((unsigned)__builtin_amdgcn_readfirstlane(__hip_atomic_load(fw, __ATOMIC_RELAXED, __HIP_MEMORY_SCOPE_AGENT)) < epoch) {
            __builtin_amdgcn_s_sleep(2);
            if ((++sp & 255u) == 0u) { if (__hip_atomic_load(tmo, __ATOMIC_RELAXED, __HIP_MEMORY_SCOPE_AGENT) != 0u) break; if (sp > (1u << 20)) { if (lane == 0) __hip_atomic_store(tmo, 1u, __ATOMIC_RELAXED, __HIP_MEMORY_SCOPE_AGENT); break; } }
        }
        __builtin_amdgcn_fence(__ATOMIC_ACQUIRE, "agent");
        asm volatile("s_waitcnt vmcnt(0)" ::: "memory");
        const __amdgpu_buffer_rsrc_t rs = __builtin_amdgcn_make_buffer_rsrc(slab, 0, G * 8 * 32 * 1024, 0x00020000);
        const unsigned so = (unsigned)((u.slab * 8 + wid) * 32) * 1024u, vo = (unsigned)lane * 16u;
#pragma unroll
        for (int a = 0; a < 2; ++a)
#pragma unroll
            for (int b = 0; b < 2; ++b)
#pragma unroll
                for (int m = 0; m < 4; ++m)
#pragma unroll
                    for (int n = 0; n < 2; ++n) acc[a][b][m][n] = __builtin_bit_cast(f32x4, __builtin_amdgcn_raw_buffer_load_b128(rs, vo, so + (unsigned)(((a * 2 + b) * 4 + m) * 2 + n) * 1024u, 0));
    }
};
struct SEpiScaleBf16 { bf16_t* O; int ldc; const float* ssq; int act;
    __device__ __forceinline__ void operator()(const f32x4 (&acc)[2][2], int row0, int col0, int lane) const {
        typedef unsigned u32x2v __attribute__((ext_vector_type(2)));
        float rs[2]; rstd_rows<2>(ssq, row0 + (lane & 15), lane >> 4, rs);
#pragma unroll
        for (int mi = 0; mi < 2; ++mi) { const int row = row0 + 16 * mi + (lane & 15);
#pragma unroll
            for (int ni = 0; ni < 2; ++ni) { f32x4 v = acc[mi][ni] * rs[mi];
                if (act) {
#pragma unroll
                    for (int e = 0; e < 4; ++e) { const float a = fmaxf(v[e], 0.f); v[e] = a * a; } }
                u32x2v w; w.x = cvt_pk_bf16(v[0], v[1]); w.y = cvt_pk_bf16(v[2], v[3]); *(PG8_GAS u32x2v*)((PG8_GAS bf16_t*)O + (size_t)row * ldc + col0 + 16 * ni + 4 * (lane >> 4)) = w; } }
    }
};
struct SEpiScaleF32 { float* O; int ldc; const float* ssq;
    __device__ __forceinline__ void operator()(const f32x4 (&acc)[2][2], int row0, int col0, int lane) const {
        float rs[2]; rstd_rows<2>(ssq, row0 + (lane & 15), lane >> 4, rs);
#pragma unroll
        for (int mi = 0; mi < 2; ++mi) { const int row = row0 + 16 * mi + (lane & 15);
#pragma unroll
            for (int ni = 0; ni < 2; ++ni) *(PG8_GAS f32x4*)((PG8_GAS float*)O + (size_t)row * ldc + col0 + 16 * ni + 4 * (lane >> 4)) = acc[mi][ni] * rs[mi]; }
    }
};
struct SEpiRes { const float* base32; bf16_t* xb; float* out32; float* ssq_out;
    __device__ __forceinline__ void operator()(const f32x4 (&acc)[2][2], int row0, int col0, int lane) const {
        typedef unsigned u32x2v __attribute__((ext_vector_type(2)));
        f32x4 rv[2][2];
#pragma unroll
        for (int mi = 0; mi < 2; ++mi)
#pragma unroll
            for (int ni = 0; ni < 2; ++ni) { const int row = row0 + 16 * mi + (lane & 15), col = col0 + 16 * ni + 4 * (lane >> 4);
                if (base32) rv[mi][ni] = *(const PG8_GAS f32x4*)((const PG8_GAS float*)base32 + (size_t)row * 1024 + col);
                else { const u32x2v w = *(const PG8_GAS u32x2v*)((const PG8_GAS bf16_t*)xb + (size_t)row * XBLD + col);
                    rv[mi][ni] = (f32x4){__uint_as_float(w.x << 16), __uint_as_float(w.x & 0xffff0000u), __uint_as_float(w.y << 16), __uint_as_float(w.y & 0xffff0000u)}; } }
#pragma unroll
        for (int mi = 0; mi < 2; ++mi) { const int row = row0 + 16 * mi + (lane & 15); float ss = 0.f;
#pragma unroll
            for (int ni = 0; ni < 2; ++ni) { const int col = col0 + 16 * ni + 4 * (lane >> 4);
                const f32x4 x = rv[mi][ni] + acc[mi][ni];
                if (out32) *(PG8_GAS f32x4*)((PG8_GAS float*)out32 + (size_t)row * 1024 + col) = x;
                else { ss += (x[0] * x[0] + x[1] * x[1]) + (x[2] * x[2] + x[3] * x[3]);
                    u32x2v w; w.x = cvt_pk_bf16(x[0], x[1]); w.y = cvt_pk_bf16(x[2], x[3]); *(PG8_GAS u32x2v*)((PG8_GAS bf16_t*)xb + (size_t)row * XBLD + col) = w; } }
            if (!out32) { ss = pg8_sum4rows(ss);
                if ((lane >> 4) == 0) ((PG8_GAS float*)ssq_out)[(size_t)row * 32 + (col0 >> 5)] = ss; } }
    }
};
template <class Epi>
__device__ __forceinline__ void sgemm_phase(PG8_LAS unsigned char* lds, const bf16_t* A, int lda, const bf16_t* Bt, int ldb, int K, int N, int row_base, int nrows, const Epi& E, int wave_id, int vcu, int G) {
    int lane; asm volatile("v_mbcnt_lo_u32_b32 %0, -1, 0\n\tv_mbcnt_hi_u32_b32 %0, -1, %0" : "=v"(lane));
    const int tid = wave_id * 64 + lane;
    const int wr = wave_id & 1, wc = (wave_id >> 1) & 1, wk = wave_id >> 2, m16 = lane & 15, kq = lane >> 4;
    const int tm = nrows / 64, ntile = tm * (N / 64), nch = K / 128;
    constexpr int PITCH = 272, MATB = 64 * PITCH, BUFB = 2 * MATB;
    PG8_LAS f32x4* red = (PG8_LAS f32x4*)(lds + 2 * BUFB) + (wave_id & 3) * 256 + lane;
    const int lr = tid >> 4, lc = tid & 15;
    const unsigned wofs = (unsigned)(lr * PITCH + lc * 16);
    const unsigned aofs = (unsigned)((32 * wr + m16) * PITCH + wk * 128 + kq * 16), bofs = (unsigned)(MATB + (32 * wc + m16) * PITCH + wk * 128 + kq * 16);
#pragma unroll 1
    for (int t = vcu; t < ntile; t += G) {
        const int rm = t % tm, cn = t / tm, trow = row_base + rm * 64, tcol = cn * 64;
        const PG8_GAS bf16_t* ag = (const PG8_GAS bf16_t*)A + (size_t)(trow + lr) * lda + lc * 8;
        const PG8_GAS bf16_t* bg = (const PG8_GAS bf16_t*)Bt + (size_t)(tcol + lr) * ldb + lc * 8;
        const size_t r32a = (size_t)32 * lda, r32b = (size_t)32 * ldb;
        f32x4 acc[2][2];
#pragma unroll
        for (int mi = 0; mi < 2; ++mi)
#pragma unroll
            for (int ni = 0; ni < 2; ++ni) acc[mi][ni] = (f32x4){0.f, 0.f, 0.f, 0.f};
        u32x4 ring[4][4];
#define SG_ISSUE(slot, c) do { ring[slot][0] = *(const PG8_GAS u32x4*)(ag + (c) * 128); ring[slot][1] = *(const PG8_GAS u32x4*)(ag + r32a + (c) * 128); \
                               ring[slot][2] = *(const PG8_GAS u32x4*)(bg + (c) * 128); ring[slot][3] = *(const PG8_GAS u32x4*)(bg + r32b + (c) * 128); } while (0)
        SG_ISSUE(0, 0); SG_ISSUE(1, 1); SG_ISSUE(2, 2);
#pragma unroll 1
        for (int c0 = 0; c0 < nch; c0 += 4) {
#pragma unroll
            for (int j = 0; j < 4; ++j) { const int c = c0 + j;
                if (c + 3 < nch) SG_ISSUE((j + 3) & 3, c + 3);
                PG8_LAS unsigned char* buf = lds + (j & 1) * BUFB;
                *(PG8_LAS u32x4*)(buf + wofs) = ring[j][0]; *(PG8_LAS u32x4*)(buf + wofs + 32 * PITCH) = ring[j][1];
                *(PG8_LAS u32x4*)(buf + MATB + wofs) = ring[j][2]; *(PG8_LAS u32x4*)(buf + MATB + wofs + 32 * PITCH) = ring[j][3];
                __syncthreads();
                bf16x8 af[2][2], bf[2][2];
#pragma unroll
                for (int ks = 0; ks < 2; ++ks)
#pragma unroll
                    for (int h = 0; h < 2; ++h) { af[ks][h] = *(const PG8_LAS bf16x8*)(buf + aofs + h * 16 * PITCH + ks * 64); bf[ks][h] = *(const PG8_LAS bf16x8*)(buf + bofs + h * 16 * PITCH + ks * 64); }
#pragma unroll
                for (int ks = 0; ks < 2; ++ks)
#pragma unroll
                    for (int mi = 0; mi < 2; ++mi)
#pragma unroll
                        for (int ni = 0; ni < 2; ++ni) acc[mi][ni] = __builtin_amdgcn_mfma_f32_16x16x32_bf16(bf[ks][ni], af[ks][mi], acc[mi][ni], 0, 0, 0);
            }
        }
#undef SG_ISSUE
        if (wk == 1) {
#pragma unroll
            for (int mi = 0; mi < 2; ++mi)
#pragma unroll
                for (int ni = 0; ni < 2; ++ni) red[(mi * 2 + ni) * 64] = acc[mi][ni]; }
        __syncthreads();
        if (wk == 0) {
#pragma unroll
            for (int mi = 0; mi < 2; ++mi)
#pragma unroll
                for (int ni = 0; ni < 2; ++ni) acc[mi][ni] += red[(mi * 2 + ni) * 64];
            E(acc, trow + 32 * wr, tcol + 32 * wc, lane); }
        __syncthreads();
    }
}
struct NoSide { __device__ __forceinline__ void operator()(int, int, int) const {} };
struct NoPre { __device__ __forceinline__ void operator()() const {} };
template <class Epi, class Sched, bool ALIGN_EPI = false, bool SP2 = false, class Side = NoSide, class Pre = NoPre>
__device__ __forceinline__ void gemm_phase(PG8_LAS unsigned char* lds, const Gemm g, const Sched& S, const Epi& E, int wave_id, const Side& W = Side(), const Pre& P = Pre()) {
    int tid_; asm volatile("v_mbcnt_lo_u32_b32 %0, -1, 0\n\tv_mbcnt_hi_u32_b32 %0, -1, %0" : "=v"(tid_)); tid_ += wave_id * 64;
    const int tid = tid_, wid = __builtin_amdgcn_readfirstlane(tid >> 6), lane = tid & 63, wr = wid >> 2, wc = wid & 3, fr = lane & 15, fq = lane >> 4;
    const int K = g.K; int nt;
    unsigned voffA[2], voffB[2];
#pragma unroll
    for (int i = 0; i < 2; ++i) { int R, C; stage_rc(tid * 16 + i * 8192, R, C); const int Rb = Epi::PERM ? ((R & ~31) + perm32(R & 31)) : R;
        voffA[i] = (unsigned)(R * g.lda + C) * 2u; voffB[i] = (unsigned)(Rb * g.ldb + C) * 2u; }
    const size_t kstep = (size_t)(BK * 2);
    const size_t hstepA = (size_t)HALF * g.lda * 2, hstepB = (size_t)HALF * g.ldb * 2;
    const size_t tstepA = 2 * hstepA, tstepB = 2 * hstepB;
    const unsigned ldsw = (unsigned)wid * 1024u;
    const int aoff = lds_byte(wr * 64 + fr, fq * 8), boff = lds_byte(wc * 32 + fr, fq * 8);
#define PG8_SA(b, h) (((b) * 2 + (h)) * HTB)
#define PG8_SB(b, h) ((4 + (b) * 2 + (h)) * HTB)
#define PG8_STAGE(bufoff, gbase, voff) do { _Pragma("unroll") for (int _i = 0; _i < 2; ++_i) \
        __builtin_amdgcn_global_load_lds((const unsigned*)((const char*)(gbase) + (voff)[_i]), (PG8_LAS unsigned*)(lds + (bufoff) + ldsw + _i * 8192), 16, 0, 0); } while (0)
#define PG8_LDA(dst, b, h) do { _Pragma("unroll") for (int m = 0; m < 4; ++m) _Pragma("unroll") for (int k = 0; k < 2; ++k) dst[m][k] = *(const PG8_LAS bf16x8*)(lds + PG8_SA(b, h) + aoff + m * 2048 + k * 1024); } while (0)
#define PG8_LDB(dst, b, h) do { _Pragma("unroll") for (int n = 0; n < 2; ++n) _Pragma("unroll") for (int k = 0; k < 2; ++k) dst[n][k] = *(const PG8_LAS bf16x8*)(lds + PG8_SB(b, h) + boff + n * 2048 + k * 1024); } while (0)
#define PG8_MMA(ai, bj, At, Bt) do { __builtin_amdgcn_s_setprio(1); _Pragma("unroll") for (int m = 0; m < 4; ++m) _Pragma("unroll") for (int n = 0; n < 2; ++n) _Pragma("unroll") for (int k = 0; k < 2; ++k) \
        acc[ai][bj][m][n] = __builtin_amdgcn_mfma_f32_16x16x32_bf16(Bt[n][k], At[m][k], acc[ai][bj][m][n], 0, 0, 0); __builtin_amdgcn_s_setprio(0); } while (0)
#define PG8_WAIT_V(n) asm volatile("s_waitcnt vmcnt(" #n ")" ::: "memory")
#define PG8_WAIT_L(n) asm volatile("s_waitcnt lgkmcnt(" #n ")" ::: "memory")
#define PG8_BAR __builtin_amdgcn_s_barrier()
#define PG8_SCHED __builtin_amdgcn_sched_barrier(0)
    Unit cur, nxt; int ui = 0;
    if (!S.next(0, cur)) return;
    nt = cur.nkt;
    f32x4 acc[2][2][4][2];
    S.acc_init(acc, cur, wid, lane);
    bf16x8 At[4][2], B0[2][2], B1[2][2];
    const char* cA = (const char*)g.A + (size_t)cur.pm * tstepA + (size_t)cur.kt0 * kstep; const char* cB = (const char*)g.Bt + (size_t)cur.pn * tstepB + (size_t)cur.kt0 * kstep;
    S.a_ready(cur);
    if constexpr (SP2) {
        PG8_STAGE(PG8_SB(0, 0), cB, voffB); PG8_STAGE(PG8_SB(0, 1), cB + hstepB, voffB); PG8_STAGE(PG8_SA(0, 0), cA, voffA); PG8_STAGE(PG8_SA(0, 1), cA + hstepA, voffA);
        P();
        if (wr == 1) PG8_BAR;
        PG8_WAIT_V(2); PG8_BAR;
        PG8_STAGE(PG8_SB(1, 0), cB + kstep, voffB); PG8_STAGE(PG8_SA(1, 0), cA + kstep, voffA); PG8_STAGE(PG8_SB(1, 1), cB + hstepB + kstep, voffB);
        PG8_WAIT_V(6); PG8_BAR;
    } else {
        PG8_STAGE(PG8_SB(0, 0), cB, voffB); PG8_STAGE(PG8_SA(0, 0), cA, voffA); PG8_STAGE(PG8_SB(0, 1), cB + hstepB, voffB); PG8_STAGE(PG8_SA(0, 1), cA + hstepA, voffA);
        P();
        if (wr == 1) PG8_BAR;
        PG8_WAIT_V(4); PG8_BAR;
        PG8_STAGE(PG8_SB(1, 0), cB + kstep, voffB); PG8_STAGE(PG8_SA(1, 0), cA + kstep, voffA); PG8_STAGE(PG8_SB(1, 1), cB + hstepB + kstep, voffB);
        PG8_WAIT_V(6); PG8_BAR;
    }
    for (;;) {
        const bool has_next = S.next(ui + 1, nxt);
        const char* nA = has_next ? (const char*)g.A + (size_t)nxt.pm * tstepA + (size_t)nxt.kt0 * kstep : cA; const char* nB = has_next ? (const char*)g.Bt + (size_t)nxt.pn * tstepB + (size_t)nxt.kt0 * kstep : cB;
        for (int t = 0; t < nt; t += 2) {
            const bool last = (t == nt - 2);
            const char* a1 = cA + (size_t)(t + 1) * kstep;
            const char* a2 = last ? nA : cA + (size_t)(t + 2) * kstep; const char* b2 = last ? nB : cB + (size_t)(t + 2) * kstep;
            const char* a3 = a2 + kstep; const char* b3 = b2 + kstep;
            if (last && has_next) S.a_ready(nxt);
            if constexpr (SP2) {
            PG8_LDB(B0, 0, 0); PG8_LDB(B1, 0, 1); PG8_SCHED; PG8_LDA(At, 0, 0); PG8_STAGE(PG8_SA(1, 1), a1 + hstepA, voffA);
            PG8_WAIT_V(8); PG8_WAIT_L(0); PG8_BAR; PG8_MMA(0, 0, At, B0); PG8_MMA(0, 1, At, B1); PG8_BAR; PG8_SCHED;
            PG8_LDA(At, 0, 1); PG8_STAGE(PG8_SB(0, 0), b2, voffB); PG8_STAGE(PG8_SB(0, 1), b2 + hstepB, voffB); PG8_STAGE(PG8_SA(0, 0), a2, voffA);
            PG8_WAIT_V(8); PG8_WAIT_L(0); PG8_BAR; PG8_MMA(1, 0, At, B0); PG8_MMA(1, 1, At, B1); PG8_BAR; PG8_SCHED;
            PG8_LDB(B0, 1, 0); PG8_LDB(B1, 1, 1); PG8_SCHED; PG8_LDA(At, 1, 0); PG8_STAGE(PG8_SA(0, 1), a2 + hstepA, voffA);
            PG8_WAIT_V(8); PG8_WAIT_L(0); PG8_BAR; PG8_MMA(0, 0, At, B0); PG8_MMA(0, 1, At, B1); PG8_BAR; PG8_SCHED;
            PG8_LDA(At, 1, 1); PG8_STAGE(PG8_SB(1, 0), b3, voffB); PG8_STAGE(PG8_SB(1, 1), b3 + hstepB, voffB); PG8_STAGE(PG8_SA(1, 0), a3, voffA);
            PG8_WAIT_V(8); PG8_WAIT_L(0); PG8_BAR; PG8_MMA(1, 0, At, B0); PG8_MMA(1, 1, At, B1); PG8_BAR; PG8_SCHED;
            } else {
            PG8_LDB(B0, 0, 0); PG8_SCHED; PG8_LDA(At, 0, 0); PG8_STAGE(PG8_SA(1, 1), a1 + hstepA, voffA);
            PG8_WAIT_L(8); PG8_BAR; PG8_WAIT_L(0); PG8_MMA(0, 0, At, B0); PG8_BAR; PG8_SCHED;
            PG8_LDB(B1, 0, 1); PG8_STAGE(PG8_SB(0, 0), b2, voffB);
            PG8_BAR; PG8_WAIT_L(0); PG8_MMA(0, 1, At, B1); PG8_BAR;
            PG8_LDA(At, 0, 1); PG8_STAGE(PG8_SA(0, 0), a2, voffA);
            PG8_BAR; PG8_WAIT_L(0); PG8_MMA(1, 0, At, B0); PG8_BAR; PG8_SCHED;
            PG8_STAGE(PG8_SB(0, 1), b2 + hstepB, voffB);
            PG8_WAIT_V(6); PG8_BAR; PG8_MMA(1, 1, At, B1); PG8_BAR;
            PG8_LDB(B0, 1, 0); PG8_SCHED; PG8_LDA(At, 1, 0); PG8_STAGE(PG8_SA(0, 1), a2 + hstepA, voffA);
            PG8_WAIT_L(8); PG8_BAR; PG8_WAIT_L(0); PG8_MMA(0, 0, At, B0); PG8_BAR; PG8_SCHED;
            PG8_LDB(B1, 1, 1); PG8_STAGE(PG8_SB(1, 0), b3, voffB);
            PG8_BAR; PG8_WAIT_L(0); PG8_MMA(0, 1, At, B1); PG8_BAR;
            PG8_LDA(At, 1, 1); PG8_STAGE(PG8_SA(1, 0), a3, voffA);
            PG8_BAR; PG8_WAIT_L(0); PG8_MMA(1, 0, At, B0); PG8_BAR; PG8_SCHED;
            PG8_STAGE(PG8_SB(1, 1), b3 + hstepB, voffB);
            PG8_WAIT_V(6); PG8_BAR; PG8_MMA(1, 1, At, B1); PG8_BAR;
            }
        }
        if constexpr (ALIGN_EPI) { if (wr == 0) PG8_BAR; }
        if constexpr (!Epi::AFTER_DRAIN) {
            if (cur.kind == 1) S.slab_store(acc, cur, wid, lane);
            else E(acc, cur, wr, wc, fr, fq);
#ifdef PROBE_EPI2
            if constexpr (Epi::PERM || sizeof(Epi) == 16) { asm volatile("" ::: "memory"); E(acc, cur, wr, wc, fr, fq); }
#endif
            S.done(cur); W(ui, wid, lane); }
        if (!has_next) break;
        S.acc_init(acc, nxt, wid, lane);
        cur = nxt; cA = nA; cB = nB; ++ui; nt = cur.nkt;
        if constexpr (ALIGN_EPI) { if (wr == 1) PG8_BAR; }
    }
    PG8_WAIT_V(0);
    if constexpr (!ALIGN_EPI) { if (wr == 0) PG8_BAR; }
    PG8_BAR;
    if constexpr (Epi::AFTER_DRAIN) { E.fused(acc, cur, wr, wc, fr, fq, lds, wid, lane); S.done(cur); }
#undef PG8_SA
#undef PG8_SB
#undef PG8_STAGE
#undef PG8_LDA
#undef PG8_LDB
#undef PG8_MMA
#undef PG8_WAIT_V
#undef PG8_WAIT_L
#undef PG8_BAR
#undef PG8_SCHED
}
}
constexpr int NWAVES = 8;
constexpr int GRID = 256;
constexpr int D = 1024, FF = 4096, MP = 16384, MS = 1024, M = MP + MS;
constexpr int SEQ = 8192, NSEQ_S = 128, PAST = 2048;
constexpr int XBLD = pg8::XBLD, A1LD = 1024, HLD = 4096, KVRLD = 1536, QGLD = 1280, WLD1 = 1024, WLD4 = 4096;
constexpr int BCXLD = 3072;
constexpr int NQG = 1280;
constexpr float EPS = 1e-6f;
constexpr size_t MiB = 1u << 20;
constexpr int FRAGB = 16384;

constexpr size_t WS_CTL = 0, CTL_ZERO_BYTES = 1 * MiB;
constexpr size_t WS_WIN = 2 * MiB;
constexpr size_t WS_WOUT = WS_WIN + 13 * MiB;
constexpr size_t WS_WKV = WS_WOUT + 5 * MiB;
constexpr size_t WS_WQG = WS_WKV + 4 * MiB;
constexpr size_t WS_WO = WS_WQG + 6 * MiB;
constexpr size_t WS_WUP = WS_WO + 5 * MiB;
constexpr size_t WS_WDN = WS_WUP + 35 * MiB;
constexpr size_t WS_XB = WS_WDN + 34 * MiB;
constexpr size_t WS_SSQ = WS_XB + 37 * MiB;
constexpr size_t WS_ACT1 = WS_SSQ + 6 * MiB;
constexpr size_t WS_QG = WS_ACT1 + 37 * MiB;
constexpr size_t WS_BIG = WS_QG + 46 * MiB;
constexpr size_t WS_SLCP = WS_BIG + 140 * MiB;
constexpr size_t WS_WINP = WS_SLCP + 16 * MiB;
constexpr size_t WS_CMPP = WS_WINP + 16 * MiB;
constexpr size_t WS_CMPS = WS_CMPP + 1 * MiB;
constexpr size_t WS_WINS = WS_CMPS + 8 * MiB;
constexpr size_t WS_SLCS = WS_WINS + 72 * MiB;
constexpr size_t WS_SLAB = WS_SLCS + 264 * MiB;
constexpr size_t WS_LIST = WS_SLAB + 128 * MiB;
constexpr size_t WS_PARTO = WS_LIST + 32 * MiB;
constexpr size_t WS_PARTML = WS_PARTO + 192 * MiB;
constexpr size_t WS_END = WS_PARTML + 12 * MiB;
constexpr int CW_BAR = 4096, CW_TMO = 64, CW_SLABF = 8192, CW_CNT = 65536, CW_DQ = 36864, CNT_PAD = 16;

constexpr size_t O_Y = 0, O_PCMP = 17825792, O_PSLC = 26214400, O_PWIN = 34603008, O_PCONV = 35127296, O_SCMP = 35135488, O_SSLC = 35659776, O_SWIN = 36184064, O_SCONV = 69738496, O_END = 70262784;

constexpr int RING_BYTES = 131072;
constexpr int WLDS_BYTES = 18432;
constexpr int LDSCTL_OFF = 147456, MISC_OFF = LDSCTL_OFF + 320;
constexpr int LDS_BYTES = 147456 + 1024;

#define GAS __attribute__((address_space(1)))
#define LAS __attribute__((address_space(3)))
typedef unsigned short bf16;
typedef unsigned v4u __attribute__((ext_vector_type(4)));
typedef unsigned v2u __attribute__((ext_vector_type(2)));
typedef float f32x4 __attribute__((ext_vector_type(4)));
typedef short bf16x8 __attribute__((ext_vector_type(8)));
typedef GAS unsigned gu32;
#define RLX_AGENT __ATOMIC_RELAXED, __HIP_MEMORY_SCOPE_AGENT
#define LDS_WAIT() asm volatile("s_waitcnt lgkmcnt(0)" ::: "memory")
#define VM_WAIT() asm volatile("s_waitcnt vmcnt(0)" ::: "memory")
__device__ __forceinline__ unsigned pk2(float lo, float hi) { return pg8::cvt_pk_bf16(lo, hi); }
__device__ __forceinline__ float bf2f(unsigned short h) { return __uint_as_float((unsigned)h << 16); }
__device__ __forceinline__ float bflo(unsigned w) { return __uint_as_float(w << 16); }
__device__ __forceinline__ float bfhi(unsigned w) { return __uint_as_float(w & 0xffff0000u); }


#define DPP_F(x, ctrl) __int_as_float(__builtin_amdgcn_mov_dpp(__float_as_int(x), (ctrl), 0xF, 0xF, true))
#define DPP_I(x, ctrl) __builtin_amdgcn_mov_dpp((x), (ctrl), 0xF, 0xF, true)
#define DPP_XOR1 0xB1
#define DPP_XOR2 0x4E
#define DPP_HMIRROR 0x141
#define DPP_MIRROR 0x140
__device__ __forceinline__ float sum_x16_x32(float x) {
    auto a = __builtin_amdgcn_permlane16_swap(__float_as_uint(x), __float_as_uint(x), false, false); x = __uint_as_float(a[0]) + __uint_as_float(a[1]);
    auto b = __builtin_amdgcn_permlane32_swap(__float_as_uint(x), __float_as_uint(x), false, false); return __uint_as_float(b[0]) + __uint_as_float(b[1]);
}
__device__ __forceinline__ float max_x16_x32(float x) {
    auto a = __builtin_amdgcn_permlane16_swap(__float_as_uint(x), __float_as_uint(x), false, false); x = fmaxf(__uint_as_float(a[0]), __uint_as_float(a[1]));
    auto b = __builtin_amdgcn_permlane32_swap(__float_as_uint(x), __float_as_uint(x), false, false); return fmaxf(__uint_as_float(b[0]), __uint_as_float(b[1]));
}
__device__ __forceinline__ float sum8(float x) { x += DPP_F(x, DPP_XOR1); x += DPP_F(x, DPP_XOR2); x += DPP_F(x, DPP_HMIRROR); return x; }
__device__ __forceinline__ float sum4(float x) { x += DPP_F(x, DPP_XOR1); x += DPP_F(x, DPP_XOR2); return x; }

#define XB_TMO      128
#define XB_XCNT(j)  (256  + 64 * (j))
#define XB_XSUB(j)  (1280 + 64 * (j))
#define XB_XGEN(j)  (2304 + 64 * (j))
#define XB_TOP      3328
#define XB_TOPGEN   3392
#define XCD_BAR_WORDS 3456
#define XB_SPIN_CAP (1u << 18)

__device__ __forceinline__ unsigned xb_ld(unsigned* p)              { return __hip_atomic_load(p, __ATOMIC_RELAXED, __HIP_MEMORY_SCOPE_AGENT); }
__device__ __forceinline__ unsigned xb_add(unsigned* p, unsigned v) { return __hip_atomic_fetch_add(p, v, __ATOMIC_RELAXED, __HIP_MEMORY_SCOPE_AGENT); }
__device__ __forceinline__ unsigned xb_xcc_id() { return (unsigned)__builtin_amdgcn_s_getreg((3 << 11) | 20) & 0xFu; }
#define XB_SPIN(cond, bar) do { unsigned _sp = 0; while (cond) { __builtin_amdgcn_s_sleep(1); \
    if ((++_sp & 255u) == 0u) { if (xb_ld(&(bar)[XB_TMO])) break; if (_sp > XB_SPIN_CAP) { atomicAdd(&(bar)[XB_TMO], 1u); break; } } } } while (0)

struct XcdBarrier {
    unsigned* bar; unsigned x;
    volatile LAS unsigned* st;
};

__device__ __forceinline__ XcdBarrier xcd_barrier_post(unsigned* bar, volatile LAS unsigned* st) {
    XcdBarrier b; b.bar = bar; b.x = xb_xcc_id(); b.st = st;
    if (threadIdx.x == 0) (void)xb_add(&bar[XB_XCNT(b.x)], 1u);
    return b;
}
__device__ __forceinline__ void xcd_barrier_complete(unsigned* bar, unsigned x, unsigned& nloc, unsigned& nx) {
    const unsigned G = gridDim.x * gridDim.y * gridDim.z;
    unsigned sum, cnt, mine, sp = 0u;
    for (;;) {
        sum = 0u; cnt = 0u; mine = 0u;
#pragma unroll
        for (unsigned j = 0; j < 16; ++j) { const unsigned c = xb_ld(&bar[XB_XCNT(j)]); sum += c; cnt += (c > 0u) ? 1u : 0u; mine = (j == x) ? c : mine; }
        if (sum == G) break;
        __builtin_amdgcn_s_sleep(1);
        if ((++sp & 255u) == 0u) { if (xb_ld(&bar[XB_TMO])) break; if (sp > XB_SPIN_CAP) { atomicAdd(&bar[XB_TMO], 1u); break; } }
    }
    nloc = mine > 0u ? mine : 1u; nx = cnt > 0u ? cnt : 1u;
}

__device__ __forceinline__ void xcd_barrier(const XcdBarrier& b) {
    asm volatile("s_waitcnt vmcnt(0)" ::: "memory");
    __syncthreads();
    if (threadIdx.x == 0) {
        unsigned* bar = b.bar;
        __builtin_amdgcn_s_waitcnt(0);
        unsigned nloc = b.st[0], nx = b.st[1];
        if (nloc == 0u) { xcd_barrier_complete(bar, b.x, nloc, nx); b.st[0] = nloc; b.st[1] = nx; }
        const unsigned old = xb_add(&bar[XB_XSUB(b.x)], 1u);
        const unsigned gen = old / nloc;
        if (old + 1u == (gen + 1u) * nloc) {
            __builtin_amdgcn_fence(__ATOMIC_RELEASE, "agent");
            asm volatile("s_waitcnt vmcnt(0)" ::: "memory");
            const unsigned og = xb_add(&bar[XB_TOP], 1u);
            const unsigned tg = og / nx;
            if (og + 1u == (tg + 1u) * nx) xb_add(&bar[XB_TOPGEN], 1u);
            else XB_SPIN(xb_ld(&bar[XB_TOPGEN]) == tg, bar);
            __builtin_amdgcn_fence(__ATOMIC_ACQUIRE, "agent");
            xb_add(&bar[XB_XGEN(b.x)], 1u);
            asm volatile("s_waitcnt vmcnt(0)" ::: "memory");
        } else {
            XB_SPIN(xb_ld(&bar[XB_XGEN(b.x)]) == gen, bar);
            __builtin_amdgcn_fence(__ATOMIC_ACQUIRE, "agent");
            asm volatile("s_waitcnt vmcnt(0)" ::: "memory");
        }
    }
    __syncthreads();
}

struct Frame {
    LAS unsigned char* lds;
    volatile LAS unsigned* MISC;
    gu32* ctl;
    int wave, vcu; static constexpr int G = GRID;
};

constexpr int ARGS_OFF = LDSCTL_OFF + 512;
__device__ __forceinline__ void* argp(const Frame& F, int i) { unsigned a = (unsigned)(ARGS_OFF + 8 * i); asm volatile("" : "+v"(a));
    const LAS unsigned* p = (const LAS unsigned*)(F.lds + a);
    const unsigned lo = __builtin_amdgcn_readfirstlane(p[0]), hi = __builtin_amdgcn_readfirstlane(p[1]); return (void*)(((unsigned long long)hi << 32) | lo); }
__device__ __forceinline__ int lane_id() { int l; asm volatile("v_mbcnt_lo_u32_b32 %0, -1, 0\n\tv_mbcnt_hi_u32_b32 %0, -1, %0" : "=v"(l)); return l; }
#define AIN(k) ((const float*)argp(F, (k)))
#define AOUT ((float*)argp(F, 23))
#define AWS ((unsigned char*)argp(F, 24))

__device__ __forceinline__ float wave_sum(float v) { v = sum8(v); v += DPP_F(v, DPP_MIRROR); return sum_x16_x32(v); }

__device__ __forceinline__ void p0_transpose_item(const float* W, const float* gain, int K, int N, int Npad, bf16* WT, int ldw, LAS float* scr, int item, int lane) {
    const int nblk = Npad / 64, kb = item / nblk, nb = item % nblk, k0 = 64 * kb, n0 = 64 * nb;
    const int n4 = lane & 15, kr = lane >> 4; const bool nok = n0 + 4 * n4 + 3 < N;
    f32x4 v[16];
#pragma unroll
    for (int i = 0; i < 16; ++i) { v[i] = (f32x4){0.f, 0.f, 0.f, 0.f}; if (nok) v[i] = *(const GAS f32x4*)((const GAS float*)W + (size_t)(k0 + 4 * i + kr) * N + n0 + 4 * n4); }
#pragma unroll
    for (int i = 0; i < 16; ++i) { const int kk = 4 * i + kr; const float gv = gain ? ((const GAS float*)gain)[k0 + kk] : 1.f; LAS float* d = scr + kk * 65 + 4 * n4;
        d[0] = v[i][0] * gv; d[1] = v[i][1] * gv; d[2] = v[i][2] * gv; d[3] = v[i][3] * gv; }
    LDS_WAIT(); asm volatile("" ::: "memory");
    const int c = lane & 7;
#pragma unroll
    for (int j = 0; j < 8; ++j) { const int n = (lane >> 3) + 8 * j; const LAS float* s = scr + (8 * c) * 65 + n;
        v4u o; o.x = pk2(s[0 * 65], s[1 * 65]); o.y = pk2(s[2 * 65], s[3 * 65]); o.z = pk2(s[4 * 65], s[5 * 65]); o.w = pk2(s[6 * 65], s[7 * 65]);
        *(GAS v4u*)(WT + (size_t)(n0 + n) * ldw + k0 + 8 * c) = o; }
    LDS_WAIT(); asm volatile("" ::: "memory");
}
__device__ __forceinline__ void x_rows4_to_bf16(const float* xrow, bf16* orow, int ldo, float* ssqrow, int lane) {
    const GAS f32x4* xr = (const GAS f32x4*)xrow + lane;
    f32x4 v[4][4];
#pragma unroll
    for (int r = 0; r < 4; ++r)
#pragma unroll
        for (int j = 0; j < 4; ++j) v[r][j] = xr[r * 256 + 64 * j];
#pragma unroll
    for (int r = 0; r < 4; ++r) { float s = 0.f;
#pragma unroll
        for (int j = 0; j < 4; ++j) s += (v[r][j].x * v[r][j].x + v[r][j].y * v[r][j].y) + (v[r][j].z * v[r][j].z + v[r][j].w * v[r][j].w);
        s = wave_sum(s);
        GAS unsigned long long* o8 = (GAS unsigned long long*)(orow + (size_t)r * ldo) + lane;
#pragma unroll
        for (int j = 0; j < 4; ++j) o8[64 * j] = (unsigned long long)pk2(v[r][j].x, v[r][j].y) | ((unsigned long long)pk2(v[r][j].z, v[r][j].w) << 32);
        if (lane < 32) ssqrow[r * 32 + lane] = lane == 0 ? s : 0.f; }
}

__device__ __forceinline__ int koff(int key, int c) { return ((((key >> 4) * 2 + (c >> 2)) * 4 + (c & 3)) * 16 + (key & 15)) * 16; }
__device__ __forceinline__ int voff(int d, int s, int kq) { return 8192 + (((s * 4 + (d >> 4)) * 4 + kq) * 16 + (d & 15)) * 16; }

__device__ __forceinline__ void rows32_to_frags(const float* src, size_t stride, int nvalid, const float* gain, unsigned char* frag, size_t gstride, int s, float* out, int out_lo,
                                                LAS unsigned char* tile, int lane) {
    const int kv = lane >> 5, g = (lane >> 3) & 3, c = lane & 7;
    f32x4 ga = {1.f, 1.f, 1.f, 1.f}, gb = {1.f, 1.f, 1.f, 1.f};
    if (gain) { ga = *(const f32x4*)(gain + 8 * c); gb = *(const f32x4*)(gain + 8 * c + 4); }
    LAS bf16* T = (LAS bf16*)tile;
#pragma unroll 1
    for (int r0 = 0; r0 < 32; r0 += 16) {
        f32x4 ra[16], rb[16];
#pragma unroll
        for (int q = 0; q < 16; ++q) { ra[q] = (f32x4){0.f, 0.f, 0.f, 0.f}; rb[q] = (f32x4){0.f, 0.f, 0.f, 0.f};
            if (r0 + q < nvalid) { const GAS f32x4* p = (const GAS f32x4*)(src + (size_t)(r0 + q) * stride + lane * 8); ra[q] = p[0]; rb[q] = p[1]; } }
#pragma unroll
        for (int q = 0; q < 16; ++q) { const int r = r0 + q; f32x4 a = ra[q], b = rb[q];
            float ss = (a[0] * a[0] + a[1] * a[1]) + (a[2] * a[2] + a[3] * a[3]) + (b[0] * b[0] + b[1] * b[1]) + (b[2] * b[2] + b[3] * b[3]);
            ss = sum8(ss);
            if (gain && kv == 0) { const float rs = 1.0f / sqrtf(ss * (1.0f / 64.0f) + EPS); a = a * rs * ga; b = b * rs * gb; }
            if (out && r >= out_lo && r < nvalid) { GAS f32x4* o = (GAS f32x4*)(out + (size_t)r * 512 + lane * 8); o[0] = a; o[1] = b; }
            v4u w; w.x = pk2(a[0], a[1]); w.y = pk2(a[2], a[3]); w.z = pk2(b[0], b[1]); w.w = pk2(b[2], b[3]);
            if (kv == 0) *(GAS v4u*)(frag + (size_t)g * gstride + koff(32 * s + r, c)) = w;
            else *(LAS v4u*)(T + (g * 32 + r) * 72 + 8 * c) = w; }
    }
    LDS_WAIT(); asm volatile("" ::: "memory");
#pragma unroll 2
    for (int it = 0; it < 16; ++it) {
        const int idx = it * 64 + lane, gg = idx >> 8, rem = idx & 255, dg = rem >> 6, kq = (rem >> 4) & 3, d16 = rem & 15, d = dg * 16 + d16;
        const LAS bf16* tp = T + (gg * 32 + 4 * kq) * 72 + d;
        const unsigned e0 = tp[0], e1 = tp[72], e2 = tp[144], e3 = tp[216], e4 = tp[16 * 72], e5 = tp[17 * 72], e6 = tp[18 * 72], e7 = tp[19 * 72];
        v4u w; w.x = e0 | (e1 << 16); w.y = e2 | (e3 << 16); w.z = e4 | (e5 << 16); w.w = e6 | (e7 << 16);
        *(GAS v4u*)(frag + (size_t)gg * gstride + voff(d, s, kq)) = w;
    }
    LDS_WAIT(); asm volatile("" ::: "memory");
}
__device__ __forceinline__ void rows32_compress(const float* src, size_t stride, const float* gain, unsigned char* frag, size_t gstride, int n, float* out, int lane) {
    const int kv = lane >> 5, g = (lane >> 3) & 3, c = lane & 7;
    f32x4 a = {0.f, 0.f, 0.f, 0.f}, b = {0.f, 0.f, 0.f, 0.f};
#pragma unroll 1
    for (int r0 = 0; r0 < 32; r0 += 16) {
        f32x4 rx[16], ry[16];
#pragma unroll
        for (int q = 0; q < 16; ++q) { const GAS f32x4* p = (const GAS f32x4*)(src + (size_t)(r0 + q) * stride + lane * 8); rx[q] = p[0]; ry[q] = p[1]; }
#pragma unroll
        for (int q = 0; q < 16; ++q) { a += rx[q]; b += ry[q]; if (out) { GAS f32x4* o = (GAS f32x4*)(out + (size_t)(r0 + q) * 512 + lane * 8); o[0] = rx[q]; o[1] = ry[q]; } }
    }
    a = a * (1.0f / 32.0f); b = b * (1.0f / 32.0f);
    float ss = (a[0] * a[0] + a[1] * a[1]) + (a[2] * a[2] + a[3] * a[3]) + (b[0] * b[0] + b[1] * b[1]) + (b[2] * b[2] + b[3] * b[3]);
    ss = sum8(ss);
    unsigned char* fb = frag + (size_t)g * gstride;
    if (kv == 0) { const float rs = 1.0f / sqrtf(ss * (1.0f / 64.0f) + EPS); const f32x4 ga = *(const f32x4*)(gain + 8 * c), gb = *(const f32x4*)(gain + 8 * c + 4); a = a * rs * ga; b = b * rs * gb;
        v4u w; w.x = pk2(a[0], a[1]); w.y = pk2(a[2], a[3]); w.z = pk2(b[0], b[1]); w.w = pk2(b[2], b[3]);
        *(GAS v4u*)(fb + koff(n & 63, c)) = w;
    } else {
        const int kk = n & 31, s = (n >> 5) & 1, kq = (kk & 15) >> 2, pos = (kk >> 4) * 4 + (kk & 3);
        const unsigned w0 = pk2(a[0], a[1]), w1 = pk2(a[2], a[3]), w2 = pk2(b[0], b[1]), w3 = pk2(b[2], b[3]);
        GAS bf16* vp = (GAS bf16*)(fb + voff(8 * c, s, kq)) + pos;
        vp[0] = (bf16)(w0 & 0xffff); vp[8] = (bf16)(w0 >> 16); vp[16] = (bf16)(w1 & 0xffff); vp[24] = (bf16)(w1 >> 16);
        vp[32] = (bf16)(w2 & 0xffff); vp[40] = (bf16)(w2 >> 16); vp[48] = (bf16)(w3 & 0xffff); vp[56] = (bf16)(w3 >> 16);
    }
}
struct Args { const float* in[22]; const int* page_table; float* out; unsigned char* ws; int ph_lo, ph_hi; };

#if defined(PROBE_P0)
#define P0REP(k) ((k) == PROBE_P0 ? 2 : 1)
#else
#define P0REP(k) 1
#endif
__device__ __forceinline__ void p0_prologue(Frame& F) {
    unsigned char* ws = AWS; float* aout = AOUT;
    LAS float* scr = (LAS float*)(F.lds + F.wave * WLDS_BYTES);
    LAS unsigned char* tile = F.lds + F.wave * WLDS_BYTES;
    const int lane = lane_id();
    const int gw = F.vcu * NWAVES + F.wave, NGW = F.G * NWAVES;
    const float* norm1 = AIN(7); const float* norm2 = AIN(19);
    constexpr int I_IN = 16 * 48, I_SQ = 16 * 16, I_KV = 16 * 24, I_QG = 16 * 20, I_UP = 16 * 64, I_DN = 64 * 16;
    constexpr int NITEMS = 2 * I_IN + 2 * I_SQ + I_KV + 2 * I_QG + 2 * I_SQ + 4 * I_UP + 4 * I_DN;
    for (int prep_ = 0; prep_ < P0REP(1); ++prep_)
    for (int it = gw; it < NITEMS; it += NGW) {
        int r = it;
        if (r < 2 * I_IN) { const int l = r / I_IN; p0_transpose_item(AIN(8) + (size_t)l * D * 3072, norm1 + l * D, D, 3072, 3072, (bf16*)(ws + WS_WIN) + (size_t)l * 3072 * WLD1, WLD1, scr, r % I_IN, lane); continue; } r -= 2 * I_IN;
        if (r < 2 * I_SQ) { const int l = r / I_SQ; p0_transpose_item(AIN(10) + (size_t)l * D * D, nullptr, D, D, D, (bf16*)(ws + WS_WOUT) + (size_t)l * D * WLD1, WLD1, scr, r % I_SQ, lane); continue; } r -= 2 * I_SQ;
        if (r < I_KV) { p0_transpose_item(AIN(12), AIN(11), D, 1536, 1536, (bf16*)(ws + WS_WKV), WLD1, scr, r, lane); continue; } r -= I_KV;
        if (r < 2 * I_QG) { const int l = r / I_QG; p0_transpose_item(AIN(16) + (size_t)l * D * 1072, norm1 + (2 + l) * D, D, 1072, NQG, (bf16*)(ws + WS_WQG) + (size_t)l * NQG * WLD1, WLD1, scr, r % I_QG, lane); continue; } r -= 2 * I_QG;
        if (r < 2 * I_SQ) { const int l = r / I_SQ; p0_transpose_item(AIN(18) + (size_t)l * D * D, nullptr, D, D, D, (bf16*)(ws + WS_WO) + (size_t)l * D * WLD1, WLD1, scr, r % I_SQ, lane); continue; } r -= 2 * I_SQ;
        if (r < 4 * I_UP) { const int l = r / I_UP; p0_transpose_item(AIN(20) + (size_t)l * D * FF, norm2 + l * D, D, FF, FF, (bf16*)(ws + WS_WUP) + (size_t)l * FF * WLD1, WLD1, scr, r % I_UP, lane); continue; } r -= 4 * I_UP;
        { const int l = r / I_DN; p0_transpose_item(AIN(21) + (size_t)l * FF * D, nullptr, FF, D, D, (bf16*)(ws + WS_WDN) + (size_t)l * D * WLD4, WLD4, scr, r % I_DN, lane); }
    }
    for (int prep_ = 0; prep_ < P0REP(2); ++prep_)
    for (int m = gw * 4; m < M; m += NGW * 4) {
        const float* xr = m < MP ? AIN(0) + (size_t)m * D : AIN(1) + (size_t)(m - MP) * D;
        x_rows4_to_bf16(xr, (bf16*)(ws + WS_XB) + (size_t)m * XBLD, XBLD, (float*)(ws + WS_SSQ) + (size_t)m * 32, lane);
    }
    const int* pt = (const int*)argp(F, 22);
    for (int prep_ = 0; prep_ < P0REP(3); ++prep_)
    for (int it = gw; it < NSEQ_S * 64; it += NGW) { const int seq = it >> 6, n = it & 63; const int page = pt[seq * 16 + (n >> 2)];
        rows32_compress(AIN(2) + ((size_t)page * 128 + (n & 3) * 32) * 512, 512, AIN(13), ws + WS_CMPS + (size_t)seq * 4 * FRAGB, FRAGB, n, nullptr, lane); }
    for (int prep_ = 0; prep_ < P0REP(4); ++prep_)
    for (int it = gw; it < NSEQ_S * 64; it += NGW) { const int seq = it >> 6, blk = (it >> 1) & 31, s = it & 1; const int page = pt[seq * 16 + (blk >> 1)];
        rows32_to_frags(AIN(3) + ((size_t)page * 128 + (blk & 1) * 64 + s * 32) * 512, 512, 32, nullptr, ws + WS_SLCS + ((size_t)seq * 4 * 33 + blk) * FRAGB, (size_t)33 * FRAGB, s, nullptr, 0, tile, lane); }
    for (int prep_ = 0; prep_ < P0REP(5); ++prep_)
    for (int it = gw; it < NSEQ_S * 16; it += NGW) { const int seq = it >> 4, blk = (it >> 1) & 7, s = it & 1, r0 = blk * 64 + s * 32;
        rows32_to_frags(AIN(4) + ((size_t)seq * 512 + r0) * 512, 512, 32, nullptr, ws + WS_WINS + ((size_t)seq * 4 * 9 + blk) * FRAGB, (size_t)9 * FRAGB, s,
                        aout + O_SWIN + ((long)seq * 512 + r0 - 8) * 512, r0 == 0 ? 8 : 0, tile, lane); }
}

__device__ __forceinline__ void conv_phase(Frame& F, int l) {
    unsigned char* aws = AWS; float* aout = AOUT;
    const bf16* BCX = (const bf16*)(aws + WS_BIG); bf16* V = (bf16*)(aws + WS_ACT1);
    const float* cw = AIN(9) + (size_t)l * 3 * D; const float* st = AIN(5);
    const int lane = lane_id();
    const int gw = F.vcu * NWAVES + F.wave, NGW = F.G * NWAVES;
    for (int it = gw; it < (M / 8) * 2; it += NGW) {
        const int rc = it >> 1, ch = (it & 1) * 512 + lane * 8, row0 = rc * 8;
        float u1[8], u2[8], w0[8], w1[8], w2[8];
#pragma unroll
        for (int j = 0; j < 8; ++j) { w0[j] = cw[ch + j]; w1[j] = cw[D + ch + j]; w2[j] = cw[2 * D + ch + j]; u1[j] = 0.f; u2[j] = 0.f; }
        const bool samp = rc >= MP / 8; const int t0 = row0 & (SEQ - 1);
        if (samp) { const int seq = rc - MP / 8; const float* sp = st + ((size_t)(l * NSEQ_S + seq) * 2) * D + ch;
#pragma unroll
            for (int j = 0; j < 8; ++j) { u2[j] = sp[j]; u1[j] = sp[D + j]; }
        } else if (t0 != 0) {
#pragma unroll
            for (int h = 1; h <= 2; ++h) { const GAS bf16* rp = (const GAS bf16*)BCX + (size_t)(row0 - h) * BCXLD + ch; const v4u c4 = *(const GAS v4u*)(rp + 1024), x4 = *(const GAS v4u*)(rp + 2048);
#pragma unroll
                for (int q = 0; q < 4; ++q) { const float a0 = bflo(c4[q]) * bflo(x4[q]), a1 = bfhi(c4[q]) * bfhi(x4[q]); if (h == 1) { u1[2 * q] = a0; u1[2 * q + 1] = a1; } else { u2[2 * q] = a0; u2[2 * q + 1] = a1; } } }
        }
        v4u rb4[8], rc4[8], rx4[8];
#pragma unroll
        for (int r = 0; r < 8; ++r) { const GAS bf16* rp = (const GAS bf16*)BCX + (size_t)(row0 + r) * BCXLD + ch; rb4[r] = *(const GAS v4u*)rp; rc4[r] = *(const GAS v4u*)(rp + 1024); rx4[r] = *(const GAS v4u*)(rp + 2048); }
#pragma unroll
        for (int r = 0; r < 8; ++r) { const v4u b4 = rb4[r], c4 = rc4[r], x4 = rx4[r];
            float u[8], v[8];
#pragma unroll
            for (int q = 0; q < 4; ++q) { u[2 * q] = bflo(c4[q]) * bflo(x4[q]); u[2 * q + 1] = bfhi(c4[q]) * bfhi(x4[q]); }
#pragma unroll
            for (int j = 0; j < 8; ++j) { const float z = w0[j] * u2[j] + w1[j] * u1[j] + w2[j] * u[j]; const float bgv = (j & 1) ? bfhi(b4[j >> 1]) : bflo(b4[j >> 1]); v[j] = bgv * z; }
            v4u o; o.x = pk2(v[0], v[1]); o.y = pk2(v[2], v[3]); o.z = pk2(v[4], v[5]); o.w = pk2(v[6], v[7]);
            *(GAS v4u*)((GAS bf16*)V + (size_t)(row0 + r) * A1LD + ch) = o;
            if (r >= 6) {
                float* op = nullptr;
                if (samp) op = aout + O_SCONV + ((size_t)(l * NSEQ_S + (rc - MP / 8)) * 2 + (r - 6)) * D + ch;
                else if (t0 == SEQ - 8) op = aout + O_PCONV + ((size_t)(l * 2 + row0 / SEQ) * 2 + (r - 6)) * D + ch;
                if (op) { *(GAS f32x4*)op = (f32x4){u[0], u[1], u[2], u[3]}; *(GAS f32x4*)(op + 4) = (f32x4){u[4], u[5], u[6], u[7]}; }
            }
#pragma unroll
            for (int j = 0; j < 8; ++j) { u2[j] = u1[j]; u1[j] = u[j]; }
        }
    }
}

__device__ __forceinline__ void kvfin_phase(Frame& F) {
    unsigned char* ws = AWS; float* aout = AOUT; const float* KVR = (const float*)(ws + WS_BIG);
    LAS unsigned char* tile = F.lds + F.wave * WLDS_BYTES;
    const int lane = lane_id();
    const int gw = F.vcu * NWAVES + F.wave, NGW = F.G * NWAVES;
    constexpr int N_PC = 512, N_SC = 32, N_PS = 512, N_SS = 256, N_PW = 512, N_SW = 256, NIT = N_PC + N_SC + N_PS + N_SS + N_PW + N_SW;
    for (int it = gw; it < NIT; it += NGW) {
        int r = it;
        if (r < N_PC) { const int b = r >> 8, n = r & 255; const size_t row = (size_t)b * SEQ + 32 * n;
            rows32_compress(KVR + row * KVRLD, KVRLD, AIN(13), ws + WS_CMPP + ((size_t)b * 4 * 4 + (n >> 6)) * FRAGB, (size_t)4 * FRAGB, n, aout + O_PCMP + row * 512, lane); continue; } r -= N_PC;
        if (r < N_SC) {
            for (int q = 0; q < 32; ++q) { const size_t row = (size_t)r * 32 + q; const GAS f32x4* p = (const GAS f32x4*)(KVR + (MP + row) * KVRLD + lane * 8); GAS f32x4* o = (GAS f32x4*)(aout + O_SCMP + row * 512 + lane * 8); o[0] = p[0]; o[1] = p[1]; }
            continue; } r -= N_SC;
        if (r < N_PS) { const int b = r >> 8, blk = (r >> 1) & 127, s = r & 1; const size_t row = (size_t)b * SEQ + blk * 64 + s * 32;
            rows32_to_frags(KVR + row * KVRLD + 512, KVRLD, 32, AIN(14), ws + WS_SLCP + ((size_t)b * 4 * 128 + blk) * FRAGB, (size_t)128 * FRAGB, s, aout + O_PSLC + row * 512, 0, tile, lane); continue; } r -= N_PS;
        if (r < N_SS) { const int seq = r >> 1, s = r & 1; const size_t row = (size_t)seq * 8;
            rows32_to_frags(KVR + (MP + row) * KVRLD + 512, KVRLD, s == 0 ? 8 : 0, AIN(14), ws + WS_SLCS + ((size_t)seq * 4 * 33 + 32) * FRAGB, (size_t)33 * FRAGB, s, aout + O_SSLC + row * 512, 0, tile, lane); continue; } r -= N_SS;
        if (r < N_PW) { const int b = r >> 8, blk = (r >> 1) & 127, s = r & 1; const int t = blk * 64 + s * 32; const size_t row = (size_t)b * SEQ + t;
            float* o = t >= SEQ - 512 ? aout + O_PWIN + ((size_t)b * 512 + (t - (SEQ - 512))) * 512 : nullptr;
            rows32_to_frags(KVR + row * KVRLD + 1024, KVRLD, 32, AIN(15), ws + WS_WINP + ((size_t)b * 4 * 128 + blk) * FRAGB, (size_t)128 * FRAGB, s, o, 0, tile, lane); continue; } r -= N_PW;
        { const int seq = r >> 1, s = r & 1; const size_t row = (size_t)seq * 8;
            rows32_to_frags(KVR + (MP + row) * KVRLD + 1024, KVRLD, s == 0 ? 8 : 0, AIN(15), ws + WS_WINS + ((size_t)seq * 4 * 9 + 8) * FRAGB, (size_t)9 * FRAGB, s, aout + O_SWIN + ((size_t)seq * 512 + 504) * 512, 0, tile, lane); }
    }
}
#define MFMA16(a, b, c) __builtin_amdgcn_mfma_f32_16x16x32_bf16((a), (b), (c), 0, 0, 0)
struct AttState { float m[2], l[2]; f32x4 o[4][2]; };
__device__ __forceinline__ void att_init(AttState& st) {
#pragma unroll
    for (int cg = 0; cg < 2; ++cg) { st.m[cg] = -1e30f; st.l[cg] = 0.f;
#pragma unroll
        for (int dg = 0; dg < 4; ++dg) st.o[dg][cg] = (f32x4){0.f, 0.f, 0.f, 0.f}; }
}
__device__ __forceinline__ bf16x8 pack_p(const f32x4& a, const f32x4& b) {
    v4u w; w.x = pk2(a[0], a[1]); w.y = pk2(a[2], a[3]); w.z = pk2(b[0], b[1]); w.w = pk2(b[2], b[3]); return __builtin_bit_cast(bf16x8, w);
}
typedef __amdgpu_buffer_rsrc_t rsrc_t;
__device__ __forceinline__ rsrc_t mk_rsrc(const void* p) { return __builtin_amdgcn_make_buffer_rsrc((void*)p, 0, 0x7fffff00, 0x00020000); }
__device__ __forceinline__ bf16x8 frag_ld(rsrc_t rs, int boff, int k, int lane) { return __builtin_bit_cast(bf16x8, __builtin_amdgcn_raw_buffer_load_b128(rs, lane * 16, boff + k * 1024, 0)); }
__device__ __forceinline__ void load_k(bf16x8 (&kf)[3][2], rsrc_t rs, int boff, int lane) {
#pragma unroll
    for (int kg = 0; kg < 3; ++kg)
#pragma unroll
        for (int dh = 0; dh < 2; ++dh) kf[kg][dh] = frag_ld(rs, boff, kg * 2 + dh, lane);
}
__device__ __forceinline__ void load_q_raw(const bf16* QG, int row, int hfull, int rq, v4u& r0, v4u& r1) {
    const GAS bf16* qp = (const GAS bf16*)QG + (size_t)row * QGLD + hfull * 64 + rq * 8; r0 = *(const GAS v4u*)qp; r1 = *(const GAS v4u*)(qp + 32);
}
__device__ __forceinline__ void norm_q(const v4u r0, const v4u r1, const float* qn, int rq, bf16x8 (&qf)[2]) {
    float x0[8], x1[8]; float ss = 0.f;
#pragma unroll
    for (int q = 0; q < 4; ++q) { x0[2 * q] = bflo(r0[q]); x0[2 * q + 1] = bfhi(r0[q]); x1[2 * q] = bflo(r1[q]); x1[2 * q + 1] = bfhi(r1[q]); }
#pragma unroll
    for (int j = 0; j < 8; ++j) ss += x0[j] * x0[j] + x1[j] * x1[j];
    ss = sum_x16_x32(ss);
    const float rs = (1.0f / sqrtf(ss * (1.0f / 64.0f) + EPS)) * (0.125f * 1.4426950408889634f);
    const GAS f32x4* gq = (const GAS f32x4*)(qn + rq * 8); const f32x4 g0 = gq[0], g1 = gq[1], g2 = gq[8], g3 = gq[9];
#pragma unroll
    for (int j = 0; j < 4; ++j) { x0[j] *= rs * g0[j]; x0[4 + j] *= rs * g1[j]; x1[j] *= rs * g2[j]; x1[4 + j] *= rs * g3[j]; }
    v4u w0, w1; w0.x = pk2(x0[0], x0[1]); w0.y = pk2(x0[2], x0[3]); w0.z = pk2(x0[4], x0[5]); w0.w = pk2(x0[6], x0[7]);
    w1.x = pk2(x1[0], x1[1]); w1.y = pk2(x1[2], x1[3]); w1.z = pk2(x1[4], x1[5]); w1.w = pk2(x1[6], x1[7]);
    qf[0] = __builtin_bit_cast(bf16x8, w0); qf[1] = __builtin_bit_cast(bf16x8, w1);
}
__device__ __forceinline__ void load_q(const bf16* QG, const float* qn, int row, int hfull, int rq, bf16x8 (&qf)[2]) { v4u r0, r1; load_q_raw(QG, row, hfull, rq, r0, r1); norm_q(r0, r1, qn, rq, qf); }
__device__ __forceinline__ float gate_ld(const bf16* QG, int row4, int g, int br, int lane) {
    int l2 = lane; asm volatile("" : "+v"(l2));
    const int c16 = l2 & 15; const unsigned off = (unsigned)(row4 + (c16 >> 2)) * (unsigned)QGLD + 1024u + (unsigned)((g * 4 + (c16 & 3)) * 3 + br);
    return 1.0f / (1.0f + __expf(-bf2f(((const GAS bf16*)QG)[off])));
}
__device__ __forceinline__ void stg_put(LAS unsigned char* stg, int col, int dg, int rq, v2u w) {
    *(LAS v2u*)(stg + col * 128 + (((2 * dg + (rq >> 1)) ^ (col & 7)) * 16) + (rq & 1) * 8) = w;
}
__device__ __forceinline__ v4u stg_get(const LAS unsigned char* stg, int lane, int k) { const int col = lane >> 1, ch = (lane & 1) * 4 + k;
    return *(const LAS v4u*)(stg + col * 128 + ((ch ^ (col & 7)) * 16)); }
struct SeqDesc { int qrow0, P, win_blk0, ncb; const unsigned char* slc; const unsigned char* win; const unsigned char* cmp;
    unsigned* cnt; unsigned* list; bf16* parto; float* partml; };

__device__ __forceinline__ void attn_sparse_phase(Frame& F, int j) {
    unsigned char* ws = AWS; const bf16* QG = (const bf16*)(ws + WS_QG); const float* qn = AIN(17) + j * 64;
    const GAS unsigned* cnt = (const GAS unsigned*)((unsigned*)F.ctl + CW_CNT + j * 1024 * CNT_PAD);
    const GAS unsigned* list = (const GAS unsigned*)(ws + WS_LIST);
    GAS bf16* parto = (GAS bf16*)(ws + WS_PARTO); GAS float* partml = (GAS float*)(ws + WS_PARTML);
    LAS int* P = (LAS int*)(F.lds + F.wave * WLDS_BYTES);
    const int lane = lane_id(), col16 = lane & 15, rq = lane >> 4, head = col16 & 3, tk4 = col16 >> 2;
    const int xc = F.vcu >> 5;
    unsigned* dq = (unsigned*)F.ctl + CW_DQ + 64 * (8 * j + xc);
    {
        int nch[16]; int tot = 0;
#pragma unroll
        for (int q = 0; q < 16; ++q) { const unsigned c1 = cnt[(16 * lane + q) * CNT_PAD]; nch[q] = (int)((c1 + 63u) >> 6); tot += nch[q]; }
        P[1088 + lane] = tot; LDS_WAIT(); asm volatile("" ::: "memory");
        int base = 0;
#pragma unroll 1
        for (int i = 0; i < 64; ++i) { const int v = P[1088 + i]; base += i < lane ? v : 0; }
#pragma unroll
        for (int k = 0; k < 16; ++k) { P[16 * lane + k] = base; base += nch[k]; }
        if (lane == 63) P[1024] = base;
        LDS_WAIT(); asm volatile("" ::: "memory");
    }
    const int ibase = P[128 * xc], total = P[128 * xc + 128] - ibase;
#pragma unroll 1
    for (;;) {
        unsigned it_ = 0; if (lane == 0) it_ = __hip_atomic_fetch_add(dq, 1u, __ATOMIC_RELAXED, __HIP_MEMORY_SCOPE_AGENT);
        const int itl = __builtin_amdgcn_readfirstlane(it_); if (itl >= total) break; const int item = ibase + itl;
        int lo_ = 0, hi_ = 1024;
#pragma unroll 1
        while (hi_ - lo_ > 1) { const int mid = (lo_ + hi_) >> 1; if (P[mid] <= item) lo_ = mid; else hi_ = mid; }
        const int L = __builtin_amdgcn_readfirstlane(lo_), chunk = item - __builtin_amdgcn_readfirstlane(P[lo_]);
        const int n = (int)cnt[L * CNT_PAD], e0 = chunk * 64, e1 = n < e0 + 64 ? n : e0 + 64;
        const int bg = L >> 7, g = bg & 3, b = bg >> 2;
        const GAS unsigned char* kb = (const GAS unsigned char*)(ws + WS_SLCP) + (size_t)L * FRAGB + lane * 16;
        bf16x8 kf[4][2], vf[2][4];
#pragma unroll
        for (int kg = 0; kg < 4; ++kg)
#pragma unroll
            for (int dh = 0; dh < 2; ++dh) kf[kg][dh] = *(const GAS bf16x8*)(kb + (kg * 2 + dh) * 1024);
#pragma unroll
        for (int sl = 0; sl < 2; ++sl)
#pragma unroll
            for (int dg = 0; dg < 4; ++dg) vf[sl][dg] = *(const GAS bf16x8*)(kb + 8192 + (sl * 4 + dg) * 1024);
        const GAS unsigned* le = list + (size_t)L * 8192;
        LAS unsigned* entL = (LAS unsigned*)(F.lds + F.wave * WLDS_BYTES + 8192);
        LAS unsigned char* stg = F.lds + F.wave * WLDS_BYTES + 12288;
        { const int e = e0 + lane; entL[lane] = le[e < e1 ? e : e0]; LDS_WAIT(); asm volatile("" ::: "memory"); }
        v4u raw[2][2], rawn[2][2];
#pragma unroll
        for (int cg = 0; cg < 2; ++cg) { const unsigned ent = entL[4 * cg + tk4]; load_q_raw(QG, (int)((size_t)b * SEQ + (ent & 0xffffu)), g * 4 + head, rq, raw[cg][0], raw[cg][1]); }
#pragma unroll 1
        for (int eb = e0; eb < e1; eb += 8) {
            { const int nb = eb + 8 < e1 ? eb + 8 - e0 : eb - e0;
#pragma unroll
              for (int cg = 0; cg < 2; ++cg) { const unsigned ent = entL[nb + 4 * cg + tk4]; load_q_raw(QG, (int)((size_t)b * SEQ + (ent & 0xffffu)), g * 4 + head, rq, rawn[cg][0], rawn[cg][1]); } }
            __builtin_amdgcn_sched_barrier(0);
#pragma unroll
            for (int cg = 0; cg < 2; ++cg) {
                const int e = eb + 4 * cg + tk4; const bool valid = e < e1; const unsigned ent = entL[eb - e0 + 4 * cg + tk4];
                const size_t row = (size_t)b * SEQ + (ent & 0xffffu); const int r = (int)(ent >> 16);
                bf16x8 qf[2]; norm_q(raw[cg][0], raw[cg][1], qn, rq, qf);
                f32x4 s[4];
#pragma unroll
                for (int kg = 0; kg < 4; ++kg) { s[kg] = (f32x4){0.f, 0.f, 0.f, 0.f}; s[kg] = MFMA16(kf[kg][0], qf[0], s[kg]); s[kg] = MFMA16(kf[kg][1], qf[1], s[kg]); }
                float mx = -1e30f;
#pragma unroll
                for (int kg = 0; kg < 4; ++kg)
#pragma unroll
                    for (int i = 0; i < 4; ++i) mx = fmaxf(mx, s[kg][i]);
                mx = max_x16_x32(mx);
                float ls = 0.f;
#pragma unroll
                for (int kg = 0; kg < 4; ++kg)
#pragma unroll
                    for (int i = 0; i < 4; ++i) { const float p = __builtin_amdgcn_exp2f(s[kg][i] - mx); s[kg][i] = p; ls += p; }
                ls = sum_x16_x32(ls);
                f32x4 o[4];
#pragma unroll
                for (int dg = 0; dg < 4; ++dg) o[dg] = (f32x4){0.f, 0.f, 0.f, 0.f};
#pragma unroll
                for (int sl = 0; sl < 2; ++sl) { const bf16x8 pf = pack_p(s[2 * sl], s[2 * sl + 1]);
#pragma unroll
                    for (int dg = 0; dg < 4; ++dg) o[dg] = MFMA16(vf[sl][dg], pf, o[dg]); }
                if (valid && rq == 0) { const size_t pi = ((row * 6 + r) * 16 + g * 4 + head); partml[pi * 2] = mx; partml[pi * 2 + 1] = ls; }
#pragma unroll
                for (int dg = 0; dg < 4; ++dg) { v2u w; w.x = pk2(o[dg][0], o[dg][1]); w.y = pk2(o[dg][2], o[dg][3]); stg_put(stg, cg * 16 + col16, dg, rq, w); }
            }
            LDS_WAIT(); asm volatile("" ::: "memory");
            { const int c_ = lane >> 1, e_ = eb + (c_ >> 2), hd_ = c_ & 3;
              if (e_ < e1) { const unsigned ent = entL[e_ - e0]; const size_t pi = (((size_t)b * SEQ + (ent & 0xffffu)) * 6 + (ent >> 16)) * 16 + g * 4 + hd_; GAS bf16* pp = parto + pi * 64 + (lane & 1) * 32;
#pragma unroll
                  for (int k = 0; k < 4; ++k) *(GAS v4u*)(pp + 8 * k) = stg_get(stg, lane, k); } }
            LDS_WAIT(); asm volatile("" ::: "memory");
#pragma unroll
            for (int cg = 0; cg < 2; ++cg) { raw[cg][0] = rawn[cg][0]; raw[cg][1] = rawn[cg][1]; }
        }
    }
}
__device__ __forceinline__ void attn_combine_phase(Frame& F, int j, bool dummy = false) {
    unsigned char* ws = AWS; const GAS bf16* QG = (const GAS bf16*)(ws + WS_QG); GAS bf16* O = (GAS bf16*)(ws + WS_ACT1); GAS bf16* Od = dummy ? (GAS bf16*)(ws + WS_BIG) : O;
    const GAS bf16* parto = (const GAS bf16*)(ws + WS_PARTO); const GAS float* partml = (const GAS float*)(ws + WS_PARTML);
    const int lane = lane_id(), hfull = lane >> 2, q = lane & 3;
    const int gw = F.vcu * NWAVES + F.wave, NGW = F.G * NWAVES;
#pragma unroll 1
    for (int row0 = gw; row0 < MP; row0 += 2 * NGW) {
        float m[2][6], l[2][6]; v4u pa[2][6], pb[2][6], b0[2], b1[2]; float gl[2];
#pragma unroll
        for (int u = 0; u < 2; ++u) { const int row = row0 + u * NGW;
#pragma unroll
            for (int sl = 0; sl < 6; ++sl) { const GAS float* p = partml + (((size_t)row * 6 + sl) * 16 + hfull) * 2; m[u][sl] = p[0]; l[u][sl] = p[1];
                const GAS v4u* op = (const GAS v4u*)(parto + (((size_t)row * 6 + sl) * 16 + hfull) * 64 + q * 16); pa[u][sl] = op[0]; pb[u][sl] = op[1]; }
            gl[u] = bf2f(QG[(size_t)row * QGLD + 1024 + hfull * 3 + 1]);
            const GAS v4u* dsr = (const GAS v4u*)(O + (size_t)row * A1LD + hfull * 64 + q * 16); b0[u] = dsr[0]; b1[u] = dsr[1]; }
#pragma unroll
        for (int u = 0; u < 2; ++u) { const int row = row0 + u * NGW;
            float M = -1e30f;
#pragma unroll
            for (int sl = 0; sl < 6; ++sl) M = fmaxf(M, l[u][sl] > 0.f ? m[u][sl] : -1e30f);
            float acc[16]; float Lt = 0.f;
#pragma unroll
            for (int e = 0; e < 16; ++e) acc[e] = 0.f;
#pragma unroll
            for (int sl = 0; sl < 6; ++sl) { const v4u a = pa[u][sl], b = pb[u][sl];
                const float w = l[u][sl] > 0.f ? __builtin_amdgcn_exp2f(m[u][sl] - M) : 0.f; Lt += w * l[u][sl];
                if (l[u][sl] > 0.f) {
#pragma unroll
                    for (int e = 0; e < 4; ++e) { acc[2 * e] += w * bflo(a[e]); acc[2 * e + 1] += w * bfhi(a[e]); acc[8 + 2 * e] += w * bflo(b[e]); acc[8 + 2 * e + 1] += w * bfhi(b[e]); } } }
            const float f = (1.0f / (1.0f + __expf(-gl[u]))) / Lt;
            v4u r0, r1; GAS v4u* dst = (GAS v4u*)(Od + (size_t)row * A1LD + hfull * 64 + q * 16);
#pragma unroll
            for (int e = 0; e < 4; ++e) { r0[e] = pk2(bflo(b0[u][e]) + acc[2 * e] * f, bfhi(b0[u][e]) + acc[2 * e + 1] * f); r1[e] = pk2(bflo(b1[u][e]) + acc[8 + 2 * e] * f, bfhi(b1[u][e]) + acc[8 + 2 * e + 1] * f); }
            dst[0] = r0; dst[1] = r1; }
    }
}
template <int MODE>
__device__ __forceinline__ void att_block_h(bf16x8 (&kf)[3][2], rsrc_t rs, int boff, int noff, const bf16x8 (&qf)[2][2], int pos0, const int (&lo)[2], const int (&hi)[2], const bool (&on)[2], AttState& st, int lane) {
    const int rq = lane >> 4;
    bf16x8 vf[2][4];
#pragma unroll
    for (int sl = 0; sl < 2; ++sl)
#pragma unroll
        for (int dg = 0; dg < 4; ++dg) vf[sl][dg] = frag_ld(rs, boff, 8 + sl * 4 + dg, lane);
    bf16x8 k3[2]; k3[0] = frag_ld(rs, boff, 6, lane); k3[1] = frag_ld(rs, boff, 7, lane);
    __builtin_amdgcn_sched_barrier(0);
    f32x4 s[2][4];
#pragma unroll
    for (int cg = 0; cg < 2; ++cg) { const float nm = -st.m[cg];
#pragma unroll
        for (int kg = 0; kg < 3; ++kg) { s[cg][kg] = (f32x4){nm, nm, nm, nm}; s[cg][kg] = MFMA16(kf[kg][0], qf[cg][0], s[cg][kg]); s[cg][kg] = MFMA16(kf[kg][1], qf[cg][1], s[cg][kg]); }
        s[cg][3] = (f32x4){nm, nm, nm, nm}; s[cg][3] = MFMA16(k3[0], qf[cg][0], s[cg][3]); s[cg][3] = MFMA16(k3[1], qf[cg][1], s[cg][3]); }
    __builtin_amdgcn_sched_barrier(0);
    load_k(kf, rs, noff, lane);
    __builtin_amdgcn_sched_barrier(0);
#pragma unroll
    for (int cg = 0; cg < 2; ++cg) {
        if (MODE == 1) { const int rlo = lo[cg] - pos0 - 4 * rq, rhi = hi[cg] - pos0 - 4 * rq;
#pragma unroll
            for (int kg = 0; kg < 4; ++kg)
#pragma unroll
                for (int i = 0; i < 4; ++i) { const bool ok = (16 * kg + i) >= rlo && (16 * kg + i) <= rhi; s[cg][kg][i] = ok ? s[cg][kg][i] : -INFINITY; } }
        if (MODE == 2) {
#pragma unroll
            for (int kg = 0; kg < 4; ++kg)
#pragma unroll
                for (int i = 0; i < 4; ++i) s[cg][kg][i] = on[cg] ? s[cg][kg][i] : -INFINITY; }
        float mx = fmaxf(fmaxf(s[cg][0][0], s[cg][0][1]), fmaxf(s[cg][0][2], s[cg][0][3]));
#pragma unroll
        for (int kg = 1; kg < 4; ++kg) mx = fmaxf(fmaxf(mx, fmaxf(s[cg][kg][0], s[cg][kg][1])), fmaxf(s[cg][kg][2], s[cg][kg][3]));
        if (__any(mx > 8.0f || (mx < -32.0f && mx > -INFINITY))) { mx = max_x16_x32(mx); const float lc = sum_x16_x32(st.l[cg]); const float dl = lc > 0.f ? fmaxf(mx, 0.f) : (mx > -INFINITY ? mx : 0.f), alpha = __builtin_amdgcn_exp2f(-dl); st.m[cg] += dl; st.l[cg] *= alpha;
#pragma unroll
            for (int kg = 0; kg < 4; ++kg) s[cg][kg] = s[cg][kg] - dl;
#pragma unroll
            for (int dg = 0; dg < 4; ++dg) st.o[dg][cg] = st.o[dg][cg] * alpha; }
        float ls = 0.f;
#pragma unroll
        for (int kg = 0; kg < 4; ++kg)
#pragma unroll
            for (int i = 0; i < 4; ++i) { const float p = __builtin_amdgcn_exp2f(s[cg][kg][i]); s[cg][kg][i] = p; ls += p; }
        st.l[cg] += ls;
#pragma unroll
        for (int sl = 0; sl < 2; ++sl) { const bf16x8 pf = pack_p(s[cg][2 * sl], s[cg][2 * sl + 1]);
#pragma unroll
            for (int dg = 0; dg < 4; ++dg) st.o[dg][cg] = MFMA16(vf[sl][dg], pf, st.o[dg][cg]); }
    }
}
__device__ __forceinline__ void att_init0h(AttState& st) {
#pragma unroll
    for (int cg = 0; cg < 2; ++cg) { st.m[cg] = 0.f; st.l[cg] = 0.f;
#pragma unroll
        for (int dg = 0; dg < 4; ++dg) st.o[dg][cg] = (f32x4){0.f, 0.f, 0.f, 0.f}; }
}
__device__ __forceinline__ void attn_full_task(const bf16* QG, const float* qn, bf16* O, const SeqDesc sd, int g, LAS unsigned char* wl, int lane) {
    const int col16 = lane & 15, rq = lane >> 4, head = col16 & 3, tk4 = col16 >> 2;
    const int t0 = sd.P, cur = t0 >> 6, qrow = sd.qrow0;
    LAS float* impL = (LAS float*)wl;
    LAS int* selL = (LAS int*)(wl + 4096);
    LAS int* prog = (LAS int*)(wl + 4352);
    LAS f32x4* oL = (LAS f32x4*)(wl + 4608) + lane;
    bf16x8 qf[2][2]; int tcol[2]; float glg[2][3];
#pragma unroll
    for (int cg = 0; cg < 2; ++cg) { tcol[cg] = t0 + 4 * cg + tk4; load_q(QG, qn, qrow + 4 * cg + tk4, g * 4 + head, rq, qf[cg]);
        const GAS bf16* gp = (const GAS bf16*)QG + (size_t)(qrow + 4 * cg + tk4) * QGLD + 1024 + (g * 4 + head) * 3;
#pragma unroll
        for (int br = 0; br < 3; ++br) glg[cg][br] = bf2f(gp[br]); }
    {
        int hic[2]; hic[0] = ((tcol[0] + 1) >> 5) - 1; hic[1] = ((tcol[1] + 1) >> 5) - 1;
        int cbmax = (2 * cur + 1) >> 6; if (cbmax > sd.ncb - 1) cbmax = sd.ncb - 1;
        float m[2] = {0.f, 0.f}, l[2] = {0.f, 0.f};
#pragma unroll 1
        for (int cb = 0; cb <= cbmax; ++cb) {
            const GAS unsigned char* kb = (const GAS unsigned char*)sd.cmp + (size_t)cb * FRAGB + lane * 16;
            bf16x8 kf[4][2];
#pragma unroll
            for (int kg = 0; kg < 4; ++kg) { kf[kg][0] = *(const GAS bf16x8*)(kb + (kg * 2) * 1024); kf[kg][1] = *(const GAS bf16x8*)(kb + (kg * 2 + 1) * 1024); }
#pragma unroll
            for (int cg = 0; cg < 2; ++cg) {
                f32x4 sc[4]; const float nm = -m[cg]; float mx = -INFINITY;
#pragma unroll
                for (int kg = 0; kg < 4; ++kg) { sc[kg] = (f32x4){nm, nm, nm, nm}; sc[kg] = MFMA16(kf[kg][0], qf[cg][0], sc[kg]); sc[kg] = MFMA16(kf[kg][1], qf[cg][1], sc[kg]); }
#pragma unroll
                for (int kg = 0; kg < 4; ++kg)
#pragma unroll
                    for (int i = 0; i < 4; ++i) { sc[kg][i] = (16 * kg + i) <= hic[cg] - 64 * cb - 4 * rq ? sc[kg][i] : -INFINITY; mx = fmaxf(mx, sc[kg][i]); }
                if (__any(mx > 8.0f || (mx < -32.0f && mx > -INFINITY))) { mx = max_x16_x32(mx); const float lc = sum_x16_x32(l[cg]); const float dl = lc > 0.f ? fmaxf(mx, 0.f) : (mx > -INFINITY ? mx : 0.f); m[cg] += dl; l[cg] *= __builtin_amdgcn_exp2f(-dl);
#pragma unroll
                    for (int kg = 0; kg < 4; ++kg) sc[kg] = sc[kg] - dl; }
#pragma unroll
                for (int kg = 0; kg < 4; ++kg)
#pragma unroll
                    for (int i = 0; i < 4; ++i) l[cg] += __builtin_amdgcn_exp2f(sc[kg][i]);
            }
        }
        float linv[2];
#pragma unroll
        for (int cg = 0; cg < 2; ++cg) { const float lt = sum_x16_x32(l[cg]); linv[cg] = lt > 0.f ? 1.0f / lt : 0.f; }
        f32x4 oc4[4][2];
#pragma unroll
        for (int dg = 0; dg < 4; ++dg) { oc4[dg][0] = (f32x4){0.f, 0.f, 0.f, 0.f}; oc4[dg][1] = (f32x4){0.f, 0.f, 0.f, 0.f}; }
#pragma unroll 1
        for (int cb = 0; cb <= cbmax; ++cb) {
            const GAS unsigned char* kb = (const GAS unsigned char*)sd.cmp + (size_t)cb * FRAGB + lane * 16;
            bf16x8 kf[4][2], vf[2][4];
#pragma unroll
            for (int kg = 0; kg < 4; ++kg) { kf[kg][0] = *(const GAS bf16x8*)(kb + (kg * 2) * 1024); kf[kg][1] = *(const GAS bf16x8*)(kb + (kg * 2 + 1) * 1024); }
#pragma unroll
            for (int sl = 0; sl < 2; ++sl)
#pragma unroll
                for (int dg = 0; dg < 4; ++dg) vf[sl][dg] = *(const GAS bf16x8*)(kb + 8192 + (sl * 4 + dg) * 1024);
#pragma unroll
            for (int cg = 0; cg < 2; ++cg) {
                f32x4 sc[4]; const float nm = -m[cg];
#pragma unroll
                for (int kg = 0; kg < 4; ++kg) { sc[kg] = (f32x4){nm, nm, nm, nm}; sc[kg] = MFMA16(kf[kg][0], qf[cg][0], sc[kg]); sc[kg] = MFMA16(kf[kg][1], qf[cg][1], sc[kg]); }
#pragma unroll
                for (int kg = 0; kg < 4; ++kg) {
#pragma unroll
                    for (int i = 0; i < 4; ++i) sc[kg][i] = (16 * kg + i) <= hic[cg] - 64 * cb - 4 * rq ? __builtin_amdgcn_exp2f(sc[kg][i]) * linv[cg] : 0.f;
                    float e0 = sc[kg][0] + sc[kg][1], e1 = sc[kg][2] + sc[kg][3];
                    e0 = sum4(e0); e1 = sum4(e1);
                    if (head == 0) { LAS float* ip = impL + (4 * cg + tk4) * 128 + 32 * cb + 8 * kg + 2 * rq; ip[0] = e0; ip[1] = e1; }
                }
#pragma unroll
                for (int sl = 0; sl < 2; ++sl) { const bf16x8 pf = pack_p(sc[2 * sl], sc[2 * sl + 1]);
#pragma unroll
                    for (int dg = 0; dg < 4; ++dg) oc4[dg][cg] = MFMA16(vf[sl][dg], pf, oc4[dg][cg]); }
            }
        }
#pragma unroll
        for (int cg = 0; cg < 2; ++cg) { const float gt = 1.0f / (1.0f + __expf(-glg[cg][0]));
#pragma unroll
            for (int dg = 0; dg < 4; ++dg) oL[(dg * 2 + cg) * 64] = oc4[dg][cg] * gt; }
    }
    LDS_WAIT(); asm volatile("" ::: "memory");
    {
        const int tok = lane >> 3, j8 = lane & 7; float v[16];
#pragma unroll
        for (int k = 0; k < 16; ++k) { const int bb = 16 * j8 + k; const float x = impL[tok * 128 + bb]; v[k] = (bb >= 1 && bb <= cur - 2) ? x : -1.f; }
#pragma unroll
        for (int r = 0; r < 5; ++r) {
            float best = v[0]; int bi = 0;
#pragma unroll
            for (int k = 1; k < 16; ++k) if (v[k] > best) { best = v[k]; bi = k; }
            int gi = 16 * j8 + bi;
#pragma unroll
            for (int st_ = 0; st_ < 3; ++st_) { const float ov = st_ == 0 ? DPP_F(best, DPP_XOR1) : st_ == 1 ? DPP_F(best, DPP_XOR2) : DPP_F(best, DPP_HMIRROR);
                const int oi = st_ == 0 ? DPP_I(gi, DPP_XOR1) : st_ == 1 ? DPP_I(gi, DPP_XOR2) : DPP_I(gi, DPP_HMIRROR); if (ov > best || (ov == best && oi < gi)) { best = ov; gi = oi; } }
            if (j8 == 0) selL[tok * 8 + r] = best >= 0.f ? gi : -1;
            if ((gi >> 4) == j8) {
#pragma unroll
                for (int k = 0; k < 16; ++k) if ((gi & 15) == k) v[k] = -1.f; }
        }
    }
    LDS_WAIT(); asm volatile("" ::: "memory");
    {
        AttState st; att_init0h(st);
        int lo[2] = {0, 0}, hi[2] = {tcol[0], tcol[1]};
        int nprog;
        {
            int fm = 1 << 16; asm volatile("" : "+s"(fm));
            if (lane == 0) { int n = 0; prog[n++] = 0 | fm; if (cur >= 2) prog[n++] = (cur - 1) | fm; if (cur >= 1) prog[n++] = cur | fm; prog[63] = n; }
            LDS_WAIT(); asm volatile("" ::: "memory");
            int n = __builtin_amdgcn_readfirstlane(prog[63]);
#pragma unroll 1
            for (int half = 0; half < 2; ++half) { const int b = lane + 64 * half; int tm = 0;
#pragma unroll 1
                for (int tok = 0; tok < 8; ++tok)
#pragma unroll
                    for (int r = 0; r < 5; ++r) tm |= (selL[tok * 8 + r] == b) ? (1 << tok) : 0;
                const unsigned long long bal = __ballot(tm != 0); const int pre = __popcll(bal & ((1ull << lane) - 1ull));
                if (tm != 0) prog[n + pre] = b | (tm << 8);
                n += __popcll(bal); }
            if (lane == 0) { prog[n] = prog[n - 1]; prog[63] = n; }
            LDS_WAIT(); asm volatile("" ::: "memory"); nprog = __builtin_amdgcn_readfirstlane(prog[63]); }
        const rsrc_t rs = mk_rsrc(sd.slc);
        bf16x8 kf[3][2]; load_k(kf, rs, 0, lane);
#pragma unroll 1
        for (int i = 0; i < nprog; ++i) {
            const int e = __builtin_amdgcn_readfirstlane(prog[i]), en = __builtin_amdgcn_readfirstlane(prog[i + 1]);
            const int b = e & 255, tm = (e >> 8) & 255, bp = b * FRAGB, np = (en & 255) * FRAGB;
            bool on[2]; on[0] = (tm >> tk4) & 1; on[1] = (tm >> (4 + tk4)) & 1;
            if (e >> 16) { if (b == cur) att_block_h<1>(kf, rs, bp, np, qf, 64 * b, lo, hi, on, st, lane); else att_block_h<0>(kf, rs, bp, np, qf, 64 * b, lo, hi, on, st, lane); }
            else att_block_h<2>(kf, rs, bp, np, qf, 64 * b, lo, hi, on, st, lane);
        }
#pragma unroll
        for (int cg = 0; cg < 2; ++cg) { const float lt = sum_x16_x32(st.l[cg]), f = (1.0f / (1.0f + __expf(-glg[cg][1]))) / lt;
#pragma unroll
            for (int dg = 0; dg < 4; ++dg) oL[(dg * 2 + cg) * 64] = oL[(dg * 2 + cg) * 64] + st.o[dg][cg] * f; }
    }
    asm volatile("" ::: "memory");
    {
        AttState st; att_init0h(st);
        int lo[2] = {tcol[0] - 512, tcol[1] - 512}, hi[2] = {tcol[0], tcol[1]}; bool on[2] = {true, true};
        int b0 = cur - 8; if (b0 < sd.win_blk0) b0 = sd.win_blk0;
        const rsrc_t rs = mk_rsrc(sd.win);
        bf16x8 kf[3][2]; load_k(kf, rs, (b0 - sd.win_blk0) * FRAGB, lane);
#pragma unroll 1
        for (int b = b0; b <= cur; ++b) { const int bn = b < cur ? b + 1 : b; const bool edge = b == cur || b == cur - 8;
            if (edge) att_block_h<1>(kf, rs, (b - sd.win_blk0) * FRAGB, (bn - sd.win_blk0) * FRAGB, qf, 64 * b, lo, hi, on, st, lane);
            else att_block_h<0>(kf, rs, (b - sd.win_blk0) * FRAGB, (bn - sd.win_blk0) * FRAGB, qf, 64 * b, lo, hi, on, st, lane); }
#pragma unroll
        for (int cg = 0; cg < 2; ++cg) { const float lt = sum_x16_x32(st.l[cg]), f = (1.0f / (1.0f + __expf(-glg[cg][2]))) / lt;
            int l3 = lane; asm volatile("" : "+v"(l3)); const unsigned ooff = (unsigned)(qrow + 4 * cg + ((l3 & 15) >> 2)) * (unsigned)A1LD + (unsigned)((g * 4 + (l3 & 3)) * 64 + 4 * (l3 >> 4)); GAS bf16* op = (GAS bf16*)O + ooff;
#pragma unroll
            for (int dg = 0; dg < 4; ++dg) { const f32x4 ov = oL[(dg * 2 + cg) * 64] + st.o[dg][cg] * f; v2u w; w.x = pk2(ov[0], ov[1]); w.y = pk2(ov[2], ov[3]); *(GAS v2u*)(op + 16 * dg) = w; } }
    }
    LDS_WAIT(); asm volatile("" ::: "memory");
}
__device__ __forceinline__ void attn_sample_part(Frame& F, int j) {
    unsigned char* ws = AWS; const bf16* QG = (const bf16*)(ws + WS_QG); const float* qn = AIN(17) + j * 64;
    LAS unsigned* ctr2 = (LAS unsigned*)(F.lds + LDSCTL_OFF + 128) + 2 + j; unsigned si = 0; const int l0 = lane_id();
    if (l0 == 0) si = __hip_atomic_fetch_add(ctr2, 1u, __ATOMIC_RELAXED, __HIP_MEMORY_SCOPE_WORKGROUP);
    const int sidx = __builtin_amdgcn_readfirstlane(si);
    if (sidx < 2) { const int t = F.vcu * 2 + sidx, seq = t >> 2; SeqDesc sd;
        sd.qrow0 = MP + seq * 8; sd.P = PAST; sd.win_blk0 = 24; sd.ncb = 1;
        sd.slc = ws + WS_SLCS + (size_t)t * 33 * FRAGB; sd.win = ws + WS_WINS + (size_t)t * 9 * FRAGB; sd.cmp = ws + WS_CMPS + (size_t)t * FRAGB;
        sd.cnt = nullptr; sd.list = nullptr; sd.parto = nullptr; sd.partml = nullptr;
        attn_full_task(QG, qn, (bf16*)(ws + WS_ACT1), sd, t & 3, F.lds + F.wave * WLDS_BYTES, lane_id());
#if defined(PROBE_SAMP2)
        attn_full_task(QG, qn, (bf16*)(ws + WS_ACT1), sd, t & 3, F.lds + F.wave * WLDS_BYTES, lane_id());
#endif
    }
}
__device__ __forceinline__ void glds16(const void* gsrc, unsigned lds_dst) { unsigned keep;
    asm volatile("s_mov_b32 %0, m0\n\ts_mov_b32 m0, %2\n\ts_nop 0\n\tglobal_load_lds_dwordx4 %1, off\n\ts_mov_b32 m0, %0" : "=&s"(keep) : "v"(gsrc), "s"(lds_dst) : "memory"); }
__device__ __forceinline__ bf16x8 lfrag(const LAS unsigned char* buf, int k, int lane) { return *(const LAS bf16x8*)(buf + k * 1024 + lane * 16); }
template <int MODE>
__device__ __forceinline__ void att_block_lds(const LAS unsigned char* buf, const bf16x8 (&qf)[2][2], int pos0, const int (&lo)[2], const int (&hi)[2], AttState& st, int lane) {
    const int rq = lane >> 4; constexpr float THR = 8.0f;
    typedef float f32x2v __attribute__((ext_vector_type(2)));
    f32x4 s[2][4];
    {
        bf16x8 kf[4][2];
#pragma unroll
        for (int kg = 0; kg < 4; ++kg) { kf[kg][0] = lfrag(buf, kg * 2, lane); kf[kg][1] = lfrag(buf, kg * 2 + 1, lane); }
        if (__all(st.m[0] == 0.f && st.m[1] == 0.f)) {
#pragma unroll
            for (int cg = 0; cg < 2; ++cg)
#pragma unroll
                for (int kg = 0; kg < 4; ++kg) { s[cg][kg] = MFMA16(kf[kg][0], qf[cg][0], ((f32x4){0.f, 0.f, 0.f, 0.f})); s[cg][kg] = MFMA16(kf[kg][1], qf[cg][1], s[cg][kg]); }
        } else {
#pragma unroll
            for (int cg = 0; cg < 2; ++cg) { const float nm = -st.m[cg];
#pragma unroll
                for (int kg = 0; kg < 4; ++kg) { s[cg][kg] = (f32x4){nm, nm, nm, nm}; s[cg][kg] = MFMA16(kf[kg][0], qf[cg][0], s[cg][kg]); s[cg][kg] = MFMA16(kf[kg][1], qf[cg][1], s[cg][kg]); } }
        }
    }
    bf16x8 vf[2][4];
#pragma unroll
    for (int sl = 0; sl < 2; ++sl)
#pragma unroll
        for (int dg = 0; dg < 4; ++dg) vf[sl][dg] = lfrag(buf, 8 + sl * 4 + dg, lane);
#pragma unroll
    for (int cg = 0; cg < 2; ++cg) {
        const int rb = (MODE == 2 ? lo[cg] : hi[cg]) - pos0 - 4 * rq;
        const bool has = MODE == 0 ? true : MODE == 1 ? rb >= 0 : rb <= 51;
        float ls;
        {
            f32x2v a2 = (f32x2v){0.f, 0.f};
#pragma unroll
            for (int kg = 0; kg < 4; ++kg) { f32x4 pv;
#pragma unroll
                for (int i = 0; i < 4; ++i) { pv[i] = __builtin_amdgcn_exp2f(s[cg][kg][i]);
                    if (MODE == 1) pv[i] = (16 * kg + i) <= rb ? pv[i] : 0.f;
                    if (MODE == 2) pv[i] = (16 * kg + i) >= rb ? pv[i] : 0.f; }
                a2 += (f32x2v){pv[0], pv[1]}; a2 += (f32x2v){pv[2], pv[3]}; s[cg][kg] = pv; }
            ls = a2.x + a2.y;
        }
#if defined(PROBE_RARE)
        if (__any(ls >= 0.f)) {
#else
        if (__any(!(ls <= 4096.0f) || (has && ls < 0x1p-30f))) {
#endif
            const float nm = -st.m[cg];
#pragma unroll
            for (int kg = 0; kg < 4; ++kg) { const bf16x8 k0 = lfrag(buf, kg * 2, lane), k1 = lfrag(buf, kg * 2 + 1, lane); s[cg][kg] = (f32x4){nm, nm, nm, nm}; s[cg][kg] = MFMA16(k0, qf[cg][0], s[cg][kg]); s[cg][kg] = MFMA16(k1, qf[cg][1], s[cg][kg]); }
            if (MODE != 0) {
#pragma unroll
                for (int kg = 0; kg < 4; ++kg)
#pragma unroll
                    for (int i = 0; i < 4; ++i) { const bool ok = MODE == 1 ? (16 * kg + i) <= rb : (16 * kg + i) >= rb; s[cg][kg][i] = ok ? s[cg][kg][i] : -INFINITY; } }
            float mx = fmaxf(fmaxf(s[cg][0][0], s[cg][0][1]), fmaxf(s[cg][0][2], s[cg][0][3]));
#pragma unroll
            for (int kg = 1; kg < 4; ++kg) mx = fmaxf(fmaxf(mx, fmaxf(s[cg][kg][0], s[cg][kg][1])), fmaxf(s[cg][kg][2], s[cg][kg][3]));
            if (__any(mx > THR || (mx < -32.0f && mx > -INFINITY))) {
                mx = max_x16_x32(mx); const float lc = sum_x16_x32(st.l[cg]); const float dl = lc > 0.f ? fmaxf(mx, 0.f) : (mx > -INFINITY ? mx : 0.f), alpha = __builtin_amdgcn_exp2f(-dl); st.m[cg] += dl; st.l[cg] *= alpha;
#pragma unroll
                for (int kg = 0; kg < 4; ++kg) s[cg][kg] = s[cg][kg] - dl;
#pragma unroll
                for (int dg = 0; dg < 4; ++dg) st.o[dg][cg] = st.o[dg][cg] * alpha;
            }
            ls = 0.f;
#pragma unroll
            for (int kg = 0; kg < 4; ++kg)
#pragma unroll
                for (int i = 0; i < 4; ++i) { const float p = __builtin_amdgcn_exp2f(s[cg][kg][i]); s[cg][kg][i] = p; ls += p; }
        }
        st.l[cg] += ls;
#pragma unroll
        for (int sl = 0; sl < 2; ++sl) { const bf16x8 pf = pack_p(s[cg][2 * sl], s[cg][2 * sl + 1]);
#pragma unroll
            for (int dg = 0; dg < 4; ++dg) st.o[dg][cg] = MFMA16(vf[sl][dg], pf, st.o[dg][cg]); }
    }
}
__device__ __forceinline__ void att_init0(AttState& st) {
#pragma unroll
    for (int cg = 0; cg < 2; ++cg) { st.m[cg] = 0.f; st.l[cg] = 0.f;
#pragma unroll
        for (int dg = 0; dg < 4; ++dg) st.o[dg][cg] = (f32x4){0.f, 0.f, 0.f, 0.f}; }
}

__device__ __forceinline__ void attn_tile_phase(Frame& F, int j) {
    unsigned char* ws = AWS; const bf16* QG = (const bf16*)(ws + WS_QG); bf16* O = (bf16*)(ws + WS_ACT1); const float* qn = AIN(17) + j * 64;
    const int w = F.wave, bg = F.vcu >> 5, c5 = F.vcu & 31, b = bg >> 2, g = bg & 3;
    const unsigned char* cmpb = ws + WS_CMPP + (size_t)bg * 4 * FRAGB; const unsigned char* slcb = ws + WS_SLCP + (size_t)bg * 128 * FRAGB; const unsigned char* winb = ws + WS_WINP + (size_t)bg * 128 * FRAGB;
    unsigned* cnt = (unsigned*)F.ctl + CW_CNT + (j * 1024 + bg * 128) * CNT_PAD; GAS unsigned* list = (GAS unsigned*)(ws + WS_LIST) + (size_t)bg * 128 * 8192;
    GAS bf16* parto = (GAS bf16*)(ws + WS_PARTO); GAS float* partml = (GAS float*)(ws + WS_PARTML);
    const LAS unsigned char* ring = F.lds; const unsigned lds0 = (unsigned)(unsigned long long)(const LAS void*)F.lds;
    LAS unsigned char* wl = F.lds + 65536 + w * 8448; LAS float* impL = (LAS float*)wl; LAS int* selL = (LAS int*)(wl + 4096);
    int pend_b = -1; unsigned pend_idx = 0u, pend_val = 0u;
#pragma unroll 1
    for (int tile = 0; tile < 4; ++tile) {
        const int lane = lane_id(), col16 = lane & 15, rq = lane >> 4, head = col16 & 3, tk4 = col16 >> 2;
        const int cur = tile == 0 ? c5 : tile == 1 ? 63 - c5 : tile == 2 ? 64 + c5 : 127 - c5;
        const int oc = 8 * cur + w, t0 = 8 * oc, qrow = b * SEQ + t0;
        const int n1 = ((2 * cur + 1) >> 6) + 1, nf = cur >= 2 ? 3 : cur + 1, wb0 = cur > 8 ? cur - 8 : 0, nw = cur - wb0 + 1, nsteps = 2 * n1 + nf + nw;
#define STEP_PTR(s_) ((s_) < 2 * n1 ? cmpb + (size_t)((s_) < n1 ? (s_) : (s_) - n1) * FRAGB : (s_) < 2 * n1 + nf ? slcb + (size_t)((s_) == 2 * n1 ? 0 : ((s_) == 2 * n1 + nf - 1 ? cur : cur - 1)) * FRAGB : winb + (size_t)(wb0 + (s_) - 2 * n1 - nf) * FRAGB)
#define ISSUE(s_) do { const unsigned char* gp_ = STEP_PTR(s_) + (size_t)(2 * w) * 1024 + lane * 16; const unsigned ld_ = lds0 + (unsigned)(((s_) & 3) * 16384 + 2 * w * 1024); glds16(gp_, ld_); glds16(gp_ + 1024, ld_ + 1024); } while (0)
        bf16x8 qf[2][2]; int tcol[2];
        v4u qr[2][2];
#pragma unroll
        for (int cg = 0; cg < 2; ++cg) { tcol[cg] = t0 + 4 * cg + tk4; load_q_raw(QG, qrow + 4 * cg + tk4, g * 4 + head, rq, qr[cg][0], qr[cg][1]); }
        float gl[2][3];
#pragma unroll
        for (int cg = 0; cg < 2; ++cg) { const GAS bf16* gp = (const GAS bf16*)QG + (size_t)(qrow + 4 * cg + tk4) * QGLD + 1024 + (g * 4 + head) * 3;
#pragma unroll
            for (int br = 0; br < 3; ++br) gl[cg][br] = bf2f(gp[br]); }
#pragma unroll
        for (int cg = 0; cg < 2; ++cg) norm_q(qr[cg][0], qr[cg][1], qn, rq, qf[cg]);
        asm volatile("s_waitcnt vmcnt(0) lgkmcnt(0)\n\ts_barrier" ::: "memory");
        if (pend_b >= 0) list[(size_t)pend_b * 8192 + pend_idx] = pend_val;
        ISSUE(0); if (1 < nsteps) ISSUE(1); if (2 < nsteps) ISSUE(2);
        int hic[2]; hic[0] = ((tcol[0] + 1) >> 5) - 1; hic[1] = ((tcol[1] + 1) >> 5) - 1;
        float m[2] = {0.f, 0.f}, l[2] = {0.f, 0.f}, linv[2] = {0.f, 0.f};
        const int hmin = ((t0 + 1) >> 5) - 1;
        bool atom_out = false;
        LAS v2u* oLp = (LAS v2u*)(wl + 4352) + lane;
#if defined(PROBE_V0)
#define STEP_HEAD(s_) do { asm volatile("s_waitcnt vmcnt(0)\n\ts_barrier" ::: "memory"); if ((s_) + 3 < nsteps) ISSUE((s_) + 3); } while (0)
#else
#define STEP_HEAD(s_) do { if ((s_) + 2 < nsteps) asm volatile("s_waitcnt vmcnt(4)\n\ts_barrier" ::: "memory"); \
            else if ((s_) + 1 < nsteps) asm volatile("s_waitcnt vmcnt(2)\n\ts_barrier" ::: "memory"); \
            else if (atom_out) asm volatile("s_waitcnt vmcnt(1)\n\ts_barrier" ::: "memory"); else asm volatile("s_waitcnt vmcnt(0)\n\ts_barrier" ::: "memory"); \
            if ((s_) + 3 < nsteps) ISSUE((s_) + 3); } while (0)
#endif
#if defined(PROBE_SK)
        { for (int s2 = 0; s2 < nsteps; ++s2) { STEP_HEAD(s2); }
          asm volatile("s_waitcnt vmcnt(0) lgkmcnt(0)\n\ts_barrier" ::: "memory"); ISSUE(0); if (1 < nsteps) ISSUE(1); if (2 < nsteps) ISSUE(2); }
#endif
        int s = 0;
#pragma unroll 1
        for (; s < n1; ++s) {
            STEP_HEAD(s); const LAS unsigned char* buf = ring + (s & 3) * 16384;
            const int cb = s; bf16x8 kf[4][2];
#pragma unroll
            for (int kg = 0; kg < 4; ++kg) { kf[kg][0] = lfrag(buf, kg * 2, lane); kf[kg][1] = lfrag(buf, kg * 2 + 1, lane); }
            const bool full = 64 * cb + 63 <= hmin;
            const bool mz = __all(m[0] == 0.f && m[1] == 0.f);
#pragma unroll
            for (int cg = 0; cg < 2; ++cg) {
                typedef float f32x2v __attribute__((ext_vector_type(2)));
                f32x4 sc[4]; const float nm = -m[cg];
                if (mz) {
#pragma unroll
                    for (int kg = 0; kg < 4; ++kg) { sc[kg] = MFMA16(kf[kg][0], qf[cg][0], ((f32x4){0.f, 0.f, 0.f, 0.f})); sc[kg] = MFMA16(kf[kg][1], qf[cg][1], sc[kg]); }
                } else {
#pragma unroll
                    for (int kg = 0; kg < 4; ++kg) { sc[kg] = (f32x4){nm, nm, nm, nm}; sc[kg] = MFMA16(kf[kg][0], qf[cg][0], sc[kg]); sc[kg] = MFMA16(kf[kg][1], qf[cg][1], sc[kg]); } }
                const int rb = hic[cg] - 64 * cb - 4 * rq; const bool has = full || rb >= 0;
                f32x2v a2 = (f32x2v){0.f, 0.f};
                if (full) {
#pragma unroll
                    for (int kg = 0; kg < 4; ++kg) { f32x4 pv;
#pragma unroll
                        for (int i = 0; i < 4; ++i) pv[i] = __builtin_amdgcn_exp2f(sc[kg][i]);
                        a2 += (f32x2v){pv[0], pv[1]}; a2 += (f32x2v){pv[2], pv[3]}; }
                } else {
#pragma unroll
                    for (int kg = 0; kg < 4; ++kg) { f32x4 pv;
#pragma unroll
                        for (int i = 0; i < 4; ++i) { pv[i] = __builtin_amdgcn_exp2f(sc[kg][i]); pv[i] = (16 * kg + i) <= rb ? pv[i] : 0.f; }
                        a2 += (f32x2v){pv[0], pv[1]}; a2 += (f32x2v){pv[2], pv[3]}; } }
                float ls = a2.x + a2.y;
#if defined(PROBE_RARE)
                if (__any(ls >= 0.f)) {
#else
                if (__any(!(ls <= 4096.0f) || (has && ls < 0x1p-30f))) {
#endif
#pragma unroll
                    for (int kg = 0; kg < 4; ++kg) { sc[kg] = (f32x4){nm, nm, nm, nm}; sc[kg] = MFMA16(kf[kg][0], qf[cg][0], sc[kg]); sc[kg] = MFMA16(kf[kg][1], qf[cg][1], sc[kg]); }
#pragma unroll
                    for (int kg = 0; kg < 4; ++kg)
#pragma unroll
                        for (int i = 0; i < 4; ++i) sc[kg][i] = (16 * kg + i) <= rb ? sc[kg][i] : -INFINITY;
                    float mx = fmaxf(fmaxf(sc[0][0], sc[0][1]), fmaxf(sc[0][2], sc[0][3]));
#pragma unroll
                    for (int kg = 1; kg < 4; ++kg) mx = fmaxf(fmaxf(mx, fmaxf(sc[kg][0], sc[kg][1])), fmaxf(sc[kg][2], sc[kg][3]));
                    if (__any(mx > 8.0f || (mx < -32.0f && mx > -INFINITY))) { mx = max_x16_x32(mx); const float lc = sum_x16_x32(l[cg]); const float dl = lc > 0.f ? fmaxf(mx, 0.f) : (mx > -INFINITY ? mx : 0.f); m[cg] += dl; l[cg] *= __builtin_amdgcn_exp2f(-dl);
#pragma unroll
                        for (int kg = 0; kg < 4; ++kg) sc[kg] = sc[kg] - dl; }
                    ls = 0.f;
#pragma unroll
                    for (int kg = 0; kg < 4; ++kg)
#pragma unroll
                        for (int i = 0; i < 4; ++i) ls += __builtin_amdgcn_exp2f(sc[kg][i]);
                }
                l[cg] += ls;
            }
        }
#pragma unroll
        for (int cg = 0; cg < 2; ++cg) { float lt = l[cg]; lt = sum_x16_x32(lt); linv[cg] = lt > 0.f ? 1.0f / lt : 0.f; }
        {
            f32x4 outv[4][2];
#pragma unroll
            for (int dg = 0; dg < 4; ++dg) { outv[dg][0] = (f32x4){0.f, 0.f, 0.f, 0.f}; outv[dg][1] = (f32x4){0.f, 0.f, 0.f, 0.f}; }
#pragma unroll 1
            for (; s < 2 * n1; ++s) {
                STEP_HEAD(s); const LAS unsigned char* buf = ring + (s & 3) * 16384;
                const int cb = s - n1; bf16x8 kf[4][2], vf[2][4];
                const bool mz2 = __all(m[0] == 0.f && m[1] == 0.f);
#pragma unroll
                for (int kg = 0; kg < 4; ++kg) { kf[kg][0] = lfrag(buf, kg * 2, lane); kf[kg][1] = lfrag(buf, kg * 2 + 1, lane); }
#pragma unroll
                for (int sl = 0; sl < 2; ++sl)
#pragma unroll
                    for (int dg = 0; dg < 4; ++dg) vf[sl][dg] = lfrag(buf, 8 + sl * 4 + dg, lane);
#pragma unroll
                for (int cg = 0; cg < 2; ++cg) {
                    f32x4 sc[4];
#pragma unroll
                    for (int kg = 0; kg < 4; ++kg) { const float nm = -m[cg];
                        if (mz2) sc[kg] = MFMA16(kf[kg][0], qf[cg][0], ((f32x4){0.f, 0.f, 0.f, 0.f})); else { sc[kg] = (f32x4){nm, nm, nm, nm}; sc[kg] = MFMA16(kf[kg][0], qf[cg][0], sc[kg]); }
                        sc[kg] = MFMA16(kf[kg][1], qf[cg][1], sc[kg]); }
                    if (64 * cb + 63 > hmin) {
#pragma unroll
                        for (int kg = 0; kg < 4; ++kg)
#pragma unroll
                            for (int i = 0; i < 4; ++i) sc[kg][i] = (16 * kg + i) <= hic[cg] - 64 * cb - 4 * rq ? sc[kg][i] : -INFINITY; }
#pragma unroll
                    for (int kg = 0; kg < 4; ++kg) {
#pragma unroll
                        for (int i = 0; i < 4; ++i) sc[kg][i] = __builtin_amdgcn_exp2f(sc[kg][i]) * linv[cg];
                        float e0 = sc[kg][0] + sc[kg][1], e1 = sc[kg][2] + sc[kg][3];
                        e0 = sum4(e0); e1 = sum4(e1);
                        if (head == 0) { LAS float* ip = impL + (4 * cg + tk4) * 128 + 32 * cb + 8 * kg + 2 * rq; ip[0] = e0; ip[1] = e1; }
                    }
#pragma unroll
                    for (int sl = 0; sl < 2; ++sl) { const bf16x8 pf = pack_p(sc[2 * sl], sc[2 * sl + 1]);
#pragma unroll
                        for (int dg = 0; dg < 4; ++dg) outv[dg][cg] = MFMA16(vf[sl][dg], pf, outv[dg][cg]); }
                }
            }
#pragma unroll
            for (int cg = 0; cg < 2; ++cg) { const float gt = 1.0f / (1.0f + __expf(-gl[cg][0]));
#pragma unroll
                for (int dg = 0; dg < 4; ++dg) { const f32x4 ov = outv[dg][cg] * gt; v2u wv; wv.x = pk2(ov[0], ov[1]); wv.y = pk2(ov[2], ov[3]); oLp[(dg * 2 + cg) * 64] = wv; } }
        }
        LDS_WAIT(); asm volatile("" ::: "memory");
#if defined(PROBE_TK)
        for (int rep_ = 0; rep_ < 3; ++rep_)
#endif
        {
            const int tok = lane >> 3, j8 = lane & 7; float v[16];
#pragma unroll
            for (int k = 0; k < 16; ++k) { const int bb = 16 * j8 + k; const float x = impL[tok * 128 + bb]; v[k] = (bb >= 1 && bb <= cur - 2) ? x : -1.f; }
#pragma unroll
            for (int r = 0; r < 5; ++r) {
                float best = v[0]; int bi = 0;
#pragma unroll
                for (int k = 1; k < 16; ++k) if (v[k] > best) { best = v[k]; bi = k; }
                int gi = 16 * j8 + bi;
#pragma unroll
                for (int st_ = 0; st_ < 3; ++st_) { const float ov = st_ == 0 ? DPP_F(best, DPP_XOR1) : st_ == 1 ? DPP_F(best, DPP_XOR2) : DPP_F(best, DPP_HMIRROR);
                    const int oi = st_ == 0 ? DPP_I(gi, DPP_XOR1) : st_ == 1 ? DPP_I(gi, DPP_XOR2) : DPP_I(gi, DPP_HMIRROR); if (ov > best || (ov == best && oi < gi)) { best = ov; gi = oi; } }
                if (j8 == 0) selL[tok * 8 + r] = best >= 0.f ? gi : -1;
                if ((gi >> 4) == j8) {
#pragma unroll
                    for (int k = 0; k < 16; ++k) if ((gi & 15) == k) v[k] = -1.f; }
            }
        }
        LDS_WAIT(); asm volatile("" ::: "memory");
        int ent_b = -1; unsigned ent_idx = 0u, ent_val = 0u;
        if (lane < 40) { const int tok = lane / 5, r = lane - tok * 5, bb = selL[tok * 8 + r]; const size_t row = (size_t)(qrow + tok);
            if (bb >= 0) { ent_b = bb; ent_val = (unsigned)(t0 + tok) | ((unsigned)r << 16); }
            else {
#pragma unroll
                for (int h = 0; h < 4; ++h) { GAS float* mlp = partml + ((row * 6 + r) * 16 + g * 4 + h) * 2; mlp[0] = -1e30f; mlp[1] = 0.f; } } }
        {
            AttState st; att_init0(st);
            int lo[2] = {0, 0}, hi[2] = {tcol[0], tcol[1]};
            const int sw = 2 * n1 + nf;
            const int sa = nsteps - 3 > 2 * n1 ? nsteps - 3 : 2 * n1;
            const bool anyv = __any(ent_b >= 0);
#pragma unroll 1
            for (; s < nsteps; ++s) {
                if (s == sw) {
#pragma unroll
                    for (int cg = 0; cg < 2; ++cg) { float lt = st.l[cg]; lt = sum_x16_x32(lt); const size_t pi = ((size_t)(qrow + 4 * cg + tk4) * 6 + 5) * 16 + g * 4 + head;
                        if (rq == 0) { GAS float* mlp = partml + pi * 2; mlp[0] = st.m[cg]; mlp[1] = lt; }
#pragma unroll
                        for (int dg = 0; dg < 4; ++dg) { v2u wv; wv.x = pk2(st.o[dg][cg][0], st.o[dg][cg][1]); wv.y = pk2(st.o[dg][cg][2], st.o[dg][cg][3]); stg_put(wl, cg * 16 + col16, dg, rq, wv); } }
                    LDS_WAIT(); asm volatile("" ::: "memory");
                    { const int c_ = lane >> 1, tk_ = 4 * (c_ >> 4) + ((c_ & 15) >> 2), hd_ = c_ & 3; GAS bf16* pp = parto + ((((size_t)(qrow + tk_) * 6 + 5) * 16 + g * 4 + hd_) * 64) + (lane & 1) * 32;
#pragma unroll
                      for (int k = 0; k < 4; ++k) *(GAS v4u*)(pp + 8 * k) = stg_get(wl, lane, k); }
                    LDS_WAIT(); asm volatile("" ::: "memory");
                    att_init0(st); lo[0] = tcol[0] - 512; lo[1] = tcol[1] - 512;
                }
                STEP_HEAD(s); const LAS unsigned char* buf = ring + (s & 3) * 16384;
                if (s == sa && anyv) { if (ent_b >= 0) ent_idx = atomicAdd(cnt + ent_b * CNT_PAD, 1u); atom_out = true; }
                int blk, mode;
                if (s < sw) { const int fs = s - 2 * n1; blk = fs == 0 ? 0 : (fs == nf - 1 ? cur : cur - 1); mode = (blk == cur || blk == 0) ? 1 : 0; }
                else { blk = wb0 + (s - sw); mode = blk == cur ? 1 : (cur >= 8 && blk == wb0) ? 2 : 0; }
                if (mode == 1) att_block_lds<1>(buf, qf, 64 * blk, lo, hi, st, lane); else if (mode == 2) att_block_lds<2>(buf, qf, 64 * blk, lo, hi, st, lane); else att_block_lds<0>(buf, qf, 64 * blk, lo, hi, st, lane);
            }
            v2u ow[2][4];
#pragma unroll
            for (int cg = 0; cg < 2; ++cg) { float lt = st.l[cg]; lt = sum_x16_x32(lt); const float f = (1.0f / (1.0f + __expf(-gl[cg][2]))) / lt;
#pragma unroll
                for (int dg = 0; dg < 4; ++dg) { const v2u pv = oLp[(dg * 2 + cg) * 64]; const f32x4 ov = (f32x4){bflo(pv.x), bfhi(pv.x), bflo(pv.y), bfhi(pv.y)} + st.o[dg][cg] * f;
                    ow[cg][dg].x = pk2(ov[0], ov[1]); ow[cg][dg].y = pk2(ov[2], ov[3]); } }
            LDS_WAIT(); asm volatile("" ::: "memory");
#pragma unroll
            for (int cg = 0; cg < 2; ++cg)
#pragma unroll
                for (int dg = 0; dg < 4; ++dg) stg_put(wl, cg * 16 + col16, dg, rq, ow[cg][dg]);
            LDS_WAIT(); asm volatile("" ::: "memory");
            { const int c_ = lane >> 1, tk_ = 4 * (c_ >> 4) + ((c_ & 15) >> 2), hd_ = c_ & 3; GAS bf16* op = (GAS bf16*)O + (size_t)(qrow + tk_) * A1LD + (g * 4 + hd_) * 64 + (lane & 1) * 32;
#pragma unroll
              for (int k = 0; k < 4; ++k) *(GAS v4u*)(op + 8 * k) = stg_get(wl, lane, k); }
            LDS_WAIT(); asm volatile("" ::: "memory");
        }
        pend_b = ent_b; pend_idx = ent_idx; pend_val = ent_val;
#undef STEP_HEAD
#undef STEP_PTR
#undef ISSUE
    }
    if (pend_b >= 0) list[(size_t)pend_b * 8192 + pend_idx] = pend_val;
    asm volatile("s_waitcnt vmcnt(0) lgkmcnt(0)\n\ts_barrier" ::: "memory");
}
#ifndef MK_FUSED
#define MK_FUSED 1
#endif
constexpr int NPHASE = 26;
#ifndef MK_STREAMK
#define MK_STREAMK 0
#endif
#if MK_STREAMK
#define ORDER_T pg8::StreamOrder
#define ORDER_INIT(M_, N_, K_, G_, v_, slab_, fl_, tmo_, ep_) S.init(M_, N_, K_, G_, v_, slab_, fl_, tmo_, ep_)
#else
#define ORDER_T pg8::StaticOrder
#define ORDER_INIT(M_, N_, K_, G_, v_, slab_, fl_, tmo_, ep_) S.init(M_, N_, G_, (int)blockIdx.x, K_)
#endif
__global__ void __launch_bounds__(NWAVES * 64, 2) yoco_fwd(Args args) {
    extern __shared__ __attribute__((aligned(16))) unsigned char lds[];
    Frame F;
    F.lds = (LAS unsigned char*)lds;
    F.MISC = (volatile LAS unsigned*)(F.lds + MISC_OFF);
    const int tid0 = threadIdx.x; F.wave = __builtin_amdgcn_readfirstlane(tid0 >> 6);
    { const int bx = blockIdx.x; F.vcu = (bx % 8) * (GRID / 8) + bx / 8; }

    if (tid0 < 25) { const unsigned long long* ka = (const unsigned long long*)__builtin_amdgcn_kernarg_segment_ptr();
        *(LAS unsigned long long*)(F.lds + ARGS_OFF + 8 * tid0) = ka[tid0]; }
    if (tid0 < 128) ((LAS unsigned*)(F.lds + LDSCTL_OFF))[tid0] = 0u;
    __syncthreads();
    F.ctl = (gu32*)(AWS + WS_CTL);
    XcdBarrier bar; bar.bar = (unsigned*)(F.ctl + CW_BAR); bar.x = 0; bar.st = nullptr;
    if (MK_FUSED) bar = xcd_barrier_post((unsigned*)(F.ctl + CW_BAR), F.MISC + 8);
#if MK_FUSED
    constexpr int lo = 0, hi = NPHASE;
#else
    const int lo = args.ph_lo, hi = args.ph_hi;
#endif
#if MK_FUSED && !defined(MK_PHMASK)
#define IN(k) ((k) < NPHASE)
#else
#ifndef MK_PHMASK
#define MK_PHMASK 0x3ffffff
#endif
#define IN(k) (((MK_PHMASK >> ((k) < NPHASE ? (k) : 0)) & 1) && lo <= (k) && (k) < hi)
#endif
#ifndef PROBE_REP
#define PROBE_REP -1
#endif
#define NREP(k) ((k) == PROBE_REP ? 2 : 1)
#define NREP_S(k) ((k) + 100 == PROBE_REP ? 4 : 1)
#define SEAM(k) do { if (IN(k) && IN((k) + 1)) { XcdBarrier b2_ = bar; asm volatile("" : "+s"(b2_.bar), "+s"(b2_.x)); xcd_barrier(b2_); } } while (0)
#define PHASE_PTRS unsigned char* ws = AWS; float* Y = AOUT; \
    bf16* XB = (bf16*)(ws + WS_XB); float* SSQ0 = (float*)(ws + WS_SSQ); float* SSQ1 = SSQ0 + (size_t)M * 32; \
    bf16* ACT1 = (bf16*)(ws + WS_ACT1); bf16* BIG16 = (bf16*)(ws + WS_BIG); bf16* QGB = (bf16*)(ws + WS_QG); \
    (void)XB; (void)SSQ0; (void)SSQ1; (void)ACT1; (void)BIG16; (void)QGB; (void)Y;
    typedef pg8::EpiScaleBf16<0> EpiS0; typedef pg8::EpiScaleBf16<1> EpiS1;

    if (IN(0)) { for (int rep = 0; rep < NREP(0); ++rep) { p0_prologue(F); __syncthreads(); } } SEAM(0);

    for (int l = 0; l < 2; ++l) {
        const int pb = 1 + 5 * l;
        if (IN(pb)) { PHASE_PTRS const int EPOCH = 2 * (pb) + 1;
            pg8::Gemm g{XB, (const bf16*)(ws + WS_WIN) + (size_t)l * 3072 * WLD1, MP, 3072, D, XBLD, WLD1}; ORDER_T S; ORDER_INIT(MP, 3072, D, F.G, F.vcu, (float*)(ws + WS_SLAB + (size_t)(EPOCH & 1) * 64 * MiB), (unsigned*)F.ctl + CW_SLABF, (unsigned*)F.ctl + CW_TMO, (unsigned)(EPOCH));
            pg8::PreRstd<ORDER_T> PR{(LAS float*)(F.lds + RING_BYTES), SSQ0, &S, F.wave}; EpiS0 E{BIG16, BCXLD, (const LAS float*)(F.lds + RING_BYTES)};
            for (int rep = 0; rep < NREP(pb); ++rep) pg8::gemm_phase<EpiS0, ORDER_T, true, true, pg8::NoSide, pg8::PreRstd<ORDER_T>>(F.lds, g, S, E, F.wave, pg8::NoSide(), PR);
            { pg8::SEpiScaleBf16 SE{BIG16, BCXLD, SSQ0, 0}; pg8::sgemm_phase(F.lds, g.A, g.lda, g.Bt, g.ldb, D, 3072, MP, MS, SE, F.wave, F.vcu, F.G); }
        } SEAM(pb);
        if (IN(pb + 1)) { for (int rep = 0; rep < NREP(pb + 1); ++rep) conv_phase(F, l); } SEAM(pb + 1);
        if (IN(pb + 2)) { PHASE_PTRS const int EPOCH = 2 * (pb + 2) + 1;
            pg8::Gemm g{ACT1, (const bf16*)(ws + WS_WOUT) + (size_t)l * D * WLD1, MP, D, D, A1LD, WLD1}; ORDER_T S; ORDER_INIT(MP, D, D, F.G, F.vcu, (float*)(ws + WS_SLAB + (size_t)(EPOCH & 1) * 64 * MiB), (unsigned*)F.ctl + CW_SLABF, (unsigned*)F.ctl + CW_TMO, (unsigned)(EPOCH));
            pg8::EpiRes E{l == 0 ? AIN(0) : nullptr, l == 0 ? AIN(1) : nullptr, XB, nullptr, SSQ1};
            pg8::gemm_phase<pg8::EpiRes, ORDER_T, true, true>(F.lds, g, S, E, F.wave);
            { pg8::SEpiRes SE{l == 0 ? AIN(1) - (size_t)MP * D : nullptr, XB, nullptr, SSQ1}; pg8::sgemm_phase(F.lds, g.A, g.lda, g.Bt, g.ldb, D, D, MP, MS, SE, F.wave, F.vcu, F.G); }
        } SEAM(pb + 2);
        if (IN(pb + 3)) { PHASE_PTRS const int EPOCH = 2 * (pb + 3) + 1;
            pg8::Gemm g{XB, (const bf16*)(ws + WS_WUP) + (size_t)l * FF * WLD1, MP, FF, D, XBLD, WLD1}; ORDER_T S; ORDER_INIT(MP, FF, D, F.G, F.vcu, (float*)(ws + WS_SLAB + (size_t)(EPOCH & 1) * 64 * MiB), (unsigned*)F.ctl + CW_SLABF, (unsigned*)F.ctl + CW_TMO, (unsigned)(EPOCH));
            pg8::PreRstd<ORDER_T> PR{(LAS float*)(F.lds + RING_BYTES), SSQ1, &S, F.wave}; EpiS1 E{BIG16, HLD, (const LAS float*)(F.lds + RING_BYTES)};
            for (int rep = 0; rep < NREP(pb + 3); ++rep) pg8::gemm_phase<EpiS1, ORDER_T, true, true, pg8::NoSide, pg8::PreRstd<ORDER_T>>(F.lds, g, S, E, F.wave, pg8::NoSide(), PR);
            { pg8::SEpiScaleBf16 SE{BIG16, HLD, SSQ1, 1}; for (int rep = 0; rep < NREP_S(pb + 3); ++rep) pg8::sgemm_phase(F.lds, g.A, g.lda, g.Bt, g.ldb, D, FF, MP, MS, SE, F.wave, F.vcu, F.G); }
        } SEAM(pb + 3);
        if (IN(pb + 4)) { PHASE_PTRS const int EPOCH = 2 * (pb + 4) + 1;
            pg8::Gemm g{BIG16, (const bf16*)(ws + WS_WDN) + (size_t)l * D * WLD4, MP, D, FF, HLD, WLD4}; ORDER_T S; ORDER_INIT(MP, D, FF, F.G, F.vcu, (float*)(ws + WS_SLAB + (size_t)(EPOCH & 1) * 64 * MiB), (unsigned*)F.ctl + CW_SLABF, (unsigned*)F.ctl + CW_TMO, (unsigned)(EPOCH));
            pg8::EpiRes E{nullptr, nullptr, XB, nullptr, SSQ0};
            pg8::gemm_phase<pg8::EpiRes, ORDER_T, true, true>(F.lds, g, S, E, F.wave);
            { pg8::SEpiRes SE{nullptr, XB, nullptr, SSQ0}; pg8::sgemm_phase(F.lds, g.A, g.lda, g.Bt, g.ldb, FF, D, MP, MS, SE, F.wave, F.vcu, F.G); }
        } SEAM(pb + 4);
    }
    if (IN(11)) { PHASE_PTRS
        const int sv = (int)blockIdx.x >= 128 ? (int)blockIdx.x - 128 : (1 << 28), sG = 128;
        { const int EPOCH = 23; pg8::Gemm g{XB, (const bf16*)(ws + WS_WKV), MP, 1536, D, XBLD, WLD1}; ORDER_T S; ORDER_INIT(MP, 1536, D, F.G, F.vcu, (float*)(ws + WS_SLAB + (size_t)(EPOCH & 1) * 64 * MiB), (unsigned*)F.ctl + CW_SLABF, (unsigned*)F.ctl + CW_TMO, (unsigned)(EPOCH));
          pg8::PreRstd<ORDER_T> PR{(LAS float*)(F.lds + RING_BYTES), SSQ0, &S, F.wave}; pg8::EpiScaleF32 E{(float*)(ws + WS_BIG), KVRLD, (const LAS float*)(F.lds + RING_BYTES)};
          pg8::gemm_phase<pg8::EpiScaleF32, ORDER_T, true, true, pg8::NoSide, pg8::PreRstd<ORDER_T>>(F.lds, g, S, E, F.wave, pg8::NoSide(), PR);
          pg8::SEpiScaleF32 SE{(float*)(ws + WS_BIG), KVRLD, SSQ0}; pg8::sgemm_phase(F.lds, g.A, g.lda, g.Bt, g.ldb, D, 1536, MP, MS, SE, F.wave, sv, sG); }
        { const int EPOCH = 24; pg8::Gemm g{XB, (const bf16*)(ws + WS_WQG), MP, D, D, XBLD, WLD1}; ORDER_T S; ORDER_INIT(MP, D, D, F.G, F.vcu, (float*)(ws + WS_SLAB + (size_t)(EPOCH & 1) * 64 * MiB), (unsigned*)F.ctl + CW_SLABF, (unsigned*)F.ctl + CW_TMO, (unsigned)(EPOCH));
          pg8::PreRstd<ORDER_T> PR{(LAS float*)(F.lds + RING_BYTES), SSQ0, &S, F.wave}; EpiS0 E{QGB, QGLD, (const LAS float*)(F.lds + RING_BYTES)};
          pg8::gemm_phase<EpiS0, ORDER_T, true, true, pg8::NoSide, pg8::PreRstd<ORDER_T>>(F.lds, g, S, E, F.wave, pg8::NoSide(), PR);
          pg8::SEpiScaleBf16 SE{QGB, QGLD, SSQ0, 0}; pg8::sgemm_phase(F.lds, g.A, g.lda, g.Bt, g.ldb, D, D, MP, MS, SE, F.wave, sv, sG);
          pg8::SEpiScaleBf16 SG{QGB + 1024, QGLD, SSQ0, 0}; pg8::sgemm_phase(F.lds, g.A, g.lda, g.Bt + (size_t)1024 * WLD1, g.ldb, D, 64, 0, M, SG, F.wave, sv, sG); }
    } SEAM(11);
    if (IN(12)) { for (int rep = 0; rep < NREP(12); ++rep) kvfin_phase(F); } SEAM(12);
    for (int j = 0; j < 2; ++j) {
        const int pb = 13 + 7 * j;
        if (j == 1) {
            if (IN(19)) { PHASE_PTRS const int EPOCH = 2 * (19) + 1; pg8::Gemm g{XB, (const bf16*)(ws + WS_WQG) + (size_t)NQG * WLD1, MP, D, D, XBLD, WLD1}; ORDER_T S; ORDER_INIT(MP, D, D, F.G, F.vcu, (float*)(ws + WS_SLAB + (size_t)(EPOCH & 1) * 64 * MiB), (unsigned*)F.ctl + CW_SLABF, (unsigned*)F.ctl + CW_TMO, (unsigned)(EPOCH));
                pg8::PreRstd<ORDER_T> PR{(LAS float*)(F.lds + RING_BYTES), SSQ0, &S, F.wave}; EpiS0 E{QGB, QGLD, (const LAS float*)(F.lds + RING_BYTES)};
                pg8::gemm_phase<EpiS0, ORDER_T, true, true, pg8::NoSide, pg8::PreRstd<ORDER_T>>(F.lds, g, S, E, F.wave, pg8::NoSide(), PR);
                pg8::SEpiScaleBf16 SE{QGB, QGLD, SSQ0, 0}; pg8::sgemm_phase(F.lds, g.A, g.lda, g.Bt, g.ldb, D, D, MP, MS, SE, F.wave, F.vcu, F.G);
          pg8::SEpiScaleBf16 SG{QGB + 1024, QGLD, SSQ0, 0}; pg8::sgemm_phase(F.lds, g.A, g.lda, g.Bt + (size_t)1024 * WLD1, g.ldb, D, 64, 0, M, SG, F.wave, F.vcu, F.G); }
            SEAM(19);
        }
        const int pa = pb;
        if (IN(pa)) {
#if defined(PROBE_A1)
            attn_tile_phase(F, j);
            { XcdBarrier b2_ = bar; asm volatile("" : "+s"(b2_.bar), "+s"(b2_.x)); xcd_barrier(b2_); }
            { const int t_ = (int)blockIdx.x * 512 + F.wave * 64 + lane_id(); if (t_ < 1024) ((unsigned*)F.ctl + CW_CNT + j * 1024 * CNT_PAD)[t_ * CNT_PAD] = 0u; }
            { XcdBarrier b2_ = bar; asm volatile("" : "+s"(b2_.bar), "+s"(b2_.x)); xcd_barrier(b2_); }
#endif
            attn_tile_phase(F, j); } SEAM(pa);
        if (IN(pa + 1)) {
#if defined(PROBE_A2)
#if PROBE_A2 == 2
            attn_sparse_phase(F, j);
#else
            attn_sample_part(F, j); attn_sparse_phase(F, j);
#endif
            { XcdBarrier b2_ = bar; asm volatile("" : "+s"(b2_.bar), "+s"(b2_.x)); xcd_barrier(b2_); }
            { const int t_ = F.wave * 64 + lane_id(); if (blockIdx.x == 0 && t_ < 8) ((unsigned*)F.ctl + CW_DQ)[64 * (8 * j + t_)] = 0u; if (t_ == 0) ((LAS unsigned*)(F.lds + LDSCTL_OFF + 128))[2 + j] = 0u; }
            { XcdBarrier b2_ = bar; asm volatile("" : "+s"(b2_.bar), "+s"(b2_.x)); xcd_barrier(b2_); }
#endif
            attn_sample_part(F, j); attn_sparse_phase(F, j); } SEAM(pa + 1);
        if (IN(pa + 2)) {
#if defined(PROBE_ATT) && PROBE_ATT == 2
            attn_combine_phase(F, j, true);
#endif
            attn_combine_phase(F, j); } SEAM(pa + 2);
        const int l = 2 + j;
        if (IN(pa + 3)) { PHASE_PTRS const int EPOCH = 2 * (pa + 3) + 1;
            pg8::Gemm g{ACT1, (const bf16*)(ws + WS_WO) + (size_t)j * D * WLD1, MP, D, D, A1LD, WLD1}; ORDER_T S; ORDER_INIT(MP, D, D, F.G, F.vcu, (float*)(ws + WS_SLAB + (size_t)(EPOCH & 1) * 64 * MiB), (unsigned*)F.ctl + CW_SLABF, (unsigned*)F.ctl + CW_TMO, (unsigned)(EPOCH));
            pg8::EpiRes E{nullptr, nullptr, XB, nullptr, SSQ1};
            pg8::gemm_phase<pg8::EpiRes, ORDER_T, true, true>(F.lds, g, S, E, F.wave);
            { pg8::SEpiRes SE{nullptr, XB, nullptr, SSQ1}; pg8::sgemm_phase(F.lds, g.A, g.lda, g.Bt, g.ldb, D, D, MP, MS, SE, F.wave, F.vcu, F.G); }
        } SEAM(pa + 3);
        if (IN(pa + 4)) { PHASE_PTRS const int EPOCH = 2 * (pa + 4) + 1;
            pg8::Gemm g{XB, (const bf16*)(ws + WS_WUP) + (size_t)l * FF * WLD1, MP, FF, D, XBLD, WLD1}; ORDER_T S; ORDER_INIT(MP, FF, D, F.G, F.vcu, (float*)(ws + WS_SLAB + (size_t)(EPOCH & 1) * 64 * MiB), (unsigned*)F.ctl + CW_SLABF, (unsigned*)F.ctl + CW_TMO, (unsigned)(EPOCH));
            pg8::PreRstd<ORDER_T> PR{(LAS float*)(F.lds + RING_BYTES), SSQ1, &S, F.wave}; EpiS1 E{BIG16, HLD, (const LAS float*)(F.lds + RING_BYTES)};
            pg8::gemm_phase<EpiS1, ORDER_T, true, true, pg8::NoSide, pg8::PreRstd<ORDER_T>>(F.lds, g, S, E, F.wave, pg8::NoSide(), PR);
            { pg8::SEpiScaleBf16 SE{BIG16, HLD, SSQ1, 1}; pg8::sgemm_phase(F.lds, g.A, g.lda, g.Bt, g.ldb, D, FF, MP, MS, SE, F.wave, F.vcu, F.G); }
        } SEAM(pa + 4);
        if (IN(pa + 5)) { PHASE_PTRS const int EPOCH = 2 * (pa + 5) + 1;
            pg8::Gemm g{BIG16, (const bf16*)(ws + WS_WDN) + (size_t)l * D * WLD4, MP, D, FF, HLD, WLD4}; ORDER_T S; ORDER_INIT(MP, D, FF, F.G, F.vcu, (float*)(ws + WS_SLAB + (size_t)(EPOCH & 1) * 64 * MiB), (unsigned*)F.ctl + CW_SLABF, (unsigned*)F.ctl + CW_TMO, (unsigned)(EPOCH));
            pg8::EpiRes E{nullptr, nullptr, XB, j == 1 ? Y : nullptr, SSQ0};
            pg8::gemm_phase<pg8::EpiRes, ORDER_T, true, true>(F.lds, g, S, E, F.wave);
            { pg8::SEpiRes SE{nullptr, XB, j == 1 ? Y : nullptr, SSQ0}; pg8::sgemm_phase(F.lds, g.A, g.lda, g.Bt, g.ldb, FF, D, MP, MS, SE, F.wave, F.vcu, F.G); }
        } SEAM(pa + 5);
    }
#if defined(PROBE_BARS)
    for (int pbi = 0; pbi < PROBE_BARS; ++pbi) { XcdBarrier b2_ = bar; asm volatile("" : "+s"(b2_.bar), "+s"(b2_.x)); xcd_barrier(b2_); }
#endif
#undef IN
#undef SEAM
}

extern "C" void kernel_launch(void* const* d_in, const int* in_sizes, int n_in, void* d_out, int out_size, void* d_ws, size_t ws_size, hipStream_t stream) {
    static int grid = 0;
    if (grid == 0) {
        if (n_in != 22 || out_size != (int)O_END || ws_size < WS_END) { fprintf(stderr, "kernel_launch: unexpected shapes (n_in %d, out %d, ws %zu)\n", n_in, out_size, ws_size); grid = -1; return; }
        int dev = 0, cus = 0, per_cu = 0;
        if (hipGetDevice(&dev) != hipSuccess || hipDeviceGetAttribute(&cus, hipDeviceAttributeMultiprocessorCount, dev) != hipSuccess) { grid = -1; return; }
        if (hipFuncSetAttribute((const void*)yoco_fwd, hipFuncAttributeMaxDynamicSharedMemorySize, LDS_BYTES) != hipSuccess) { fprintf(stderr, "kernel_launch: hipFuncSetAttribute failed\n"); grid = -1; return; }
        if (hipOccupancyMaxActiveBlocksPerMultiprocessor(&per_cu, (const void*)yoco_fwd, NWAVES * 64, LDS_BYTES) != hipSuccess || per_cu < 1) fprintf(stderr, "kernel_launch: occupancy query reports %d blocks per CU\n", per_cu);
        (void)hipGetLastError();
        if (cus < GRID) { fprintf(stderr, "kernel_launch: needs %d CUs, device has %d\n", GRID, cus); grid = -1; return; }
        grid = GRID;
    }
    if (grid < 0) return;
    (void)hipMemsetAsync((char*)d_ws + WS_CTL, 0, CTL_ZERO_BYTES, stream);
    Args a{};
    for (int i = 0; i < 22; ++i) a.in[i] = (const float*)d_in[i];
    a.page_table = (const int*)d_in[6];
    a.out = (float*)d_out; a.ws = (unsigned char*)d_ws;
#if MK_FUSED
    a.ph_lo = 0; a.ph_hi = NPHASE;
    hipLaunchKernelGGL(yoco_fwd, dim3(grid), dim3(NWAVES * 64), LDS_BYTES, stream, a);
#else
    for (int p = 0; p < NPHASE; ++p) { a.ph_lo = p; a.ph_hi = p + 1; hipLaunchKernelGGL(yoco_fwd, dim3(grid), dim3(NWAVES * 64), LDS_BYTES, stream, a); }
#endif
}
```

```cpp
#include <hip/hip_runtime.h>
#include <cstdio>
#include <cstdint>
#include <cmath>
namespace pg8 {
#define PG8_LAS __attribute__((address_space(3)))
typedef unsigned short bf16_t;
typedef short bf16x8 __attribute__((ext_vector_type(8)));
typedef float f32x4 __attribute__((ext_vector_type(4)));
typedef unsigned u32x4 __attribute__((ext_vector_type(4)));
#if !defined(PG8_WGM)
#define PG8_WGM 8
#endif
constexpr int BM = 256, BK = 64, HALF = 128, HTB = HALF * BK * 2  , STAGE_BYTES = 8 * HTB, NXCD = 8, WGM = PG8_WGM;

__host__ __device__ __forceinline__ int lds_byte(int r, int c) { const int st = (r >> 4) * 2 + (c >> 5), rr = r & 15, cc = c & 31, ob = rr * 64 + cc * 2; return st * 1024 + (ob ^ (((ob >> 9) & 1) << 5)); }
__host__ __device__ __forceinline__ void stage_rc(int b, int& R, int& C) { const int st = b / 1024, sb = b % 1024, swz = sb ^ (((sb >> 9) & 1) << 5); R = (st >> 1) * 16 + swz / 64; C = (st & 1) * 32 + (swz % 64) / 2; }
__host__ __device__ __forceinline__ int perm32(int rho) { const int n = rho >> 4, i = rho & 15; return 8 * (i >> 2) + 4 * n + (i & 3); }

struct Unit { int pm, pn, kt0, nkt, kind, slab, ri; };
struct Gemm { const bf16_t* A; const bf16_t* Bt; int M, N, K, lda, ldb; };

struct StaticOrder {
    int nM, nN, nwg, G, c, nK;
    __host__ __device__ void init(int M, int N, int G_, int c_, int K = 1024) { nM = M / BM; nN = N / BM; nwg = nM * nN; G = G_; c = c_; nK = K / BK; }
    template <class A> __device__ __forceinline__ void slab_store(const A&, const Unit&, int, int) const {}
    __device__ __forceinline__ void acc_init(f32x4 (&acc)[2][2][4][2], const Unit&, int, int) const {
#pragma unroll
        for (int a = 0; a < 2; ++a)
#pragma unroll
            for (int b = 0; b < 2; ++b)
#pragma unroll
                for (int m = 0; m < 4; ++m)
#pragma unroll
                    for (int n = 0; n < 2; ++n) acc[a][b][m][n] = (f32x4){0.f, 0.f, 0.f, 0.f}; }

    __host__ __device__ bool next(int i, Unit& u) const {
        const long L = (long)i * G + c; if (L >= nwg) return false;
        int wgid = (int)L; { const int q = nwg / NXCD, r = nwg % NXCD, xcd = wgid % NXCD, off = wgid / NXCD; wgid = (xcd < r ? xcd * (q + 1) : r * (q + 1) + (xcd - r) * q) + off; }
        const int nig = WGM * nN, gid = wgid / nig, fm = gid * WGM, gsz = (nM - fm) < WGM ? (nM - fm) : WGM;
        u.pm = fm + ((wgid % nig) % gsz); u.pn = (wgid % nig) / gsz; u.kt0 = 0; u.nkt = nK; u.kind = 0; u.slab = 0; u.ri = i; return true;
    }
    __device__ __forceinline__ void a_ready(const Unit&) const {}
    __device__ __forceinline__ void done(const Unit&) const {}
};

__device__ __forceinline__ unsigned cvt_pk_bf16(float lo, float hi) { unsigned r; asm volatile("v_cvt_pk_bf16_f32 %0, %1, %2" : "=v"(r) : "v"(lo), "v"(hi)); return r; }
typedef float f32x2 __attribute__((ext_vector_type(2)));
constexpr int MPROMPT = 16384, XBLD = 1024;
#define PG8_GAS __attribute__((address_space(1)))
__device__ __forceinline__ float pg8_sum4rows(float x) {
    auto a = __builtin_amdgcn_permlane16_swap(__float_as_uint(x), __float_as_uint(x), false, false); x = __uint_as_float(a[0]) + __uint_as_float(a[1]);
    auto b = __builtin_amdgcn_permlane32_swap(__float_as_uint(x), __float_as_uint(x), false, false); return __uint_as_float(b[0]) + __uint_as_float(b[1]);
}
template <int NR>
__device__ __forceinline__ void rstd_rows(const float* ssq, int row0, int q4, float (&rs)[NR]) {
    const PG8_GAS f32x4* base = (const PG8_GAS f32x4*)ssq + 2 * q4;
    f32x4 t[NR][2];
#pragma unroll
    for (int i = 0; i < NR; ++i) { const PG8_GAS f32x4* p = base + (size_t)(row0 + 16 * i) * 8; t[i][0] = p[0]; t[i][1] = p[1]; }
#pragma unroll
    for (int i = 0; i < NR; ++i) { const f32x4 u = t[i][0] + t[i][1]; const float s = pg8_sum4rows((u[0] + u[1]) + (u[2] + u[3])); rs[i] = 1.0f / sqrtf(s * (1.0f / 1024.0f) + 1e-6f); }
}
template <class Sched>
__device__ __forceinline__ void prep_rstd(PG8_LAS float* rl, const float* ssq, const Sched& S, int wave_id) {
    int lane; asm volatile("v_mbcnt_lo_u32_b32 %0, -1, 0\n\tv_mbcnt_hi_u32_b32 %0, -1, %0" : "=v"(lane));
    const int t = wave_id * 64 + lane; Unit u;
#pragma unroll 1
    for (int i = 0; S.next(i, u); ++i) {
        if (t < 256) { const PG8_GAS f32x4* p = (const PG8_GAS f32x4*)ssq + (size_t)(u.pm * BM + t) * 8;
            f32x4 a = (p[0] + p[1]) + (p[2] + p[3]); a += (p[4] + p[5]) + (p[6] + p[7]);
            rl[i * 256 + t] = 1.0f / sqrtf(((a[0] + a[1]) + (a[2] + a[3])) * (1.0f / 1024.0f) + 1e-6f); }
    }
    __syncthreads();
}
template <class Sched> struct PreRstd { PG8_LAS float* rl; const float* ssq; const Sched* S; int wave_id;
    __device__ __forceinline__ void operator()() const { prep_rstd(rl, ssq, *S, wave_id); } };
template <int ACT> struct EpiScaleBf16 {
    static constexpr bool PERM = true, AFTER_DRAIN = false;
    bf16_t* O; int ldc; const PG8_LAS float* rl;
    __device__ __forceinline__ void operator()(const f32x4 (&acc)[2][2][4][2], const Unit& u, int wr, int wc, int fr, int fq) const {
        const int row0 = u.pm * BM + wr * 64 + fr, col0 = u.pn * BM + wc * 32 + 8 * fq;
        const PG8_LAS float* rp = rl + u.ri * 256 + wr * 64 + fr;
#pragma unroll
        for (int ai = 0; ai < 2; ++ai)
#pragma unroll
            for (int m = 0; m < 4; ++m) { const int row = row0 + ai * HALF + m * 16; const float r = rp[ai * HALF + m * 16]; PG8_GAS bf16_t* rowp = (PG8_GAS bf16_t*)O + (size_t)row * ldc + col0;
#pragma unroll
                for (int bj = 0; bj < 2; ++bj) { f32x4 v0 = acc[ai][bj][m][0] * r, v1 = acc[ai][bj][m][1] * r;
                    if (ACT == 1) {
#pragma unroll
                        for (int e = 0; e < 4; ++e) { const float a0 = fmaxf(v0[e], 0.f), a1 = fmaxf(v1[e], 0.f); v0[e] = a0 * a0; v1[e] = a1 * a1; } }
                    u32x4 w; w.x = cvt_pk_bf16(v0[0], v0[1]); w.y = cvt_pk_bf16(v0[2], v0[3]); w.z = cvt_pk_bf16(v1[0], v1[1]); w.w = cvt_pk_bf16(v1[2], v1[3]);
                    *(PG8_GAS u32x4*)(rowp + bj * HALF) = w; } }
    }
};
struct EpiScaleF32 {
    static constexpr bool PERM = true, AFTER_DRAIN = false;
    float* O; int ldc; const PG8_LAS float* rl;
    __device__ __forceinline__ void operator()(const f32x4 (&acc)[2][2][4][2], const Unit& u, int wr, int wc, int fr, int fq) const {
        const int row0 = u.pm * BM + wr * 64 + fr, col0 = u.pn * BM + wc * 32 + 8 * fq;
        const PG8_LAS float* rp = rl + u.ri * 256 + wr * 64 + fr;
#pragma unroll
        for (int ai = 0; ai < 2; ++ai)
#pragma unroll
            for (int m = 0; m < 4; ++m) { const int row = row0 + ai * HALF + m * 16; const float r = rp[ai * HALF + m * 16]; PG8_GAS float* rowp = (PG8_GAS float*)O + (size_t)row * ldc + col0;
#pragma unroll
                for (int bj = 0; bj < 2; ++bj)
#pragma unroll
                    for (int n = 0; n < 2; ++n) *(PG8_GAS f32x4*)(rowp + bj * HALF + n * 4) = acc[ai][bj][m][n] * r; }
    }
};
struct EpiRes {
    static constexpr bool PERM = true, AFTER_DRAIN = false;
    const float* base32_p; const float* base32_s; bf16_t* xb; float* out32; float* ssq_out;
    __device__ __forceinline__ void operator()(const f32x4 (&acc)[2][2][4][2], const Unit& u, int wr, int wc, int fr, int fq) const {
        const int row0 = u.pm * BM + wr * 64 + fr, col0 = u.pn * BM + wc * 32 + 8 * fq;
#pragma unroll
        for (int ai = 0; ai < 2; ++ai)
            {
                f32x4 rv[4][2][2];
#pragma unroll
                for (int q = 0; q < 4; ++q) { const int row = row0 + ai * HALF + q * 16;
                    if (base32_p) { const PG8_GAS float* b = (const PG8_GAS float*)(row < MPROMPT ? base32_p + (size_t)row * 1024 : base32_s + (size_t)(row - MPROMPT) * 1024) + col0;
#pragma unroll
                        for (int bj = 0; bj < 2; ++bj)
#pragma unroll
                            for (int n = 0; n < 2; ++n) rv[q][bj][n] = *(const PG8_GAS f32x4*)(b + bj * HALF + n * 4);
                    } else { const PG8_GAS bf16_t* b = (const PG8_GAS bf16_t*)xb + (size_t)row * XBLD + col0;
#pragma unroll
                        for (int bj = 0; bj < 2; ++bj) { const u32x4 w = *(const PG8_GAS u32x4*)(b + bj * HALF);
                            rv[q][bj][0] = (f32x4){__uint_as_float(w.x << 16), __uint_as_float(w.x & 0xffff0000u), __uint_as_float(w.y << 16), __uint_as_float(w.y & 0xffff0000u)};
                            rv[q][bj][1] = (f32x4){__uint_as_float(w.z << 16), __uint_as_float(w.z & 0xffff0000u), __uint_as_float(w.w << 16), __uint_as_float(w.w & 0xffff0000u)}; } } }
#pragma unroll
                for (int q = 0; q < 4; ++q) { const int m = q, row = row0 + ai * HALF + m * 16;
                    PG8_GAS bf16_t* xo = (PG8_GAS bf16_t*)xb + (size_t)row * XBLD + col0;
#pragma unroll
                    for (int bj = 0; bj < 2; ++bj) { const f32x4 x0 = rv[q][bj][0] + acc[ai][bj][m][0], x1 = rv[q][bj][1] + acc[ai][bj][m][1];
                        if (out32) { PG8_GAS f32x4* o = (PG8_GAS f32x4*)((PG8_GAS float*)out32 + (size_t)row * 1024 + col0 + bj * HALF); o[0] = x0; o[1] = x1; }
                        else { float ss = ((x0[0] * x0[0] + x0[1] * x0[1]) + (x0[2] * x0[2] + x0[3] * x0[3])) + ((x1[0] * x1[0] + x1[1] * x1[1]) + (x1[2] * x1[2] + x1[3] * x1[3]));
                            u32x4 w; w.x = cvt_pk_bf16(x0[0], x0[1]); w.y = cvt_pk_bf16(x0[2], x0[3]); w.z = cvt_pk_bf16(x1[0], x1[1]); w.w = cvt_pk_bf16(x1[2], x1[3]); *(PG8_GAS u32x4*)(xo + bj * HALF) = w;
                            ss = pg8_sum4rows(ss);
                            if (fq == 0) ((PG8_GAS float*)ssq_out)[(size_t)row * 32 + u.pn * 8 + bj * 4 + wc] = ss; } } }
                }
    }
};
struct StreamOrder {
    int nM, nN, nwg, np, lo, hi, u0, G, v, nstat, base;
    float* slab; unsigned* flags; unsigned* tmo; unsigned epoch;
    __device__ __forceinline__ int bound(int c) const { long b = (long)c * ((long)(nwg - base) * np) / G; const int r = (int)(b % np); if (r == 1) b -= 1; else if (r == np - 1) b += 1; return (int)b; }
    __device__ __forceinline__ void init(int M, int N, int K, int G_, int v_, float* slab_, unsigned* flags_, unsigned* tmo_, unsigned epoch_) {
        nM = M / BM; nN = N / BM; nwg = nM * nN; np = K / (2 * BK); G = G_; v = v_; nstat = nwg / G - 1; if (nstat < 0) nstat = 0; base = nstat * G;
        lo = bound(v); hi = bound(v + 1); u0 = lo / np; slab = slab_; flags = flags_; tmo = tmo_; epoch = epoch_; }
    __device__ __forceinline__ void unit_of(int L, Unit& u) const {
        const int nig = WGM * nN, gid = L / nig, fm = gid * WGM, gsz = (nM - fm) < WGM ? (nM - fm) : WGM;
        const int rem = L - gid * nig, gsh = gsz == WGM ? 3 : (gsz == 4 ? 2 : (gsz == 2 ? 1 : 0));
        u.pm = fm + (rem & (gsz - 1)); u.pn = rem >> gsh; }
    __device__ __forceinline__ bool next(int i, Unit& u) const {
        if (i < nstat) { unit_of(i * G + v, u); u.kt0 = 0; u.nkt = 2 * np; u.kind = 0; u.slab = 0; u.ri = i; return true; }
        const int Lr = u0 + (i - nstat), s0 = Lr * np, L = base + Lr; if (L >= nwg) return false;
        const int p0 = (lo > s0 ? lo : s0) - s0, p1 = (hi < s0 + np ? hi : s0 + np) - s0; if (p1 <= p0) return false;
        unit_of(L, u); u.kt0 = 2 * p0; u.nkt = 2 * (p1 - p0);
        u.kind = p0 > 0 ? 1 : (p1 < np ? 2 : 0); u.slab = p0 > 0 ? v : v + 1; u.ri = i; return true;
    }
    __device__ __forceinline__ void a_ready(const Unit&) const {}
    __device__ __forceinline__ void done(const Unit&) const {}
    __device__ __forceinline__ void slab_store(const f32x4 (&acc)[2][2][4][2], const Unit& u, int wid, int lane) const {
        const __amdgpu_buffer_rsrc_t rs = __builtin_amdgcn_make_buffer_rsrc(slab, 0, G * 8 * 32 * 1024, 0x00020000);
        const unsigned so = (unsigned)((u.slab * 8 + wid) * 32) * 1024u, vo = (unsigned)lane * 16u;
#pragma unroll
        for (int a = 0; a < 2; ++a)
#pragma unroll
            for (int b = 0; b < 2; ++b)
#pragma unroll
                for (int m = 0; m < 4; ++m)
#pragma unroll
                    for (int n = 0; n < 2; ++n) __builtin_amdgcn_raw_buffer_store_b128(__builtin_bit_cast(u32x4, acc[a][b][m][n]), rs, vo + (unsigned)(((a * 2 + b) * 4 + m) * 2 + n) * 1024u, so,   16);
        asm volatile("s_waitcnt vmcnt(0)" ::: "memory");
        if (lane == 0) __hip_atomic_store(flags + 64 * u.slab + wid, epoch, __ATOMIC_RELAXED, __HIP_MEMORY_SCOPE_AGENT);
    }
    __device__ __forceinline__ void acc_init(f32x4 (&acc)[2][2][4][2], const Unit& u, int wid, int lane) const {
#pragma unroll
        for (int a = 0; a < 2; ++a)
#pragma unroll
            for (int b = 0; b < 2; ++b)
#pragma unroll
                for (int m = 0; m < 4; ++m)
#pragma unroll
                    for (int n = 0; n < 2; ++n) acc[a][b][m][n] = (f32x4){0.f, 0.f, 0.f, 0.f};
        if (u.kind != 2) return;
        unsigned* fw = flags + 64 * u.slab + wid; unsigned sp = 0;
        while ((unsigned)__builtin_amdgcn_readfirstlane(__hip_atomic_load(fw, __ATOMIC_RELAXED, __HIP_MEMORY_SCOPE_AGENT)) < epoch) {
            __builtin_amdgcn_s_sleep(2);
            if ((++sp & 255u) == 0u) { if (__hip_atomic_load(tmo, __ATOMIC_RELAXED, __HIP_MEMORY_SCOPE_AGENT) != 0u) break; if (sp > (1u << 20)) { if (lane == 0) __hip_atomic_store(tmo, 1u, __ATOMIC_RELAXED, __HIP_MEMORY_SCOPE_AGENT); break; } }
        }
        __builtin_amdgcn_fence(__ATOMIC_ACQUIRE, "agent");
        asm volatile("s_waitcnt vmcnt(0)" ::: "memory");
        const __amdgpu_buffer_rsrc_t rs = __builtin_amdgcn_make_buffer_rsrc(slab, 0, G * 8 * 32 * 1024, 0x00020000);
        const unsigned so = (unsigned)((u.slab * 8 + wid) * 32) * 1024u, vo = (unsigned)lane * 16u;
#pragma unroll
        for (int a = 0; a < 2; ++a)
#pragma unroll
            for (int b = 0; b < 2; ++b)
#pragma unroll
                for (int m = 0; m < 4; ++m)
#pragma unroll
                    for (int n = 0; n < 2; ++n) acc[a][b][m][n] = __builtin_bit_cast(f32x4, __builtin_amdgcn_raw_buffer_load_b128(rs, vo, so + (unsigned)(((a * 2 + b) * 4 + m) * 2 + n) * 1024u, 0));
    }
};
struct SEpiScaleBf16 { bf16_t* O; int ldc; const float* ssq; int act;
    __device__ __forceinline__ void operator()(const f32x4 (&acc)[2][2], int row0, int col0, int lane) const {
        float rs[2]; rstd_rows<2>(ssq, row0 + (lane & 15), lane >> 4, rs);
#pragma unroll
        for (int mi = 0; mi < 2; ++mi) { const int row = row0 + 16 * mi + (lane & 15); u32x4 w;
#pragma unroll
            for (int ni = 0; ni < 2; ++ni) { f32x4 v = acc[mi][ni] * rs[mi];
                if (act) {
#pragma unroll
                    for (int e = 0; e < 4; ++e) { const float a = fmaxf(v[e], 0.f); v[e] = a * a; } }
                if (ni == 0) { w.x = cvt_pk_bf16(v[0], v[1]); w.y = cvt_pk_bf16(v[2], v[3]); } else { w.z = cvt_pk_bf16(v[0], v[1]); w.w = cvt_pk_bf16(v[2], v[3]); } }
            *(PG8_GAS u32x4*)((PG8_GAS bf16_t*)O + (size_t)row * ldc + col0 + 8 * (lane >> 4)) = w; }
    }
};
struct SEpiScaleF32 { float* O; int ldc; const float* ssq;
    __device__ __forceinline__ void operator()(const f32x4 (&acc)[2][2], int row0, int col0, int lane) const {
        float rs[2]; rstd_rows<2>(ssq, row0 + (lane & 15), lane >> 4, rs);
#pragma unroll
        for (int mi = 0; mi < 2; ++mi) { const int row = row0 + 16 * mi + (lane & 15);
#pragma unroll
            for (int ni = 0; ni < 2; ++ni) *(PG8_GAS f32x4*)((PG8_GAS float*)O + (size_t)row * ldc + col0 + 8 * (lane >> 4) + 4 * ni) = acc[mi][ni] * rs[mi]; }
    }
};
struct SEpiRes { const float* base32; bf16_t* xb; float* out32; float* ssq_out;
    __device__ __forceinline__ void operator()(const f32x4 (&acc)[2][2], int row0, int col0, int lane) const {
        f32x4 rv[2][2]; const int colq = col0 + 8 * (lane >> 4);
#pragma unroll
        for (int mi = 0; mi < 2; ++mi) { const int row = row0 + 16 * mi + (lane & 15);
            if (base32) { rv[mi][0] = *(const PG8_GAS f32x4*)((const PG8_GAS float*)base32 + (size_t)row * 1024 + colq); rv[mi][1] = *(const PG8_GAS f32x4*)((const PG8_GAS float*)base32 + (size_t)row * 1024 + colq + 4); }
            else { const u32x4 w = *(const PG8_GAS u32x4*)((const PG8_GAS bf16_t*)xb + (size_t)row * XBLD + colq);
                rv[mi][0] = (f32x4){__uint_as_float(w.x << 16), __uint_as_float(w.x & 0xffff0000u), __uint_as_float(w.y << 16), __uint_as_float(w.y & 0xffff0000u)};
                rv[mi][1] = (f32x4){__uint_as_float(w.z << 16), __uint_as_float(w.z & 0xffff0000u), __uint_as_float(w.w << 16), __uint_as_float(w.w & 0xffff0000u)}; } }
#pragma unroll
        for (int mi = 0; mi < 2; ++mi) { const int row = row0 + 16 * mi + (lane & 15);
            const f32x4 x0 = rv[mi][0] + acc[mi][0], x1 = rv[mi][1] + acc[mi][1];
            if (out32) { PG8_GAS f32x4* o = (PG8_GAS f32x4*)((PG8_GAS float*)out32 + (size_t)row * 1024 + colq); o[0] = x0; o[1] = x1; }
            else { float ss = ((x0[0] * x0[0] + x0[1] * x0[1]) + (x0[2] * x0[2] + x0[3] * x0[3])) + ((x1[0] * x1[0] + x1[1] * x1[1]) + (x1[2] * x1[2] + x1[3] * x1[3]));
                u32x4 w; w.x = cvt_pk_bf16(x0[0], x0[1]); w.y = cvt_pk_bf16(x0[2], x0[3]); w.z = cvt_pk_bf16(x1[0], x1[1]); w.w = cvt_pk_bf16(x1[2], x1[3]);
                *(PG8_GAS u32x4*)((PG8_GAS bf16_t*)xb + (size_t)row * XBLD + colq) = w;
                ss = pg8_sum4rows(ss);
                if ((lane >> 4) == 0) ((PG8_GAS float*)ssq_out)[(size_t)row * 32 + (col0 >> 5)] = ss; } }
    }
};
template <class Epi, int NT>
__device__ __forceinline__ void sgemm_tiles(PG8_LAS unsigned char* lds, const bf16_t* A, int lda, const bf16_t* Bt, int ldb, int nch, int trow, const int (&tcol)[2], const Epi& E, int wave_id, int lane) {
    const int tid = wave_id * 64 + lane;
    const int wr = wave_id & 1, wc = (wave_id >> 1) & 1, wk = wave_id >> 2, m16 = lane & 15, kq = lane >> 4;
    constexpr int PITCH = 272, MATB = 64 * PITCH, BUFB = (1 + NT) * MATB;
    PG8_LAS f32x4* red = (PG8_LAS f32x4*)(lds + 2 * BUFB) + (wave_id & 3) * (256 * NT) + lane;
    const int lr = tid >> 4, lc = tid & 15;
    const unsigned wofs = (unsigned)(lr * PITCH + lc * 16);
    const unsigned aofs = (unsigned)((32 * wr + m16) * PITCH + wk * 128 + kq * 16), bofs = (unsigned)(MATB + (32 * wc + m16) * PITCH + wk * 128 + kq * 16);
    const PG8_GAS bf16_t* ag = (const PG8_GAS bf16_t*)A + (size_t)(trow + lr) * lda + lc * 8;
    const PG8_GAS bf16_t* bg[NT];
#pragma unroll
    for (int nt = 0; nt < NT; ++nt) bg[nt] = (const PG8_GAS bf16_t*)Bt + (size_t)(tcol[nt] + perm32(lr)) * ldb + lc * 8;
    const size_t r32a = (size_t)32 * lda, r32b = (size_t)32 * ldb;
    f32x4 acc[NT][2][2];
#pragma unroll
    for (int nt = 0; nt < NT; ++nt)
#pragma unroll
        for (int mi = 0; mi < 2; ++mi)
#pragma unroll
            for (int ni = 0; ni < 2; ++ni) acc[nt][mi][ni] = (f32x4){0.f, 0.f, 0.f, 0.f};
    u32x4 ring[4][2 + 2 * NT];
#define SG_ISSUE(slot, c) do { ring[slot][0] = *(const PG8_GAS u32x4*)(ag + (c) * 128); ring[slot][1] = *(const PG8_GAS u32x4*)(ag + r32a + (c) * 128); \
        _Pragma("unroll") for (int nt_ = 0; nt_ < NT; ++nt_) { ring[slot][2 + 2 * nt_] = *(const PG8_GAS u32x4*)(bg[nt_] + (c) * 128); ring[slot][3 + 2 * nt_] = *(const PG8_GAS u32x4*)(bg[nt_] + r32b + (c) * 128); } } while (0)
    SG_ISSUE(0, 0); SG_ISSUE(1, 1); SG_ISSUE(2, 2);
#pragma unroll 1
    for (int c0 = 0; c0 < nch; c0 += 4) {
#pragma unroll
        for (int j = 0; j < 4; ++j) { const int c = c0 + j;
            if (c + 3 < nch) SG_ISSUE((j + 3) & 3, c + 3);
            PG8_LAS unsigned char* buf = lds + (j & 1) * BUFB;
            *(PG8_LAS u32x4*)(buf + wofs) = ring[j][0]; *(PG8_LAS u32x4*)(buf + wofs + 32 * PITCH) = ring[j][1];
#pragma unroll
            for (int nt = 0; nt < NT; ++nt) { *(PG8_LAS u32x4*)(buf + (1 + nt) * MATB + wofs) = ring[j][2 + 2 * nt]; *(PG8_LAS u32x4*)(buf + (1 + nt) * MATB + wofs + 32 * PITCH) = ring[j][3 + 2 * nt]; }
            __syncthreads();
            bf16x8 af[2][2];
#pragma unroll
            for (int ks = 0; ks < 2; ++ks)
#pragma unroll
                for (int h = 0; h < 2; ++h) af[ks][h] = *(const PG8_LAS bf16x8*)(buf + aofs + h * 16 * PITCH + ks * 64);
#pragma unroll
            for (int nt = 0; nt < NT; ++nt) { bf16x8 bf[2][2];
#pragma unroll
                for (int ks = 0; ks < 2; ++ks)
#pragma unroll
                    for (int h = 0; h < 2; ++h) bf[ks][h] = *(const PG8_LAS bf16x8*)(buf + nt * MATB + bofs + h * 16 * PITCH + ks * 64);
#pragma unroll
                for (int ks = 0; ks < 2; ++ks)
#pragma unroll
                    for (int mi = 0; mi < 2; ++mi)
#pragma unroll
                        for (int ni = 0; ni < 2; ++ni) acc[nt][mi][ni] = __builtin_amdgcn_mfma_f32_16x16x32_bf16(bf[ks][ni], af[ks][mi], acc[nt][mi][ni], 0, 0, 0); }
        }
    }
#undef SG_ISSUE
    if constexpr (NT == 2) {
        const int give = wk == 0 ? 1 : 0, keep = 1 - give;
        PG8_LAS f32x4* rq = (PG8_LAS f32x4*)(lds + 2 * BUFB) + ((wave_id & 3) * 2 + give) * 256 + lane;
        PG8_LAS f32x4* rk = (PG8_LAS f32x4*)(lds + 2 * BUFB) + ((wave_id & 3) * 2 + keep) * 256 + lane;
#pragma unroll
        for (int mi = 0; mi < 2; ++mi)
#pragma unroll
            for (int ni = 0; ni < 2; ++ni) rq[(mi * 2 + ni) * 64] = give == 1 ? acc[1][mi][ni] : acc[0][mi][ni];
        __syncthreads();
        f32x4 fin[2][2];
#pragma unroll
        for (int mi = 0; mi < 2; ++mi)
#pragma unroll
            for (int ni = 0; ni < 2; ++ni) fin[mi][ni] = (keep == 1 ? acc[1][mi][ni] : acc[0][mi][ni]) + rk[(mi * 2 + ni) * 64];
        E(fin, trow + 32 * wr, tcol[keep] + 32 * wc, lane);
        __syncthreads();
    } else {
        if (wk == 1) {
#pragma unroll
            for (int mi = 0; mi < 2; ++mi)
#pragma unroll
                for (int ni = 0; ni < 2; ++ni) red[(mi * 2 + ni) * 64] = acc[0][mi][ni]; }
        __syncthreads();
        if (wk == 0) {
#pragma unroll
            for (int mi = 0; mi < 2; ++mi)
#pragma unroll
                for (int ni = 0; ni < 2; ++ni) acc[0][mi][ni] += red[(mi * 2 + ni) * 64];
            E(acc[0], trow + 32 * wr, tcol[0] + 32 * wc, lane); }
        __syncthreads();
    }
}
template <class Epi>
__device__ __forceinline__ void sgemm_phase(PG8_LAS unsigned char* lds, const bf16_t* A, int lda, const bf16_t* Bt, int ldb, int K, int N, int row_base, int nrows, const Epi& E, int wave_id, int vcu, int G) {
    int lane; asm volatile("v_mbcnt_lo_u32_b32 %0, -1, 0\n\tv_mbcnt_hi_u32_b32 %0, -1, %0" : "=v"(lane));
    const int tm = nrows / 64, ntile = tm * (N / 64), nch = K / 128;
    const bool pair = (G % tm) == 0;
    int t = vcu;
#pragma unroll 1
    for (; pair && t + G < ntile; t += 2 * G) { const int tc[2] = {(t / tm) * 64, ((t + G) / tm) * 64};
        sgemm_tiles<Epi, 2>(lds, A, lda, Bt, ldb, nch, row_base + (t % tm) * 64, tc, E, wave_id, lane); }
#pragma unroll 1
    for (; t < ntile; t += G) { const int tc[2] = {(t / tm) * 64, 0};
        sgemm_tiles<Epi, 1>(lds, A, lda, Bt, ldb, nch, row_base + (t % tm) * 64, tc, E, wave_id, lane); }
}
struct NoSide { __device__ __forceinline__ void operator()(int, int, int) const {} };
struct NoPre { __device__ __forceinline__ void operator()() const {} };
template <class Epi, class Sched, bool ALIGN_EPI = false, bool SP2 = false, class Side = NoSide, class Pre = NoPre>
__device__ __forceinline__ void gemm_phase(PG8_LAS unsigned char* lds, const Gemm g, const Sched& S, const Epi& E, int wave_id, const Side& W = Side(), const Pre& P = Pre()) {
    int tid_; asm volatile("v_mbcnt_lo_u32_b32 %0, -1, 0\n\tv_mbcnt_hi_u32_b32 %0, -1, %0" : "=v"(tid_)); tid_ += wave_id * 64;
    const int tid = tid_, wid = __builtin_amdgcn_readfirstlane(tid >> 6), lane = tid & 63, wr = wid >> 2, wc = wid & 3, fr = lane & 15, fq = lane >> 4;
    const int K = g.K; int nt;
    unsigned voffA[2], voffB[2];
#pragma unroll
    for (int i = 0; i < 2; ++i) { int R, C; stage_rc(tid * 16 + i * 8192, R, C); const int Rb = Epi::PERM ? ((R & ~31) + perm32(R & 31)) : R;
        voffA[i] = (unsigned)(R * g.lda + C) * 2u; voffB[i] = (unsigned)(Rb * g.ldb + C) * 2u; }
    const size_t kstep = (size_t)(BK * 2);
    const size_t hstepA = (size_t)HALF * g.lda * 2, hstepB = (size_t)HALF * g.ldb * 2;
    const size_t tstepA = 2 * hstepA, tstepB = 2 * hstepB;
    const unsigned ldsw = (unsigned)wid * 1024u;
    const int aoff = lds_byte(wr * 64 + fr, fq * 8), boff = lds_byte(wc * 32 + fr, fq * 8);
#define PG8_SA(b, h) (((b) * 2 + (h)) * HTB)
#define PG8_SB(b, h) ((4 + (b) * 2 + (h)) * HTB)
#define PG8_STAGE(bufoff, gbase, voff) do { _Pragma("unroll") for (int _i = 0; _i < 2; ++_i) \
        __builtin_amdgcn_global_load_lds((const unsigned*)((const char*)(gbase) + (voff)[_i]), (PG8_LAS unsigned*)(lds + (bufoff) + ldsw + _i * 8192), 16, 0, 0); } while (0)
#define PG8_LDA(dst, b, h) do { _Pragma("unroll") for (int m = 0; m < 4; ++m) _Pragma("unroll") for (int k = 0; k < 2; ++k) dst[m][k] = *(const PG8_LAS bf16x8*)(lds + PG8_SA(b, h) + aoff + m * 2048 + k * 1024); } while (0)
#define PG8_LDB(dst, b, h) do { _Pragma("unroll") for (int n = 0; n < 2; ++n) _Pragma("unroll") for (int k = 0; k < 2; ++k) dst[n][k] = *(const PG8_LAS bf16x8*)(lds + PG8_SB(b, h) + boff + n * 2048 + k * 1024); } while (0)
#define PG8_MMA(ai, bj, At, Bt) do { __builtin_amdgcn_s_setprio(1); _Pragma("unroll") for (int m = 0; m < 4; ++m) _Pragma("unroll") for (int n = 0; n < 2; ++n) _Pragma("unroll") for (int k = 0; k < 2; ++k) \
        acc[ai][bj][m][n] = __builtin_amdgcn_mfma_f32_16x16x32_bf16(Bt[n][k], At[m][k], acc[ai][bj][m][n], 0, 0, 0); __builtin_amdgcn_s_setprio(0); } while (0)
#define PG8_WAIT_V(n) asm volatile("s_waitcnt vmcnt(" #n ")" ::: "memory")
#define PG8_WAIT_L(n) asm volatile("s_waitcnt lgkmcnt(" #n ")" ::: "memory")
#define PG8_BAR __builtin_amdgcn_s_barrier()
#define PG8_SCHED __builtin_amdgcn_sched_barrier(0)
    Unit cur, nxt; int ui = 0;
    if (!S.next(0, cur)) return;
    nt = cur.nkt;
    f32x4 acc[2][2][4][2];
    S.acc_init(acc, cur, wid, lane);
    bf16x8 At[4][2], B0[2][2], B1[2][2];
    const char* cA = (const char*)g.A + (size_t)cur.pm * tstepA + (size_t)cur.kt0 * kstep; const char* cB = (const char*)g.Bt + (size_t)cur.pn * tstepB + (size_t)cur.kt0 * kstep;
    S.a_ready(cur);
    if constexpr (SP2) {
        PG8_STAGE(PG8_SB(0, 0), cB, voffB); PG8_STAGE(PG8_SB(0, 1), cB + hstepB, voffB); PG8_STAGE(PG8_SA(0, 0), cA, voffA); PG8_STAGE(PG8_SA(0, 1), cA + hstepA, voffA);
        P();
        if (wr == 1) PG8_BAR;
        PG8_WAIT_V(2); PG8_BAR;
        PG8_STAGE(PG8_SB(1, 0), cB + kstep, voffB); PG8_STAGE(PG8_SA(1, 0), cA + kstep, voffA); PG8_STAGE(PG8_SB(1, 1), cB + hstepB + kstep, voffB);
        PG8_WAIT_V(6); PG8_BAR;
    } else {
        PG8_STAGE(PG8_SB(0, 0), cB, voffB); PG8_STAGE(PG8_SA(0, 0), cA, voffA); PG8_STAGE(PG8_SB(0, 1), cB + hstepB, voffB); PG8_STAGE(PG8_SA(0, 1), cA + hstepA, voffA);
        P();
        if (wr == 1) PG8_BAR;
        PG8_WAIT_V(4); PG8_BAR;
        PG8_STAGE(PG8_SB(1, 0), cB + kstep, voffB); PG8_STAGE(PG8_SA(1, 0), cA + kstep, voffA); PG8_STAGE(PG8_SB(1, 1), cB + hstepB + kstep, voffB);
        PG8_WAIT_V(6); PG8_BAR;
    }
    for (;;) {
        const bool has_next = S.next(ui + 1, nxt);
        const char* nA = has_next ? (const char*)g.A + (size_t)nxt.pm * tstepA + (size_t)nxt.kt0 * kstep : cA; const char* nB = has_next ? (const char*)g.Bt + (size_t)nxt.pn * tstepB + (size_t)nxt.kt0 * kstep : cB;
        for (int t = 0; t < nt; t += 2) {
            const bool last = (t == nt - 2);
            const char* a1 = cA + (size_t)(t + 1) * kstep;
            const char* a2 = last ? nA : cA + (size_t)(t + 2) * kstep; const char* b2 = last ? nB : cB + (size_t)(t + 2) * kstep;
            const char* a3 = a2 + kstep; const char* b3 = b2 + kstep;
            if (last && has_next) S.a_ready(nxt);
            if constexpr (SP2) {
            PG8_LDB(B0, 0, 0); PG8_LDB(B1, 0, 1); PG8_SCHED; PG8_LDA(At, 0, 0); PG8_STAGE(PG8_SA(1, 1), a1 + hstepA, voffA);
            PG8_WAIT_V(8); PG8_WAIT_L(0); PG8_BAR; PG8_MMA(0, 0, At, B0); PG8_MMA(0, 1, At, B1); PG8_BAR; PG8_SCHED;
            PG8_LDA(At, 0, 1); PG8_STAGE(PG8_SB(0, 0), b2, voffB); PG8_STAGE(PG8_SB(0, 1), b2 + hstepB, voffB); PG8_STAGE(PG8_SA(0, 0), a2, voffA);
            PG8_WAIT_V(8); PG8_WAIT_L(0); PG8_BAR; PG8_MMA(1, 0, At, B0); PG8_MMA(1, 1, At, B1); PG8_BAR; PG8_SCHED;
            PG8_LDB(B0, 1, 0); PG8_LDB(B1, 1, 1); PG8_SCHED; PG8_LDA(At, 1, 0); PG8_STAGE(PG8_SA(0, 1), a2 + hstepA, voffA);
            PG8_WAIT_V(8); PG8_WAIT_L(0); PG8_BAR; PG8_MMA(0, 0, At, B0); PG8_MMA(0, 1, At, B1); PG8_BAR; PG8_SCHED;
            PG8_LDA(At, 1, 1); PG8_STAGE(PG8_SB(1, 0), b3, voffB); PG8_STAGE(PG8_SB(1, 1), b3 + hstepB, voffB); PG8_STAGE(PG8_SA(1, 0), a3, voffA);
            PG8_WAIT_V(8); PG8_WAIT_L(0); PG8_BAR; PG8_MMA(1, 0, At, B0); PG8_MMA(1, 1, At, B1); PG8_BAR; PG8_SCHED;
            } else {
            PG8_LDB(B0, 0, 0); PG8_SCHED; PG8_LDA(At, 0, 0); PG8_STAGE(PG8_SA(1, 1), a1 + hstepA, voffA);
            PG8_WAIT_L(8); PG8_BAR; PG8_WAIT_L(0); PG8_MMA(0, 0, At, B0); PG8_BAR; PG8_SCHED;
            PG8_LDB(B1, 0, 1); PG8_STAGE(PG8_SB(0, 0), b2, voffB);
            PG8_BAR; PG8_WAIT_L(0); PG8_MMA(0, 1, At, B1); PG8_BAR;
            PG8_LDA(At, 0, 1); PG8_STAGE(PG8_SA(0, 0), a2, voffA);
            PG8_BAR; PG8_WAIT_L(0); PG8_MMA(1, 0, At, B0); PG8_BAR; PG8_SCHED;
            PG8_STAGE(PG8_SB(0, 1), b2 + hstepB, voffB);
            PG8_WAIT_V(6); PG8_BAR; PG8_MMA(1, 1, At, B1); PG8_BAR;
            PG8_LDB(B0, 1, 0); PG8_SCHED; PG8_LDA(At, 1, 0); PG8_STAGE(PG8_SA(0, 1), a2 + hstepA, voffA);
            PG8_WAIT_L(8); PG8_BAR; PG8_WAIT_L(0); PG8_MMA(0, 0, At, B0); PG8_BAR; PG8_SCHED;
            PG8_LDB(B1, 1, 1); PG8_STAGE(PG8_SB(1, 0), b3, voffB);
            PG8_BAR; PG8_WAIT_L(0); PG8_MMA(0, 1, At, B1); PG8_BAR;
            PG8_LDA(At, 1, 1); PG8_STAGE(PG8_SA(1, 0), a3, voffA);
            PG8_BAR; PG8_WAIT_L(0); PG8_MMA(1, 0, At, B0); PG8_BAR; PG8_SCHED;
            PG8_STAGE(PG8_SB(1, 1), b3 + hstepB, voffB);
            PG8_WAIT_V(6); PG8_BAR; PG8_MMA(1, 1, At, B1); PG8_BAR;
            }
        }
        if constexpr (ALIGN_EPI) { if (wr == 0) PG8_BAR; }
        if constexpr (!Epi::AFTER_DRAIN) {
            if (cur.kind == 1) S.slab_store(acc, cur, wid, lane);
            else E(acc, cur, wr, wc, fr, fq);
#ifdef PROBE_EPI2
            if constexpr (Epi::PERM || sizeof(Epi) == 16) { asm volatile("" ::: "memory"); E(acc, cur, wr, wc, fr, fq); }
#endif
            S.done(cur); W(ui, wid, lane); }
        if (!has_next) break;
        S.acc_init(acc, nxt, wid, lane);
        cur = nxt; cA = nA; cB = nB; ++ui; nt = cur.nkt;
        if constexpr (ALIGN_EPI) { if (wr == 1) PG8_BAR; }
    }
    PG8_WAIT_V(0);
    if constexpr (!ALIGN_EPI) { if (wr == 0) PG8_BAR; }
    PG8_BAR;
    if constexpr (Epi::AFTER_DRAIN) { E.fused(acc, cur, wr, wc, fr, fq, lds, wid, lane); S.done(cur); }
#undef PG8_SA
#undef PG8_SB
#undef PG8_STAGE
#undef PG8_LDA
#undef PG8_LDB
#undef PG8_MMA
#undef PG8_WAIT_V
#undef PG8_WAIT_L
#undef PG8_BAR
#undef PG8_SCHED
}
}
constexpr int NWAVES = 8;
constexpr int GRID = 256;
constexpr int D = 1024, FF = 4096, MP = 16384, MS = 1024, M = MP + MS;
constexpr int SEQ = 8192, NSEQ_S = 128, PAST = 2048;
constexpr int XBLD = pg8::XBLD, A1LD = 1024, HLD = 4096, KVRLD = 1536, QGLD = 1280, WLD1 = 1024, WLD4 = 4096;
constexpr int BCXLD = 3072;
constexpr int NQG = 1280;
constexpr float EPS = 1e-6f;
constexpr size_t MiB = 1u << 20;
constexpr int FRAGB = 16384;

constexpr size_t WS_CTL = 0, CTL_ZERO_BYTES = 1 * MiB;
constexpr size_t WS_WIN = 2 * MiB;
constexpr size_t WS_WOUT = WS_WIN + 13 * MiB;
constexpr size_t WS_WKV = WS_WOUT + 5 * MiB;
constexpr size_t WS_WQG = WS_WKV + 4 * MiB;
constexpr size_t WS_WO = WS_WQG + 6 * MiB;
constexpr size_t WS_WUP = WS_WO + 5 * MiB;
constexpr size_t WS_WDN = WS_WUP + 35 * MiB;
constexpr size_t WS_XB = WS_WDN + 34 * MiB;
constexpr size_t WS_SSQ = WS_XB + 37 * MiB;
constexpr size_t WS_ACT1 = WS_SSQ + 6 * MiB;
constexpr size_t WS_QG = WS_ACT1 + 37 * MiB;
constexpr size_t WS_BIG = WS_QG + 46 * MiB;
constexpr size_t WS_SLCP = WS_BIG + 140 * MiB;
constexpr size_t WS_WINP = WS_SLCP + 16 * MiB;
constexpr size_t WS_CMPP = WS_WINP + 16 * MiB;
constexpr size_t WS_CMPS = WS_CMPP + 1 * MiB;
constexpr size_t WS_WINS = WS_CMPS + 8 * MiB;
constexpr size_t WS_SLCS = WS_WINS + 72 * MiB;
constexpr size_t WS_SLAB = WS_SLCS + 264 * MiB;
constexpr size_t WS_LIST = WS_SLAB + 128 * MiB;
constexpr size_t WS_PARTO = WS_LIST + 32 * MiB;
constexpr size_t WS_PARTML = WS_PARTO + 192 * MiB;
constexpr size_t WS_END = WS_PARTML + 12 * MiB;
constexpr int CW_BAR = 4096, CW_TMO = 64, CW_SLABF = 8192, CW_CNT = 65536, CW_DQ = 36864, CNT_PAD = 16;

constexpr size_t O_Y = 0, O_PCMP = 17825792, O_PSLC = 26214400, O_PWIN = 34603008, O_PCONV = 35127296, O_SCMP = 35135488, O_SSLC = 35659776, O_SWIN = 36184064, O_SCONV = 69738496, O_END = 70262784;

constexpr int RING_BYTES = 131072;
constexpr int WLDS_BYTES = 18432;
constexpr int LDSCTL_OFF = 147456, MISC_OFF = LDSCTL_OFF + 320;
constexpr int LDS_BYTES = 147456 + 1024;

#define GAS __attribute__((address_space(1)))
#define LAS __attribute__((address_space(3)))
typedef unsigned short bf16;
typedef unsigned v4u __attribute__((ext_vector_type(4)));
typedef unsigned v2u __attribute__((ext_vector_type(2)));
typedef float f32x4 __attribute__((ext_vector_type(4)));
typedef short bf16x8 __attribute__((ext_vector_type(8)));
typedef GAS unsigned gu32;
#define RLX_AGENT __ATOMIC_RELAXED, __HIP_MEMORY_SCOPE_AGENT
#define LDS_WAIT() asm volatile("s_waitcnt lgkmcnt(0)" ::: "memory")
#define VM_WAIT() asm volatile("s_waitcnt vmcnt(0)" ::: "memory")
__device__ __forceinline__ unsigned pk2(float lo, float hi) { return pg8::cvt_pk_bf16(lo, hi); }
__device__ __forceinline__ float bf2f(unsigned short h) { return __uint_as_float((unsigned)h << 16); }
__device__ __forceinline__ float bflo(unsigned w) { return __uint_as_float(w << 16); }
__device__ __forceinline__ float bfhi(unsigned w) { return __uint_as_float(w & 0xffff0000u); }


#define DPP_F(x, ctrl) __int_as_float(__builtin_amdgcn_mov_dpp(__float_as_int(x), (ctrl), 0xF, 0xF, true))
#define DPP_I(x, ctrl) __builtin_amdgcn_mov_dpp((x), (ctrl), 0xF, 0xF, true)
#define DPP_XOR1 0xB1
#define DPP_XOR2 0x4E
#define DPP_HMIRROR 0x141
#define DPP_MIRROR 0x140
__device__ __forceinline__ float sum_x16_x32(float x) {
    auto a = __builtin_amdgcn_permlane16_swap(__float_as_uint(x), __float_as_uint(x), false, false); x = __uint_as_float(a[0]) + __uint_as_float(a[1]);
    auto b = __builtin_amdgcn_permlane32_swap(__float_as_uint(x), __float_as_uint(x), false, false); return __uint_as_float(b[0]) + __uint_as_float(b[1]);
}
__device__ __forceinline__ float max_x16_x32(float x) {
    auto a = __builtin_amdgcn_permlane16_swap(__float_as_uint(x), __float_as_uint(x), false, false); x = fmaxf(__uint_as_float(a[0]), __uint_as_float(a[1]));
    auto b = __builtin_amdgcn_permlane32_swap(__float_as_uint(x), __float_as_uint(x), false, false); return fmaxf(__uint_as_float(b[0]), __uint_as_float(b[1]));
}
__device__ __forceinline__ float sum8(float x) { x += DPP_F(x, DPP_XOR1); x += DPP_F(x, DPP_XOR2); x += DPP_F(x, DPP_HMIRROR); return x; }
__device__ __forceinline__ float sum4(float x) { x += DPP_F(x, DPP_XOR1); x += DPP_F(x, DPP_XOR2); return x; }

#define XB_TMO      128
#define XB_XCNT(j)  (256  + 64 * (j))
#define XB_XSUB(j)  (1280 + 64 * (j))
#define XB_XGEN(j)  (2304 + 64 * (j))
#define XB_TOP      3328
#define XB_TOPGEN   3392
#define XCD_BAR_WORDS 3456
#define XB_SPIN_CAP (1u << 18)

__device__ __forceinline__ unsigned xb_ld(unsigned* p)              { return __hip_atomic_load(p, __ATOMIC_RELAXED, __HIP_MEMORY_SCOPE_AGENT); }
__device__ __forceinline__ unsigned xb_add(unsigned* p, unsigned v) { return __hip_atomic_fetch_add(p, v, __ATOMIC_RELAXED, __HIP_MEMORY_SCOPE_AGENT); }
__device__ __forceinline__ unsigned xb_xcc_id() { return (unsigned)__builtin_amdgcn_s_getreg((3 << 11) | 20) & 0xFu; }
#define XB_SPIN(cond, bar) do { unsigned _sp = 0; while (cond) { __builtin_amdgcn_s_sleep(1); \
    if ((++_sp & 255u) == 0u) { if (xb_ld(&(bar)[XB_TMO])) break; if (_sp > XB_SPIN_CAP) { atomicAdd(&(bar)[XB_TMO], 1u); break; } } } } while (0)

struct XcdBarrier {
    unsigned* bar; unsigned x;
    volatile LAS unsigned* st;
};

__device__ __forceinline__ XcdBarrier xcd_barrier_post(unsigned* bar, volatile LAS unsigned* st) {
    XcdBarrier b; b.bar = bar; b.x = xb_xcc_id(); b.st = st;
    if (threadIdx.x == 0) (void)xb_add(&bar[XB_XCNT(b.x)], 1u);
    return b;
}
__device__ __forceinline__ void xcd_barrier_complete(unsigned* bar, unsigned x, unsigned& nloc, unsigned& nx) {
    const unsigned G = gridDim.x * gridDim.y * gridDim.z;
    unsigned sum, cnt, mine, sp = 0u;
    for (;;) {
        sum = 0u; cnt = 0u; mine = 0u;
#pragma unroll
        for (unsigned j = 0; j < 16; ++j) { const unsigned c = xb_ld(&bar[XB_XCNT(j)]); sum += c; cnt += (c > 0u) ? 1u : 0u; mine = (j == x) ? c : mine; }
        if (sum == G) break;
        __builtin_amdgcn_s_sleep(1);
        if ((++sp & 255u) == 0u) { if (xb_ld(&bar[XB_TMO])) break; if (sp > XB_SPIN_CAP) { atomicAdd(&bar[XB_TMO], 1u); break; } }
    }
    nloc = mine > 0u ? mine : 1u; nx = cnt > 0u ? cnt : 1u;
}

__device__ __forceinline__ void xcd_barrier(const XcdBarrier& b) {
    asm volatile("s_waitcnt vmcnt(0)" ::: "memory");
    __syncthreads();
    if (threadIdx.x == 0) {
        unsigned* bar = b.bar;
        __builtin_amdgcn_s_waitcnt(0);
        unsigned nloc = b.st[0], nx = b.st[1];
        if (nloc == 0u) { xcd_barrier_complete(bar, b.x, nloc, nx); b.st[0] = nloc; b.st[1] = nx; }
        const unsigned old = xb_add(&bar[XB_XSUB(b.x)], 1u);
        const unsigned gen = old / nloc;
        if (old + 1u == (gen + 1u) * nloc) {
            __builtin_amdgcn_fence(__ATOMIC_RELEASE, "agent");
            asm volatile("s_waitcnt vmcnt(0)" ::: "memory");
            const unsigned og = xb_add(&bar[XB_TOP], 1u);
            const unsigned tg = og / nx;
            if (og + 1u == (tg + 1u) * nx) xb_add(&bar[XB_TOPGEN], 1u);
            else XB_SPIN(xb_ld(&bar[XB_TOPGEN]) == tg, bar);
            __builtin_amdgcn_fence(__ATOMIC_ACQUIRE, "agent");
            xb_add(&bar[XB_XGEN(b.x)], 1u);
            asm volatile("s_waitcnt vmcnt(0)" ::: "memory");
        } else {
            XB_SPIN(xb_ld(&bar[XB_XGEN(b.x)]) == gen, bar);
            __builtin_amdgcn_fence(__ATOMIC_ACQUIRE, "agent");
            asm volatile("s_waitcnt vmcnt(0)" ::: "memory");
        }
    }
    __syncthreads();
}

struct Frame {
    LAS unsigned char* lds;
    volatile LAS unsigned* MISC;
    gu32* ctl;
    int wave, vcu; static constexpr int G = GRID;
};

constexpr int ARGS_OFF = LDSCTL_OFF + 512;
__device__ __forceinline__ void* argp(const Frame& F, int i) { unsigned a = (unsigned)(ARGS_OFF + 8 * i); asm volatile("" : "+v"(a));
    const LAS unsigned* p = (const LAS unsigned*)(F.lds + a);
    const unsigned lo = __builtin_amdgcn_readfirstlane(p[0]), hi = __builtin_amdgcn_readfirstlane(p[1]); return (void*)(((unsigned long long)hi << 32) | lo); }
__device__ __forceinline__ int lane_id() { int l; asm volatile("v_mbcnt_lo_u32_b32 %0, -1, 0\n\tv_mbcnt_hi_u32_b32 %0, -1, %0" : "=v"(l)); return l; }
#define AIN(k) ((const float*)argp(F, (k)))
#define AOUT ((float*)argp(F, 23))
#define AWS ((unsigned char*)argp(F, 24))

__device__ __forceinline__ float wave_sum(float v) { v = sum8(v); v += DPP_F(v, DPP_MIRROR); return sum_x16_x32(v); }

__device__ __forceinline__ void p0_transpose_item(const float* W, const float* gain, int K, int N, int Npad, bf16* WT, int ldw, LAS float* scr, int item, int lane) {
    const int nblk = Npad / 64, kb = item / nblk, nb = item % nblk, k0 = 64 * kb, n0 = 64 * nb;
    const int n4 = lane & 15, kr = lane >> 4; const bool nok = n0 + 4 * n4 + 3 < N;
    f32x4 v[16];
#pragma unroll
    for (int i = 0; i < 16; ++i) { v[i] = (f32x4){0.f, 0.f, 0.f, 0.f}; if (nok) v[i] = *(const GAS f32x4*)((const GAS float*)W + (size_t)(k0 + 4 * i + kr) * N + n0 + 4 * n4); }
#pragma unroll
    for (int i = 0; i < 16; ++i) { const int kk = 4 * i + kr; const float gv = gain ? ((const GAS float*)gain)[k0 + kk] : 1.f; LAS float* d = scr + kk * 65 + 4 * n4;
        d[0] = v[i][0] * gv; d[1] = v[i][1] * gv; d[2] = v[i][2] * gv; d[3] = v[i][3] * gv; }
    LDS_WAIT(); asm volatile("" ::: "memory");
    const int c = lane & 7;
#pragma unroll
    for (int j = 0; j < 8; ++j) { const int n = (lane >> 3) + 8 * j; const LAS float* s = scr + (8 * c) * 65 + n;
        v4u o; o.x = pk2(s[0 * 65], s[1 * 65]); o.y = pk2(s[2 * 65], s[3 * 65]); o.z = pk2(s[4 * 65], s[5 * 65]); o.w = pk2(s[6 * 65], s[7 * 65]);
        *(GAS v4u*)(WT + (size_t)(n0 + n) * ldw + k0 + 8 * c) = o; }
    LDS_WAIT(); asm volatile("" ::: "memory");
}
__device__ __forceinline__ void x_rows4_to_bf16(const float* xrow, bf16* orow, int ldo, float* ssqrow, int lane) {
    const GAS f32x4* xr = (const GAS f32x4*)xrow + lane;
    f32x4 v[4][4];
#pragma unroll
    for (int r = 0; r < 4; ++r)
#pragma unroll
        for (int j = 0; j < 4; ++j) v[r][j] = xr[r * 256 + 64 * j];
#pragma unroll
    for (int r = 0; r < 4; ++r) { float s = 0.f;
#pragma unroll
        for (int j = 0; j < 4; ++j) s += (v[r][j].x * v[r][j].x + v[r][j].y * v[r][j].y) + (v[r][j].z * v[r][j].z + v[r][j].w * v[r][j].w);
        s = wave_sum(s);
        GAS unsigned long long* o8 = (GAS unsigned long long*)(orow + (size_t)r * ldo) + lane;
#pragma unroll
        for (int j = 0; j < 4; ++j) o8[64 * j] = (unsigned long long)pk2(v[r][j].x, v[r][j].y) | ((unsigned long long)pk2(v[r][j].z, v[r][j].w) << 32);
        if (lane < 32) ssqrow[r * 32 + lane] = lane == 0 ? s : 0.f; }
}

__device__ __forceinline__ int koff(int key, int c) { return ((((key >> 4) * 2 + (c >> 2)) * 4 + (c & 3)) * 16 + (key & 15)) * 16; }
__device__ __forceinline__ int voff(int d, int s, int kq) { return 8192 + (((s * 4 + (d >> 4)) * 4 + kq) * 16 + (d & 15)) * 16; }

__device__ __forceinline__ void rows32_to_frags(const float* src, size_t stride, int nvalid, const float* gain, unsigned char* frag, size_t gstride, int s, float* out, int out_lo,
                                                LAS unsigned char* tile, int lane) {
    const int kv = lane >> 5, g = (lane >> 3) & 3, c = lane & 7;
    f32x4 ga = {1.f, 1.f, 1.f, 1.f}, gb = {1.f, 1.f, 1.f, 1.f};
    if (gain) { ga = *(const f32x4*)(gain + 8 * c); gb = *(const f32x4*)(gain + 8 * c + 4); }
    LAS bf16* T = (LAS bf16*)tile;
#pragma unroll 1
    for (int r0 = 0; r0 < 32; r0 += 16) {
        f32x4 ra[16], rb[16];
#pragma unroll
        for (int q = 0; q < 16; ++q) { ra[q] = (f32x4){0.f, 0.f, 0.f, 0.f}; rb[q] = (f32x4){0.f, 0.f, 0.f, 0.f};
            if (r0 + q < nvalid) { const GAS f32x4* p = (const GAS f32x4*)(src + (size_t)(r0 + q) * stride + lane * 8); ra[q] = p[0]; rb[q] = p[1]; } }
#pragma unroll
        for (int q = 0; q < 16; ++q) { const int r = r0 + q; f32x4 a = ra[q], b = rb[q];
            float ss = (a[0] * a[0] + a[1] * a[1]) + (a[2] * a[2] + a[3] * a[3]) + (b[0] * b[0] + b[1] * b[1]) + (b[2] * b[2] + b[3] * b[3]);
            ss = sum8(ss);
            if (gain && kv == 0) { const float rs = 1.0f / sqrtf(ss * (1.0f / 64.0f) + EPS); a = a * rs * ga; b = b * rs * gb; }
            if (out && r >= out_lo && r < nvalid) { GAS f32x4* o = (GAS f32x4*)(out + (size_t)r * 512 + lane * 8); o[0] = a; o[1] = b; }
            v4u w; w.x = pk2(a[0], a[1]); w.y = pk2(a[2], a[3]); w.z = pk2(b[0], b[1]); w.w = pk2(b[2], b[3]);
            if (kv == 0) *(GAS v4u*)(frag + (size_t)g * gstride + koff(32 * s + r, c)) = w;
            else *(LAS v4u*)(T + (g * 32 + r) * 72 + 8 * c) = w; }
    }
    LDS_WAIT(); asm volatile("" ::: "memory");
#pragma unroll 2
    for (int it = 0; it < 16; ++it) {
        const int idx = it * 64 + lane, gg = idx >> 8, rem = idx & 255, dg = rem >> 6, kq = (rem >> 4) & 3, d16 = rem & 15, d = dg * 16 + d16;
        const LAS bf16* tp = T + (gg * 32 + 4 * kq) * 72 + d;
        const unsigned e0 = tp[0], e1 = tp[72], e2 = tp[144], e3 = tp[216], e4 = tp[16 * 72], e5 = tp[17 * 72], e6 = tp[18 * 72], e7 = tp[19 * 72];
        v4u w; w.x = e0 | (e1 << 16); w.y = e2 | (e3 << 16); w.z = e4 | (e5 << 16); w.w = e6 | (e7 << 16);
        *(GAS v4u*)(frag + (size_t)gg * gstride + voff(d, s, kq)) = w;
    }
    LDS_WAIT(); asm volatile("" ::: "memory");
}
__device__ __forceinline__ void rows32_compress(const float* src, size_t stride, const float* gain, unsigned char* frag, size_t gstride, int n, float* out, int lane) {
    const int kv = lane >> 5, g = (lane >> 3) & 3, c = lane & 7;
    f32x4 a = {0.f, 0.f, 0.f, 0.f}, b = {0.f, 0.f, 0.f, 0.f};
#pragma unroll 1
    for (int r0 = 0; r0 < 32; r0 += 16) {
        f32x4 rx[16], ry[16];
#pragma unroll
        for (int q = 0; q < 16; ++q) { const GAS f32x4* p = (const GAS f32x4*)(src + (size_t)(r0 + q) * stride + lane * 8); rx[q] = p[0]; ry[q] = p[1]; }
#pragma unroll
        for (int q = 0; q < 16; ++q) { a += rx[q]; b += ry[q]; if (out) { GAS f32x4* o = (GAS f32x4*)(out + (size_t)(r0 + q) * 512 + lane * 8); o[0] = rx[q]; o[1] = ry[q]; } }
    }
    a = a * (1.0f / 32.0f); b = b * (1.0f / 32.0f);
    float ss = (a[0] * a[0] + a[1] * a[1]) + (a[2] * a[2] + a[3] * a[3]) + (b[0] * b[0] + b[1] * b[1]) + (b[2] * b[2] + b[3] * b[3]);
    ss = sum8(ss);
    unsigned char* fb = frag + (size_t)g * gstride;
    if (kv == 0) { const float rs = 1.0f / sqrtf(ss * (1.0f / 64.0f) + EPS); const f32x4 ga = *(const f32x4*)(gain + 8 * c), gb = *(const f32x4*)(gain + 8 * c + 4); a = a * rs * ga; b = b * rs * gb;
        v4u w; w.x = pk2(a[0], a[1]); w.y = pk2(a[2], a[3]); w.z = pk2(b[0], b[1]); w.w = pk2(b[2], b[3]);
        *(GAS v4u*)(fb + koff(n & 63, c)) = w;
    } else {
        const int kk = n & 31, s = (n >> 5) & 1, kq = (kk & 15) >> 2, pos = (kk >> 4) * 4 + (kk & 3);
        const unsigned w0 = pk2(a[0], a[1]), w1 = pk2(a[2], a[3]), w2 = pk2(b[0], b[1]), w3 = pk2(b[2], b[3]);
        GAS bf16* vp = (GAS bf16*)(fb + voff(8 * c, s, kq)) + pos;
        vp[0] = (bf16)(w0 & 0xffff); vp[8] = (bf16)(w0 >> 16); vp[16] = (bf16)(w1 & 0xffff); vp[24] = (bf16)(w1 >> 16);
        vp[32] = (bf16)(w2 & 0xffff); vp[40] = (bf16)(w2 >> 16); vp[48] = (bf16)(w3 & 0xffff); vp[56] = (bf16)(w3 >> 16);
    }
}
struct Args { const float* in[22]; const int* page_table; float* out; unsigned char* ws; int ph_lo, ph_hi; };

#if defined(PROBE_P0)
#define P0REP(k) ((k) == PROBE_P0 ? 2 : 1)
#else
#define P0REP(k) 1
#endif
__device__ __forceinline__ void p0_prologue(Frame& F) {
    unsigned char* ws = AWS; float* aout = AOUT;
    LAS float* scr = (LAS float*)(F.lds + F.wave * WLDS_BYTES);
    LAS unsigned char* tile = F.lds + F.wave * WLDS_BYTES;
    const int lane = lane_id();
    const int gw = F.vcu * NWAVES + F.wave, NGW = F.G * NWAVES;
    const float* norm1 = AIN(7); const float* norm2 = AIN(19);
    constexpr int I_IN = 16 * 48, I_SQ = 16 * 16, I_KV = 16 * 24, I_QG = 16 * 20, I_UP = 16 * 64, I_DN = 64 * 16;
    constexpr int NITEMS = 2 * I_IN + 2 * I_SQ + I_KV + 2 * I_QG + 2 * I_SQ + 4 * I_UP + 4 * I_DN;
    for (int prep_ = 0; prep_ < P0REP(1); ++prep_)
    for (int it = gw; it < NITEMS; it += NGW) {
        int r = it;
        if (r < 2 * I_IN) { const int l = r / I_IN; p0_transpose_item(AIN(8) + (size_t)l * D * 3072, norm1 + l * D, D, 3072, 3072, (bf16*)(ws + WS_WIN) + (size_t)l * 3072 * WLD1, WLD1, scr, r % I_IN, lane); continue; } r -= 2 * I_IN;
        if (r < 2 * I_SQ) { const int l = r / I_SQ; p0_transpose_item(AIN(10) + (size_t)l * D * D, nullptr, D, D, D, (bf16*)(ws + WS_WOUT) + (size_t)l * D * WLD1, WLD1, scr, r % I_SQ, lane); continue; } r -= 2 * I_SQ;
        if (r < I_KV) { p0_transpose_item(AIN(12), AIN(11), D, 1536, 1536, (bf16*)(ws + WS_WKV), WLD1, scr, r, lane); continue; } r -= I_KV;
        if (r < 2 * I_QG) { const int l = r / I_QG; p0_transpose_item(AIN(16) + (size_t)l * D * 1072, norm1 + (2 + l) * D, D, 1072, NQG, (bf16*)(ws + WS_WQG) + (size_t)l * NQG * WLD1, WLD1, scr, r % I_QG, lane); continue; } r -= 2 * I_QG;
        if (r < 2 * I_SQ) { const int l = r / I_SQ; p0_transpose_item(AIN(18) + (size_t)l * D * D, nullptr, D, D, D, (bf16*)(ws + WS_WO) + (size_t)l * D * WLD1, WLD1, scr, r % I_SQ, lane); continue; } r -= 2 * I_SQ;
        if (r < 4 * I_UP) { const int l = r / I_UP; p0_transpose_item(AIN(20) + (size_t)l * D * FF, norm2 + l * D, D, FF, FF, (bf16*)(ws + WS_WUP) + (size_t)l * FF * WLD1, WLD1, scr, r % I_UP, lane); continue; } r -= 4 * I_UP;
        { const int l = r / I_DN; p0_transpose_item(AIN(21) + (size_t)l * FF * D, nullptr, FF, D, D, (bf16*)(ws + WS_WDN) + (size_t)l * D * WLD4, WLD4, scr, r % I_DN, lane); }
    }
    for (int prep_ = 0; prep_ < P0REP(2); ++prep_)
    for (int m = gw * 4; m < M; m += NGW * 4) {
        const float* xr = m < MP ? AIN(0) + (size_t)m * D : AIN(1) + (size_t)(m - MP) * D;
        x_rows4_to_bf16(xr, (bf16*)(ws + WS_XB) + (size_t)m * XBLD, XBLD, (float*)(ws + WS_SSQ) + (size_t)m * 32, lane);
    }
    const int* pt = (const int*)argp(F, 22);
    for (int prep_ = 0; prep_ < P0REP(3); ++prep_)
    for (int it = gw; it < NSEQ_S * 64; it += NGW) { const int seq = it >> 6, n = it & 63; const int page = pt[seq * 16 + (n >> 2)];
        rows32_compress(AIN(2) + ((size_t)page * 128 + (n & 3) * 32) * 512, 512, AIN(13), ws + WS_CMPS + (size_t)seq * 4 * FRAGB, FRAGB, n, nullptr, lane); }
    for (int prep_ = 0; prep_ < P0REP(4); ++prep_)
    for (int it = gw; it < NSEQ_S * 64; it += NGW) { const int seq = it >> 6, blk = (it >> 1) & 31, s = it & 1; const int page = pt[seq * 16 + (blk >> 1)];
        rows32_to_frags(AIN(3) + ((size_t)page * 128 + (blk & 1) * 64 + s * 32) * 512, 512, 32, nullptr, ws + WS_SLCS + ((size_t)seq * 4 * 33 + blk) * FRAGB, (size_t)33 * FRAGB, s, nullptr, 0, tile, lane); }
    for (int prep_ = 0; prep_ < P0REP(5); ++prep_)
    for (int it = gw; it < NSEQ_S * 16; it += NGW) { const int seq = it >> 4, blk = (it >> 1) & 7, s = it & 1, r0 = blk * 64 + s * 32;
        rows32_to_frags(AIN(4) + ((size_t)seq * 512 + r0) * 512, 512, 32, nullptr, ws + WS_WINS + ((size_t)seq * 4 * 9 + blk) * FRAGB, (size_t)9 * FRAGB, s,
                        aout + O_SWIN + ((long)seq * 512 + r0 - 8) * 512, r0 == 0 ? 8 : 0, tile, lane); }
}

__device__ __forceinline__ void conv_phase(Frame& F, int l) {
    unsigned char* aws = AWS; float* aout = AOUT;
    const bf16* BCX = (const bf16*)(aws + WS_BIG); bf16* V = (bf16*)(aws + WS_ACT1);
    const float* cw = AIN(9) + (size_t)l * 3 * D; const float* st = AIN(5);
    const int lane = lane_id();
    const int gw = F.vcu * NWAVES + F.wave, NGW = F.G * NWAVES;
    for (int it = gw; it < (M / 8) * 2; it += NGW) {
        const int rc = it >> 1, ch = (it & 1) * 512 + lane * 8, row0 = rc * 8;
        float u1[8], u2[8], w0[8], w1[8], w2[8];
#pragma unroll
        for (int j = 0; j < 8; ++j) { w0[j] = cw[ch + j]; w1[j] = cw[D + ch + j]; w2[j] = cw[2 * D + ch + j]; u1[j] = 0.f; u2[j] = 0.f; }
        const bool samp = rc >= MP / 8; const int t0 = row0 & (SEQ - 1);
        if (samp) { const int seq = rc - MP / 8; const float* sp = st + ((size_t)(l * NSEQ_S + seq) * 2) * D + ch;
#pragma unroll
            for (int j = 0; j < 8; ++j) { u2[j] = sp[j]; u1[j] = sp[D + j]; }
        } else if (t0 != 0) {
#pragma unroll
            for (int h = 1; h <= 2; ++h) { const GAS bf16* rp = (const GAS bf16*)BCX + (size_t)(row0 - h) * BCXLD + ch; const v4u c4 = *(const GAS v4u*)(rp + 1024), x4 = *(const GAS v4u*)(rp + 2048);
#pragma unroll
                for (int q = 0; q < 4; ++q) { const float a0 = bflo(c4[q]) * bflo(x4[q]), a1 = bfhi(c4[q]) * bfhi(x4[q]); if (h == 1) { u1[2 * q] = a0; u1[2 * q + 1] = a1; } else { u2[2 * q] = a0; u2[2 * q + 1] = a1; } } }
        }
        v4u rb4[8], rc4[8], rx4[8];
#pragma unroll
        for (int r = 0; r < 8; ++r) { const GAS bf16* rp = (const GAS bf16*)BCX + (size_t)(row0 + r) * BCXLD + ch; rb4[r] = *(const GAS v4u*)rp; rc4[r] = *(const GAS v4u*)(rp + 1024); rx4[r] = *(const GAS v4u*)(rp + 2048); }
#pragma unroll
        for (int r = 0; r < 8; ++r) { const v4u b4 = rb4[r], c4 = rc4[r], x4 = rx4[r];
            float u[8], v[8];
#pragma unroll
            for (int q = 0; q < 4; ++q) { u[2 * q] = bflo(c4[q]) * bflo(x4[q]); u[2 * q + 1] = bfhi(c4[q]) * bfhi(x4[q]); }
#pragma unroll
            for (int j = 0; j < 8; ++j) { const float z = w0[j] * u2[j] + w1[j] * u1[j] + w2[j] * u[j]; const float bgv = (j & 1) ? bfhi(b4[j >> 1]) : bflo(b4[j >> 1]); v[j] = bgv * z; }
            v4u o; o.x = pk2(v[0], v[1]); o.y = pk2(v[2], v[3]); o.z = pk2(v[4], v[5]); o.w = pk2(v[6], v[7]);
            *(GAS v4u*)((GAS bf16*)V + (size_t)(row0 + r) * A1LD + ch) = o;
            if (r >= 6) {
                float* op = nullptr;
                if (samp) op = aout + O_SCONV + ((size_t)(l * NSEQ_S + (rc - MP / 8)) * 2 + (r - 6)) * D + ch;
                else if (t0 == SEQ - 8) op = aout + O_PCONV + ((size_t)(l * 2 + row0 / SEQ) * 2 + (r - 6)) * D + ch;
                if (op) { *(GAS f32x4*)op = (f32x4){u[0], u[1], u[2], u[3]}; *(GAS f32x4*)(op + 4) = (f32x4){u[4], u[5], u[6], u[7]}; }
            }
#pragma unroll
            for (int j = 0; j < 8; ++j) { u2[j] = u1[j]; u1[j] = u[j]; }
        }
    }
}

__device__ __forceinline__ void kvfin_phase(Frame& F) {
    unsigned char* ws = AWS; float* aout = AOUT; const float* KVR = (const float*)(ws + WS_BIG);
    LAS unsigned char* tile = F.lds + F.wave * WLDS_BYTES;
    const int lane = lane_id();
    const int gw = F.vcu * NWAVES + F.wave, NGW = F.G * NWAVES;
    constexpr int N_PC = 512, N_SC = 32, N_PS = 512, N_SS = 256, N_PW = 512, N_SW = 256, NIT = N_PC + N_SC + N_PS + N_SS + N_PW + N_SW;
    for (int it = gw; it < NIT; it += NGW) {
        int r = it;
        if (r < N_PC) { const int b = r >> 8, n = r & 255; const size_t row = (size_t)b * SEQ + 32 * n;
            rows32_compress(KVR + row * KVRLD, KVRLD, AIN(13), ws + WS_CMPP + ((size_t)b * 4 * 4 + (n >> 6)) * FRAGB, (size_t)4 * FRAGB, n, aout + O_PCMP + row * 512, lane); continue; } r -= N_PC;
        if (r < N_SC) {
            for (int q = 0; q < 32; ++q) { const size_t row = (size_t)r * 32 + q; const GAS f32x4* p = (const GAS f32x4*)(KVR + (MP + row) * KVRLD + lane * 8); GAS f32x4* o = (GAS f32x4*)(aout + O_SCMP + row * 512 + lane * 8); o[0] = p[0]; o[1] = p[1]; }
            continue; } r -= N_SC;
        if (r < N_PS) { const int b = r >> 8, blk = (r >> 1) & 127, s = r & 1; const size_t row = (size_t)b * SEQ + blk * 64 + s * 32;
            rows32_to_frags(KVR + row * KVRLD + 512, KVRLD, 32, AIN(14), ws + WS_SLCP + ((size_t)b * 4 * 128 + blk) * FRAGB, (size_t)128 * FRAGB, s, aout + O_PSLC + row * 512, 0, tile, lane); continue; } r -= N_PS;
        if (r < N_SS) { const int seq = r >> 1, s = r & 1; const size_t row = (size_t)seq * 8;
            rows32_to_frags(KVR + (MP + row) * KVRLD + 512, KVRLD, s == 0 ? 8 : 0, AIN(14), ws + WS_SLCS + ((size_t)seq * 4 * 33 + 32) * FRAGB, (size_t)33 * FRAGB, s, aout + O_SSLC + row * 512, 0, tile, lane); continue; } r -= N_SS;
        if (r < N_PW) { const int b = r >> 8, blk = (r >> 1) & 127, s = r & 1; const int t = blk * 64 + s * 32; const size_t row = (size_t)b * SEQ + t;
            float* o = t >= SEQ - 512 ? aout + O_PWIN + ((size_t)b * 512 + (t - (SEQ - 512))) * 512 : nullptr;
            rows32_to_frags(KVR + row * KVRLD + 1024, KVRLD, 32, AIN(15), ws + WS_WINP + ((size_t)b * 4 * 128 + blk) * FRAGB, (size_t)128 * FRAGB, s, o, 0, tile, lane); continue; } r -= N_PW;
        { const int seq = r >> 1, s = r & 1; const size_t row = (size_t)seq * 8;
            rows32_to_frags(KVR + (MP + row) * KVRLD + 1024, KVRLD, s == 0 ? 8 : 0, AIN(15), ws + WS_WINS + ((size_t)seq * 4 * 9 + 8) * FRAGB, (size_t)9 * FRAGB, s, aout + O_SWIN + ((size_t)seq * 512 + 504) * 512, 0, tile, lane); }
    }
}
#define MFMA16(a, b, c) __builtin_amdgcn_mfma_f32_16x16x32_bf16((a), (b), (c), 0, 0, 0)
struct AttState { float m[2], l[2]; f32x4 o[4][2]; };
__device__ __forceinline__ void att_init(AttState& st) {
#pragma unroll
    for (int cg = 0; cg < 2; ++cg) { st.m[cg] = -1e30f; st.l[cg] = 0.f;
#pragma unroll
        for (int dg = 0; dg < 4; ++dg) st.o[dg][cg] = (f32x4){0.f, 0.f, 0.f, 0.f}; }
}
__device__ __forceinline__ bf16x8 pack_p(const f32x4& a, const f32x4& b) {
    v4u w; w.x = pk2(a[0], a[1]); w.y = pk2(a[2], a[3]); w.z = pk2(b[0], b[1]); w.w = pk2(b[2], b[3]); return __builtin_bit_cast(bf16x8, w);
}
typedef __amdgpu_buffer_rsrc_t rsrc_t;
__device__ __forceinline__ rsrc_t mk_rsrc(const void* p) { return __builtin_amdgcn_make_buffer_rsrc((void*)p, 0, 0x7fffff00, 0x00020000); }
__device__ __forceinline__ bf16x8 frag_ld(rsrc_t rs, int boff, int k, int lane) { return __builtin_bit_cast(bf16x8, __builtin_amdgcn_raw_buffer_load_b128(rs, lane * 16, boff + k * 1024, 0)); }
__device__ __forceinline__ void load_k(bf16x8 (&kf)[3][2], rsrc_t rs, int boff, int lane) {
#pragma unroll
    for (int kg = 0; kg < 3; ++kg)
#pragma unroll
        for (int dh = 0; dh < 2; ++dh) kf[kg][dh] = frag_ld(rs, boff, kg * 2 + dh, lane);
}
__device__ __forceinline__ void load_q_raw(const bf16* QG, int row, int hfull, int rq, v4u& r0, v4u& r1) {
    const GAS bf16* qp = (const GAS bf16*)QG + (size_t)row * QGLD + hfull * 64 + rq * 8; r0 = *(const GAS v4u*)qp; r1 = *(const GAS v4u*)(qp + 32);
}
__device__ __forceinline__ void norm_q(const v4u r0, const v4u r1, const float* qn, int rq, bf16x8 (&qf)[2]) {
    float x0[8], x1[8]; float ss = 0.f;
#pragma unroll
    for (int q = 0; q < 4; ++q) { x0[2 * q] = bflo(r0[q]); x0[2 * q + 1] = bfhi(r0[q]); x1[2 * q] = bflo(r1[q]); x1[2 * q + 1] = bfhi(r1[q]); }
#pragma unroll
    for (int j = 0; j < 8; ++j) ss += x0[j] * x0[j] + x1[j] * x1[j];
    ss = sum_x16_x32(ss);
    const float rs = (1.0f / sqrtf(ss * (1.0f / 64.0f) + EPS)) * (0.125f * 1.4426950408889634f);
    const GAS f32x4* gq = (const GAS f32x4*)(qn + rq * 8); const f32x4 g0 = gq[0], g1 = gq[1], g2 = gq[8], g3 = gq[9];
#pragma unroll
    for (int j = 0; j < 4; ++j) { x0[j] *= rs * g0[j]; x0[4 + j] *= rs * g1[j]; x1[j] *= rs * g2[j]; x1[4 + j] *= rs * g3[j]; }
    v4u w0, w1; w0.x = pk2(x0[0], x0[1]); w0.y = pk2(x0[2], x0[3]); w0.z = pk2(x0[4], x0[5]); w0.w = pk2(x0[6], x0[7]);
    w1.x = pk2(x1[0], x1[1]); w1.y = pk2(x1[2], x1[3]); w1.z = pk2(x1[4], x1[5]); w1.w = pk2(x1[6], x1[7]);
    qf[0] = __builtin_bit_cast(bf16x8, w0); qf[1] = __builtin_bit_cast(bf16x8, w1);
}
__device__ __forceinline__ void load_q(const bf16* QG, const float* qn, int row, int hfull, int rq, bf16x8 (&qf)[2]) { v4u r0, r1; load_q_raw(QG, row, hfull, rq, r0, r1); norm_q(r0, r1, qn, rq, qf); }
__device__ __forceinline__ float gate_ld(const bf16* QG, int row4, int g, int br, int lane) {
    int l2 = lane; asm volatile("" : "+v"(l2));
    const int c16 = l2 & 15; const unsigned off = (unsigned)(row4 + (c16 >> 2)) * (unsigned)QGLD + 1024u + (unsigned)((g * 4 + (c16 & 3)) * 3 + br);
    return 1.0f / (1.0f + __expf(-bf2f(((const GAS bf16*)QG)[off])));
}
__device__ __forceinline__ void stg_put(LAS unsigned char* stg, int col, int dg, int rq, v2u w) {
    *(LAS v2u*)(stg + col * 128 + (((2 * dg + (rq >> 1)) ^ (col & 7)) * 16) + (rq & 1) * 8) = w;
}
__device__ __forceinline__ v4u stg_get(const LAS unsigned char* stg, int lane, int k) { const int col = lane >> 1, ch = (lane & 1) * 4 + k;
    return *(const LAS v4u*)(stg + col * 128 + ((ch ^ (col & 7)) * 16)); }
struct SeqDesc { int qrow0, P, win_blk0, ncb; const unsigned char* slc; const unsigned char* win; const unsigned char* cmp;
    unsigned* cnt; unsigned* list; bf16* parto; float* partml; };

__device__ __forceinline__ void attn_sparse_phase(Frame& F, int j) {
    unsigned char* ws = AWS; const bf16* QG = (const bf16*)(ws + WS_QG); const float* qn = AIN(17) + j * 64;
    const GAS unsigned* cnt = (const GAS unsigned*)((unsigned*)F.ctl + CW_CNT + j * 1024 * CNT_PAD);
    const GAS unsigned* list = (const GAS unsigned*)(ws + WS_LIST);
    GAS bf16* parto = (GAS bf16*)(ws + WS_PARTO); GAS float* partml = (GAS float*)(ws + WS_PARTML);
    LAS int* P = (LAS int*)(F.lds + F.wave * WLDS_BYTES);
    const int lane = lane_id(), col16 = lane & 15, rq = lane >> 4, head = col16 & 3, tk4 = col16 >> 2;
    const int xc = F.vcu >> 5;
    unsigned* dq = (unsigned*)F.ctl + CW_DQ + 64 * (8 * j + xc);
    {
        int nch[16]; int tot = 0;
#pragma unroll
        for (int q = 0; q < 16; ++q) { const unsigned c1 = cnt[(16 * lane + q) * CNT_PAD]; nch[q] = (int)((c1 + 63u) >> 6); tot += nch[q]; }
        P[1088 + lane] = tot; LDS_WAIT(); asm volatile("" ::: "memory");
        int base = 0;
#pragma unroll 1
        for (int i = 0; i < 64; ++i) { const int v = P[1088 + i]; base += i < lane ? v : 0; }
#pragma unroll
        for (int k = 0; k < 16; ++k) { P[16 * lane + k] = base; base += nch[k]; }
        if (lane == 63) P[1024] = base;
        LDS_WAIT(); asm volatile("" ::: "memory");
    }
    const int ibase = P[128 * xc], total = P[128 * xc + 128] - ibase;
#pragma unroll 1
    for (;;) {
        unsigned it_ = 0; if (lane == 0) it_ = __hip_atomic_fetch_add(dq, 1u, __ATOMIC_RELAXED, __HIP_MEMORY_SCOPE_AGENT);
        const int itl = __builtin_amdgcn_readfirstlane(it_); if (itl >= total) break; const int item = ibase + itl;
        int lo_ = 0, hi_ = 1024;
#pragma unroll 1
        while (hi_ - lo_ > 1) { const int mid = (lo_ + hi_) >> 1; if (P[mid] <= item) lo_ = mid; else hi_ = mid; }
        const int L = __builtin_amdgcn_readfirstlane(lo_), chunk = item - __builtin_amdgcn_readfirstlane(P[lo_]);
        const int n = (int)cnt[L * CNT_PAD], e0 = chunk * 64, e1 = n < e0 + 64 ? n : e0 + 64;
        const int bg = L >> 7, g = bg & 3, b = bg >> 2;
        const GAS unsigned char* kb = (const GAS unsigned char*)(ws + WS_SLCP) + (size_t)L * FRAGB + lane * 16;
        bf16x8 kf[4][2], vf[2][4];
#pragma unroll
        for (int kg = 0; kg < 4; ++kg)
#pragma unroll
            for (int dh = 0; dh < 2; ++dh) kf[kg][dh] = *(const GAS bf16x8*)(kb + (kg * 2 + dh) * 1024);
#pragma unroll
        for (int sl = 0; sl < 2; ++sl)
#pragma unroll
            for (int dg = 0; dg < 4; ++dg) vf[sl][dg] = *(const GAS bf16x8*)(kb + 8192 + (sl * 4 + dg) * 1024);
        const GAS unsigned* le = list + (size_t)L * 8192;
        LAS unsigned* entL = (LAS unsigned*)(F.lds + F.wave * WLDS_BYTES + 8192);
        LAS unsigned char* stg = F.lds + F.wave * WLDS_BYTES + 12288;
        { const int e = e0 + lane; entL[lane] = le[e < e1 ? e : e0]; LDS_WAIT(); asm volatile("" ::: "memory"); }
        v4u raw[2][2], rawn[2][2];
#pragma unroll
        for (int cg = 0; cg < 2; ++cg) { const unsigned ent = entL[4 * cg + tk4]; load_q_raw(QG, (int)((size_t)b * SEQ + (ent & 0xffffu)), g * 4 + head, rq, raw[cg][0], raw[cg][1]); }
#pragma unroll 1
        for (int eb = e0; eb < e1; eb += 8) {
            { const int nb = eb + 8 < e1 ? eb + 8 - e0 : eb - e0;
#pragma unroll
              for (int cg = 0; cg < 2; ++cg) { const unsigned ent = entL[nb + 4 * cg + tk4]; load_q_raw(QG, (int)((size_t)b * SEQ + (ent & 0xffffu)), g * 4 + head, rq, rawn[cg][0], rawn[cg][1]); } }
            __builtin_amdgcn_sched_barrier(0);
#pragma unroll
            for (int cg = 0; cg < 2; ++cg) {
                const int e = eb + 4 * cg + tk4; const bool valid = e < e1; const unsigned ent = entL[eb - e0 + 4 * cg + tk4];
                const size_t row = (size_t)b * SEQ + (ent & 0xffffu); const int r = (int)(ent >> 16);
                bf16x8 qf[2]; norm_q(raw[cg][0], raw[cg][1], qn, rq, qf);
                f32x4 s[4];
#pragma unroll
                for (int kg = 0; kg < 4; ++kg) { s[kg] = (f32x4){0.f, 0.f, 0.f, 0.f}; s[kg] = MFMA16(kf[kg][0], qf[0], s[kg]); s[kg] = MFMA16(kf[kg][1], qf[1], s[kg]); }
                float mx = -1e30f;
#pragma unroll
                for (int kg = 0; kg < 4; ++kg)
#pragma unroll
                    for (int i = 0; i < 4; ++i) mx = fmaxf(mx, s[kg][i]);
                mx = max_x16_x32(mx);
                float ls = 0.f;
#pragma unroll
                for (int kg = 0; kg < 4; ++kg)
#pragma unroll
                    for (int i = 0; i < 4; ++i) { const float p = __builtin_amdgcn_exp2f(s[kg][i] - mx); s[kg][i] = p; ls += p; }
                ls = sum_x16_x32(ls);
                f32x4 o[4];
#pragma unroll
                for (int dg = 0; dg < 4; ++dg) o[dg] = (f32x4){0.f, 0.f, 0.f, 0.f};
#pragma unroll
                for (int sl = 0; sl < 2; ++sl) { const bf16x8 pf = pack_p(s[2 * sl], s[2 * sl + 1]);
#pragma unroll
                    for (int dg = 0; dg < 4; ++dg) o[dg] = MFMA16(vf[sl][dg], pf, o[dg]); }
                if (valid && rq == 0) { const size_t pi = ((row * 6 + r) * 16 + g * 4 + head); partml[pi * 2] = mx; partml[pi * 2 + 1] = ls; }
#pragma unroll
                for (int dg = 0; dg < 4; ++dg) { v2u w; w.x = pk2(o[dg][0], o[dg][1]); w.y = pk2(o[dg][2], o[dg][3]); stg_put(stg, cg * 16 + col16, dg, rq, w); }
            }
            LDS_WAIT(); asm volatile("" ::: "memory");
            { const int c_ = lane >> 1, e_ = eb + (c_ >> 2), hd_ = c_ & 3;
              if (e_ < e1) { const unsigned ent = entL[e_ - e0]; const size_t pi = (((size_t)b * SEQ + (ent & 0xffffu)) * 6 + (ent >> 16)) * 16 + g * 4 + hd_; GAS bf16* pp = parto + pi * 64 + (lane & 1) * 32;
#pragma unroll
                  for (int k = 0; k < 4; ++k) *(GAS v4u*)(pp + 8 * k) = stg_get(stg, lane, k); } }
            LDS_WAIT(); asm volatile("" ::: "memory");
#pragma unroll
            for (int cg = 0; cg < 2; ++cg) { raw[cg][0] = rawn[cg][0]; raw[cg][1] = rawn[cg][1]; }
        }
    }
}
__device__ __forceinline__ void attn_combine_phase(Frame& F, int j, bool dummy = false) {
    unsigned char* ws = AWS; const GAS bf16* QG = (const GAS bf16*)(ws + WS_QG); GAS bf16* O = (GAS bf16*)(ws + WS_ACT1); GAS bf16* Od = dummy ? (GAS bf16*)(ws + WS_BIG) : O;
    const GAS bf16* parto = (const GAS bf16*)(ws + WS_PARTO); const GAS float* partml = (const GAS float*)(ws + WS_PARTML);
    const int lane = lane_id(), hfull = lane >> 2, q = lane & 3;
    const int gw = F.vcu * NWAVES + F.wave, NGW = F.G * NWAVES;
#pragma unroll 1
    for (int row0 = gw; row0 < MP; row0 += 2 * NGW) {
        float m[2][6], l[2][6]; v4u pa[2][6], pb[2][6], b0[2], b1[2]; float gl[2];
#pragma unroll
        for (int u = 0; u < 2; ++u) { const int row = row0 + u * NGW;
#pragma unroll
            for (int sl = 0; sl < 6; ++sl) { const GAS float* p = partml + (((size_t)row * 6 + sl) * 16 + hfull) * 2; m[u][sl] = p[0]; l[u][sl] = p[1];
                const GAS v4u* op = (const GAS v4u*)(parto + (((size_t)row * 6 + sl) * 16 + hfull) * 64 + q * 16); pa[u][sl] = op[0]; pb[u][sl] = op[1]; }
            gl[u] = bf2f(QG[(size_t)row * QGLD + 1024 + hfull * 3 + 1]);
            const GAS v4u* dsr = (const GAS v4u*)(O + (size_t)row * A1LD + hfull * 64 + q * 16); b0[u] = dsr[0]; b1[u] = dsr[1]; }
#pragma unroll
        for (int u = 0; u < 2; ++u) { const int row = row0 + u * NGW;
            float M = -1e30f;
#pragma unroll
            for (int sl = 0; sl < 6; ++sl) M = fmaxf(M, l[u][sl] > 0.f ? m[u][sl] : -1e30f);
            float acc[16]; float Lt = 0.f;
#pragma unroll
            for (int e = 0; e < 16; ++e) acc[e] = 0.f;
#pragma unroll
            for (int sl = 0; sl < 6; ++sl) { const v4u a = pa[u][sl], b = pb[u][sl];
                const float w = l[u][sl] > 0.f ? __builtin_amdgcn_exp2f(m[u][sl] - M) : 0.f; Lt += w * l[u][sl];
                if (l[u][sl] > 0.f) {
#pragma unroll
                    for (int e = 0; e < 4; ++e) { acc[2 * e] += w * bflo(a[e]); acc[2 * e + 1] += w * bfhi(a[e]); acc[8 + 2 * e] += w * bflo(b[e]); acc[8 + 2 * e + 1] += w * bfhi(b[e]); } } }
            const float f = (1.0f / (1.0f + __expf(-gl[u]))) / Lt;
            v4u r0, r1; GAS v4u* dst = (GAS v4u*)(Od + (size_t)row * A1LD + hfull * 64 + q * 16);
#pragma unroll
            for (int e = 0; e < 4; ++e) { r0[e] = pk2(bflo(b0[u][e]) + acc[2 * e] * f, bfhi(b0[u][e]) + acc[2 * e + 1] * f); r1[e] = pk2(bflo(b1[u][e]) + acc[8 + 2 * e] * f, bfhi(b1[u][e]) + acc[8 + 2 * e + 1] * f); }
            dst[0] = r0; dst[1] = r1; }
    }
}
template <int MODE>
__device__ __forceinline__ void att_block_h(bf16x8 (&kf)[3][2], rsrc_t rs, int boff, int noff, const bf16x8 (&qf)[2][2], int pos0, const int (&lo)[2], const int (&hi)[2], const bool (&on)[2], AttState& st, int lane) {
    const int rq = lane >> 4;
    bf16x8 vf[2][4];
#pragma unroll
    for (int sl = 0; sl < 2; ++sl)
#pragma unroll
        for (int dg = 0; dg < 4; ++dg) vf[sl][dg] = frag_ld(rs, boff, 8 + sl * 4 + dg, lane);
    bf16x8 k3[2]; k3[0] = frag_ld(rs, boff, 6, lane); k3[1] = frag_ld(rs, boff, 7, lane);
    __builtin_amdgcn_sched_barrier(0);
    f32x4 s[2][4];
#pragma unroll
    for (int cg = 0; cg < 2; ++cg) { const float nm = -st.m[cg];
#pragma unroll
        for (int kg = 0; kg < 3; ++kg) { s[cg][kg] = (f32x4){nm, nm, nm, nm}; s[cg][kg] = MFMA16(kf[kg][0], qf[cg][0], s[cg][kg]); s[cg][kg] = MFMA16(kf[kg][1], qf[cg][1], s[cg][kg]); }
        s[cg][3] = (f32x4){nm, nm, nm, nm}; s[cg][3] = MFMA16(k3[0], qf[cg][0], s[cg][3]); s[cg][3] = MFMA16(k3[1], qf[cg][1], s[cg][3]); }
    __builtin_amdgcn_sched_barrier(0);
    load_k(kf, rs, noff, lane);
    __builtin_amdgcn_sched_barrier(0);
#pragma unroll
    for (int cg = 0; cg < 2; ++cg) {
        if (MODE == 1) { const int rlo = lo[cg] - pos0 - 4 * rq, rhi = hi[cg] - pos0 - 4 * rq;
#pragma unroll
            for (int kg = 0; kg < 4; ++kg)
#pragma unroll
                for (int i = 0; i < 4; ++i) { const bool ok = (16 * kg + i) >= rlo && (16 * kg + i) <= rhi; s[cg][kg][i] = ok ? s[cg][kg][i] : -INFINITY; } }
        if (MODE == 2) {
#pragma unroll
            for (int kg = 0; kg < 4; ++kg)
#pragma unroll
                for (int i = 0; i < 4; ++i) s[cg][kg][i] = on[cg] ? s[cg][kg][i] : -INFINITY; }
        float mx = fmaxf(fmaxf(s[cg][0][0], s[cg][0][1]), fmaxf(s[cg][0][2], s[cg][0][3]));
#pragma unroll
        for (int kg = 1; kg < 4; ++kg) mx = fmaxf(fmaxf(mx, fmaxf(s[cg][kg][0], s[cg][kg][1])), fmaxf(s[cg][kg][2], s[cg][kg][3]));
        if (__any(mx > 8.0f || (mx < -32.0f && mx > -INFINITY))) { mx = max_x16_x32(mx); const float lc = sum_x16_x32(st.l[cg]); const float dl = lc > 0.f ? fmaxf(mx, 0.f) : (mx > -INFINITY ? mx : 0.f), alpha = __builtin_amdgcn_exp2f(-dl); st.m[cg] += dl; st.l[cg] *= alpha;
#pragma unroll
            for (int kg = 0; kg < 4; ++kg) s[cg][kg] = s[cg][kg] - dl;
#pragma unroll
            for (int dg = 0; dg < 4; ++dg) st.o[dg][cg] = st.o[dg][cg] * alpha; }
        float ls = 0.f;
#pragma unroll
        for (int kg = 0; kg < 4; ++kg)
#pragma unroll
            for (int i = 0; i < 4; ++i) { const float p = __builtin_amdgcn_exp2f(s[cg][kg][i]); s[cg][kg][i] = p; ls += p; }
        st.l[cg] += ls;
#pragma unroll
        for (int sl = 0; sl < 2; ++sl) { const bf16x8 pf = pack_p(s[cg][2 * sl], s[cg][2 * sl + 1]);
#pragma unroll
            for (int dg = 0; dg < 4; ++dg) st.o[dg][cg] = MFMA16(vf[sl][dg], pf, st.o[dg][cg]); }
    }
}
__device__ __forceinline__ void att_init0h(AttState& st) {
#pragma unroll
    for (int cg = 0; cg < 2; ++cg) { st.m[cg] = 0.f; st.l[cg] = 0.f;
#pragma unroll
        for (int dg = 0; dg < 4; ++dg) st.o[dg][cg] = (f32x4){0.f, 0.f, 0.f, 0.f}; }
}
__device__ __forceinline__ void attn_full_task(const bf16* QG, const float* qn, bf16* O, const SeqDesc sd, int g, LAS unsigned char* wl, int lane) {
    const int col16 = lane & 15, rq = lane >> 4, head = col16 & 3, tk4 = col16 >> 2;
    const int t0 = sd.P, cur = t0 >> 6, qrow = sd.qrow0;
    LAS float* impL = (LAS float*)wl;
    LAS int* selL = (LAS int*)(wl + 4096);
    LAS int* prog = (LAS int*)(wl + 4352);
    LAS f32x4* oL = (LAS f32x4*)(wl + 4608) + lane;
    bf16x8 qf[2][2]; int tcol[2]; float glg[2][3];
#pragma unroll
    for (int cg = 0; cg < 2; ++cg) { tcol[cg] = t0 + 4 * cg + tk4; load_q(QG, qn, qrow + 4 * cg + tk4, g * 4 + head, rq, qf[cg]);
        const GAS bf16* gp = (const GAS bf16*)QG + (size_t)(qrow + 4 * cg + tk4) * QGLD + 1024 + (g * 4 + head) * 3;
#pragma unroll
        for (int br = 0; br < 3; ++br) glg[cg][br] = bf2f(gp[br]); }
    {
        int hic[2]; hic[0] = ((tcol[0] + 1) >> 5) - 1; hic[1] = ((tcol[1] + 1) >> 5) - 1;
        int cbmax = (2 * cur + 1) >> 6; if (cbmax > sd.ncb - 1) cbmax = sd.ncb - 1;
        float m[2] = {0.f, 0.f}, l[2] = {0.f, 0.f};
#pragma unroll 1
        for (int cb = 0; cb <= cbmax; ++cb) {
            const GAS unsigned char* kb = (const GAS unsigned char*)sd.cmp + (size_t)cb * FRAGB + lane * 16;
            bf16x8 kf[4][2];
#pragma unroll
            for (int kg = 0; kg < 4; ++kg) { kf[kg][0] = *(const GAS bf16x8*)(kb + (kg * 2) * 1024); kf[kg][1] = *(const GAS bf16x8*)(kb + (kg * 2 + 1) * 1024); }
#pragma unroll
            for (int cg = 0; cg < 2; ++cg) {
                f32x4 sc[4]; const float nm = -m[cg]; float mx = -INFINITY;
#pragma unroll
                for (int kg = 0; kg < 4; ++kg) { sc[kg] = (f32x4){nm, nm, nm, nm}; sc[kg] = MFMA16(kf[kg][0], qf[cg][0], sc[kg]); sc[kg] = MFMA16(kf[kg][1], qf[cg][1], sc[kg]); }
#pragma unroll
                for (int kg = 0; kg < 4; ++kg)
#pragma unroll
                    for (int i = 0; i < 4; ++i) { sc[kg][i] = (16 * kg + i) <= hic[cg] - 64 * cb - 4 * rq ? sc[kg][i] : -INFINITY; mx = fmaxf(mx, sc[kg][i]); }
                if (__any(mx > 8.0f || (mx < -32.0f && mx > -INFINITY))) { mx = max_x16_x32(mx); const float lc = sum_x16_x32(l[cg]); const float dl = lc > 0.f ? fmaxf(mx, 0.f) : (mx > -INFINITY ? mx : 0.f); m[cg] += dl; l[cg] *= __builtin_amdgcn_exp2f(-dl);
#pragma unroll
                    for (int kg = 0; kg < 4; ++kg) sc[kg] = sc[kg] - dl; }
#pragma unroll
                for (int kg = 0; kg < 4; ++kg)
#pragma unroll
                    for (int i = 0; i < 4; ++i) l[cg] += __builtin_amdgcn_exp2f(sc[kg][i]);
            }
        }
        float linv[2];
#pragma unroll
        for (int cg = 0; cg < 2; ++cg) { const float lt = sum_x16_x32(l[cg]); linv[cg] = lt > 0.f ? 1.0f / lt : 0.f; }
        f32x4 oc4[4][2];
#pragma unroll
        for (int dg = 0; dg < 4; ++dg) { oc4[dg][0] = (f32x4){0.f, 0.f, 0.f, 0.f}; oc4[dg][1] = (f32x4){0.f, 0.f, 0.f, 0.f}; }
#pragma unroll 1
        for (int cb = 0; cb <= cbmax; ++cb) {
            const GAS unsigned char* kb = (const GAS unsigned char*)sd.cmp + (size_t)cb * FRAGB + lane * 16;
            bf16x8 kf[4][2], vf[2][4];
#pragma unroll
            for (int kg = 0; kg < 4; ++kg) { kf[kg][0] = *(const GAS bf16x8*)(kb + (kg * 2) * 1024); kf[kg][1] = *(const GAS bf16x8*)(kb + (kg * 2 + 1) * 1024); }
#pragma unroll
            for (int sl = 0; sl < 2; ++sl)
#pragma unroll
                for (int dg = 0; dg < 4; ++dg) vf[sl][dg] = *(const GAS bf16x8*)(kb + 8192 + (sl * 4 + dg) * 1024);
#pragma unroll
            for (int cg = 0; cg < 2; ++cg) {
                f32x4 sc[4]; const float nm = -m[cg];
#pragma unroll
                for (int kg = 0; kg < 4; ++kg) { sc[kg] = (f32x4){nm, nm, nm, nm}; sc[kg] = MFMA16(kf[kg][0], qf[cg][0], sc[kg]); sc[kg] = MFMA16(kf[kg][1], qf[cg][1], sc[kg]); }
#pragma unroll
                for (int kg = 0; kg < 4; ++kg) {
#pragma unroll
                    for (int i = 0; i < 4; ++i) sc[kg][i] = (16 * kg + i) <= hic[cg] - 64 * cb - 4 * rq ? __builtin_amdgcn_exp2f(sc[kg][i]) * linv[cg] : 0.f;
                    float e0 = sc[kg][0] + sc[kg][1], e1 = sc[kg][2] + sc[kg][3];
                    e0 = sum4(e0); e1 = sum4(e1);
                    if (head == 0) { LAS float* ip = impL + (4 * cg + tk4) * 128 + 32 * cb + 8 * kg + 2 * rq; ip[0] = e0; ip[1] = e1; }
                }
#pragma unroll
                for (int sl = 0; sl < 2; ++sl) { const bf16x8 pf = pack_p(sc[2 * sl], sc[2 * sl + 1]);
#pragma unroll
                    for (int dg = 0; dg < 4; ++dg) oc4[dg][cg] = MFMA16(vf[sl][dg], pf, oc4[dg][cg]); }
            }
        }
#pragma unroll
        for (int cg = 0; cg < 2; ++cg) { const float gt = 1.0f / (1.0f + __expf(-glg[cg][0]));
#pragma unroll
            for (int dg = 0; dg < 4; ++dg) oL[(dg * 2 + cg) * 64] = oc4[dg][cg] * gt; }
    }
    LDS_WAIT(); asm volatile("" ::: "memory");
    {
        const int tok = lane >> 3, j8 = lane & 7; float v[16];
#pragma unroll
        for (int k = 0; k < 16; ++k) { const int bb = 16 * j8 + k; const float x = impL[tok * 128 + bb]; v[k] = (bb >= 1 && bb <= cur - 2) ? x : -1.f; }
#pragma unroll
        for (int r = 0; r < 5; ++r) {
            float best = v[0]; int bi = 0;
#pragma unroll
            for (int k = 1; k < 16; ++k) if (v[k] > best) { best = v[k]; bi = k; }
            int gi = 16 * j8 + bi;
#pragma unroll
            for (int st_ = 0; st_ < 3; ++st_) { const float ov = st_ == 0 ? DPP_F(best, DPP_XOR1) : st_ == 1 ? DPP_F(best, DPP_XOR2) : DPP_F(best, DPP_HMIRROR);
                const int oi = st_ == 0 ? DPP_I(gi, DPP_XOR1) : st_ == 1 ? DPP_I(gi, DPP_XOR2) : DPP_I(gi, DPP_HMIRROR); if (ov > best || (ov == best && oi < gi)) { best = ov; gi = oi; } }
            if (j8 == 0) selL[tok * 8 + r] = best >= 0.f ? gi : -1;
            if ((gi >> 4) == j8) {
#pragma unroll
                for (int k = 0; k < 16; ++k) if ((gi & 15) == k) v[k] = -1.f; }
        }
    }
    LDS_WAIT(); asm volatile("" ::: "memory");
    {
        AttState st; att_init0h(st);
        int lo[2] = {0, 0}, hi[2] = {tcol[0], tcol[1]};
        int nprog;
        {
            int fm = 1 << 16; asm volatile("" : "+s"(fm));
            if (lane == 0) { int n = 0; prog[n++] = 0 | fm; if (cur >= 2) prog[n++] = (cur - 1) | fm; if (cur >= 1) prog[n++] = cur | fm; prog[63] = n; }
            LDS_WAIT(); asm volatile("" ::: "memory");
            int n = __builtin_amdgcn_readfirstlane(prog[63]);
#pragma unroll 1
            for (int half = 0; half < 2; ++half) { const int b = lane + 64 * half; int tm = 0;
#pragma unroll 1
                for (int tok = 0; tok < 8; ++tok)
#pragma unroll
                    for (int r = 0; r < 5; ++r) tm |= (selL[tok * 8 + r] == b) ? (1 << tok) : 0;
                const unsigned long long bal = __ballot(tm != 0); const int pre = __popcll(bal & ((1ull << lane) - 1ull));
                if (tm != 0) prog[n + pre] = b | (tm << 8);
                n += __popcll(bal); }
            if (lane == 0) { prog[n] = prog[n - 1]; prog[63] = n; }
            LDS_WAIT(); asm volatile("" ::: "memory"); nprog = __builtin_amdgcn_readfirstlane(prog[63]); }
        const rsrc_t rs = mk_rsrc(sd.slc);
        bf16x8 kf[3][2]; load_k(kf, rs, 0, lane);
#pragma unroll 1
        for (int i = 0; i < nprog; ++i) {
            const int e = __builtin_amdgcn_readfirstlane(prog[i]), en = __builtin_amdgcn_readfirstlane(prog[i + 1]);
            const int b = e & 255, tm = (e >> 8) & 255, bp = b * FRAGB, np = (en & 255) * FRAGB;
            bool on[2]; on[0] = (tm >> tk4) & 1; on[1] = (tm >> (4 + tk4)) & 1;
            if (e >> 16) { if (b == cur) att_block_h<1>(kf, rs, bp, np, qf, 64 * b, lo, hi, on, st, lane); else att_block_h<0>(kf, rs, bp, np, qf, 64 * b, lo, hi, on, st, lane); }
            else att_block_h<2>(kf, rs, bp, np, qf, 64 * b, lo, hi, on, st, lane);
        }
#pragma unroll
        for (int cg = 0; cg < 2; ++cg) { const float lt = sum_x16_x32(st.l[cg]), f = (1.0f / (1.0f + __expf(-glg[cg][1]))) / lt;
#pragma unroll
            for (int dg = 0; dg < 4; ++dg) oL[(dg * 2 + cg) * 64] = oL[(dg * 2 + cg) * 64] + st.o[dg][cg] * f; }
    }
    asm volatile("" ::: "memory");
    {
        AttState st; att_init0h(st);
        int lo[2] = {tcol[0] - 512, tcol[1] - 512}, hi[2] = {tcol[0], tcol[1]}; bool on[2] = {true, true};
        int b0 = cur - 8; if (b0 < sd.win_blk0) b0 = sd.win_blk0;
        const rsrc_t rs = mk_rsrc(sd.win);
        bf16x8 kf[3][2]; load_k(kf, rs, (b0 - sd.win_blk0) * FRAGB, lane);
#pragma unroll 1
        for (int b = b0; b <= cur; ++b) { const int bn = b < cur ? b + 1 : b; const bool edge = b == cur || b == cur - 8;
            if (edge) att_block_h<1>(kf, rs, (b - sd.win_blk0) * FRAGB, (bn - sd.win_blk0) * FRAGB, qf, 64 * b, lo, hi, on, st, lane);
            else att_block_h<0>(kf, rs, (b - sd.win_blk0) * FRAGB, (bn - sd.win_blk0) * FRAGB, qf, 64 * b, lo, hi, on, st, lane); }
#pragma unroll
        for (int cg = 0; cg < 2; ++cg) { const float lt = sum_x16_x32(st.l[cg]), f = (1.0f / (1.0f + __expf(-glg[cg][2]))) / lt;
            int l3 = lane; asm volatile("" : "+v"(l3)); const unsigned ooff = (unsigned)(qrow + 4 * cg + ((l3 & 15) >> 2)) * (unsigned)A1LD + (unsigned)((g * 4 + (l3 & 3)) * 64 + 4 * (l3 >> 4)); GAS bf16* op = (GAS bf16*)O + ooff;
#pragma unroll
            for (int dg = 0; dg < 4; ++dg) { const f32x4 ov = oL[(dg * 2 + cg) * 64] + st.o[dg][cg] * f; v2u w; w.x = pk2(ov[0], ov[1]); w.y = pk2(ov[2], ov[3]); *(GAS v2u*)(op + 16 * dg) = w; } }
    }
    LDS_WAIT(); asm volatile("" ::: "memory");
}
__device__ __forceinline__ void attn_sample_part(Frame& F, int j) {
    unsigned char* ws = AWS; const bf16* QG = (const bf16*)(ws + WS_QG); const float* qn = AIN(17) + j * 64;
    LAS unsigned* ctr2 = (LAS unsigned*)(F.lds + LDSCTL_OFF + 128) + 2 + j; unsigned si = 0; const int l0 = lane_id();
    if (l0 == 0) si = __hip_atomic_fetch_add(ctr2, 1u, __ATOMIC_RELAXED, __HIP_MEMORY_SCOPE_WORKGROUP);
    const int sidx = __builtin_amdgcn_readfirstlane(si);
    if (sidx < 2) { const int t = F.vcu * 2 + sidx, seq = t >> 2; SeqDesc sd;
        sd.qrow0 = MP + seq * 8; sd.P = PAST; sd.win_blk0 = 24; sd.ncb = 1;
        sd.slc = ws + WS_SLCS + (size_t)t * 33 * FRAGB; sd.win = ws + WS_WINS + (size_t)t * 9 * FRAGB; sd.cmp = ws + WS_CMPS + (size_t)t * FRAGB;
        sd.cnt = nullptr; sd.list = nullptr; sd.parto = nullptr; sd.partml = nullptr;
        attn_full_task(QG, qn, (bf16*)(ws + WS_ACT1), sd, t & 3, F.lds + F.wave * WLDS_BYTES, lane_id());
#if defined(PROBE_SAMP2)
        attn_full_task(QG, qn, (bf16*)(ws + WS_ACT1), sd, t & 3, F.lds + F.wave * WLDS_BYTES, lane_id());
#endif
    }
}
__device__ __forceinline__ void glds16(const void* gsrc, unsigned lds_dst) { unsigned keep;
    asm volatile("s_mov_b32 %0, m0\n\ts_mov_b32 m0, %2\n\ts_nop 0\n\tglobal_load_lds_dwordx4 %1, off\n\ts_mov_b32 m0, %0" : "=&s"(keep) : "v"(gsrc), "s"(lds_dst) : "memory"); }
__device__ __forceinline__ bf16x8 lfrag(const LAS unsigned char* buf, int k, int lane) { return *(const LAS bf16x8*)(buf + k * 1024 + lane * 16); }
template <int MODE>
__device__ __forceinline__ void att_block_lds(const LAS unsigned char* buf, const bf16x8 (&qf)[2][2], int pos0, const int (&lo)[2], const int (&hi)[2], AttState& st, int lane, bool up = true) {
    const int rq = lane >> 4; constexpr float THR = 8.0f;
    typedef float f32x2v __attribute__((ext_vector_type(2)));
    f32x4 s[2][4];
    {
        bf16x8 kf[4][2];
#pragma unroll
        for (int kg = 0; kg < 4; ++kg) { kf[kg][0] = lfrag(buf, kg * 2, lane); kf[kg][1] = lfrag(buf, kg * 2 + 1, lane); }
        if (__all(st.m[0] == 0.f && st.m[1] == 0.f)) {
#pragma unroll
            for (int cg = 0; cg < 2; ++cg)
#pragma unroll
                for (int kg = 0; kg < 4; ++kg) { s[cg][kg] = MFMA16(kf[kg][0], qf[cg][0], ((f32x4){0.f, 0.f, 0.f, 0.f})); s[cg][kg] = MFMA16(kf[kg][1], qf[cg][1], s[cg][kg]); }
        } else {
#pragma unroll
            for (int cg = 0; cg < 2; ++cg) { const float nm = -st.m[cg];
#pragma unroll
                for (int kg = 0; kg < 4; ++kg) { s[cg][kg] = (f32x4){nm, nm, nm, nm}; s[cg][kg] = MFMA16(kf[kg][0], qf[cg][0], s[cg][kg]); s[cg][kg] = MFMA16(kf[kg][1], qf[cg][1], s[cg][kg]); } }
        }
    }
    bf16x8 vf[2][4];
#pragma unroll
    for (int sl = 0; sl < 2; ++sl)
#pragma unroll
        for (int dg = 0; dg < 4; ++dg) vf[sl][dg] = lfrag(buf, 8 + sl * 4 + dg, lane);
#pragma unroll
    for (int cg = 0; cg < 2; ++cg) {
        const int rb0 = (up ? hi[cg] : lo[cg]) - pos0 - 4 * rq, rb = up ? rb0 : 51 - rb0;
        const bool has = MODE == 0 ? true : rb >= 0;
#define KC(kg_, i_) (up ? (16 * (kg_) + (i_)) : (51 - 16 * (kg_) - (i_)))
        float ls;
        {
            f32x2v a2 = (f32x2v){0.f, 0.f};
#pragma unroll
            for (int kg = 0; kg < 4; ++kg) { f32x4 pv;
#pragma unroll
                for (int i = 0; i < 4; ++i) { pv[i] = __builtin_amdgcn_exp2f(s[cg][kg][i]);
                    if (MODE == 1) pv[i] = KC(kg, i) <= rb ? pv[i] : 0.f; }
                a2 += (f32x2v){pv[0], pv[1]}; a2 += (f32x2v){pv[2], pv[3]}; s[cg][kg] = pv; }
            ls = a2.x + a2.y;
        }
#if defined(PROBE_RARE)
        if (__any(ls >= 0.f)) {
#else
        if (__any(!(ls <= 4096.0f) || (has && ls < 0x1p-30f))) {
#endif
            const float nm = -st.m[cg];
#pragma unroll
            for (int kg = 0; kg < 4; ++kg) { const bf16x8 k0 = lfrag(buf, kg * 2, lane), k1 = lfrag(buf, kg * 2 + 1, lane); s[cg][kg] = (f32x4){nm, nm, nm, nm}; s[cg][kg] = MFMA16(k0, qf[cg][0], s[cg][kg]); s[cg][kg] = MFMA16(k1, qf[cg][1], s[cg][kg]); }
            if (MODE != 0) {
#pragma unroll
                for (int kg = 0; kg < 4; ++kg)
#pragma unroll
                    for (int i = 0; i < 4; ++i) { const bool ok = KC(kg, i) <= rb; s[cg][kg][i] = ok ? s[cg][kg][i] : -INFINITY; } }
            float mx = fmaxf(fmaxf(s[cg][0][0], s[cg][0][1]), fmaxf(s[cg][0][2], s[cg][0][3]));
#pragma unroll
            for (int kg = 1; kg < 4; ++kg) mx = fmaxf(fmaxf(mx, fmaxf(s[cg][kg][0], s[cg][kg][1])), fmaxf(s[cg][kg][2], s[cg][kg][3]));
            if (__any(mx > THR || (mx < -32.0f && mx > -INFINITY))) {
                mx = max_x16_x32(mx); const float lc = sum_x16_x32(st.l[cg]); const float dl = lc > 0.f ? fmaxf(mx, 0.f) : (mx > -INFINITY ? mx : 0.f), alpha = __builtin_amdgcn_exp2f(-dl); st.m[cg] += dl; st.l[cg] *= alpha;
#pragma unroll
                for (int kg = 0; kg < 4; ++kg) s[cg][kg] = s[cg][kg] - dl;
#pragma unroll
                for (int dg = 0; dg < 4; ++dg) st.o[dg][cg] = st.o[dg][cg] * alpha;
            }
            ls = 0.f;
#pragma unroll
            for (int kg = 0; kg < 4; ++kg)
#pragma unroll
                for (int i = 0; i < 4; ++i) { const float p = __builtin_amdgcn_exp2f(s[cg][kg][i]); s[cg][kg][i] = p; ls += p; }
        }
        st.l[cg] += ls;
#pragma unroll
        for (int sl = 0; sl < 2; ++sl) { const bf16x8 pf = pack_p(s[cg][2 * sl], s[cg][2 * sl + 1]);
#pragma unroll
            for (int dg = 0; dg < 4; ++dg) st.o[dg][cg] = MFMA16(vf[sl][dg], pf, st.o[dg][cg]); }
    }
}
#undef KC
__device__ __forceinline__ void att_init0(AttState& st) {
#pragma unroll
    for (int cg = 0; cg < 2; ++cg) { st.m[cg] = 0.f; st.l[cg] = 0.f;
#pragma unroll
        for (int dg = 0; dg < 4; ++dg) st.o[dg][cg] = (f32x4){0.f, 0.f, 0.f, 0.f}; }
}

__device__ __forceinline__ void attn_tile_phase(Frame& F, int j) {
    unsigned char* ws = AWS; const bf16* QG = (const bf16*)(ws + WS_QG); bf16* O = (bf16*)(ws + WS_ACT1); const float* qn = AIN(17) + j * 64;
    const int w = F.wave, bg = F.vcu >> 5, c5 = F.vcu & 31, b = bg >> 2, g = bg & 3;
    const unsigned char* cmpb = ws + WS_CMPP + (size_t)bg * 4 * FRAGB; const unsigned char* slcb = ws + WS_SLCP + (size_t)bg * 128 * FRAGB; const unsigned char* winb = ws + WS_WINP + (size_t)bg * 128 * FRAGB;
    unsigned* cnt = (unsigned*)F.ctl + CW_CNT + (j * 1024 + bg * 128) * CNT_PAD; GAS unsigned* list = (GAS unsigned*)(ws + WS_LIST) + (size_t)bg * 128 * 8192;
    GAS bf16* parto = (GAS bf16*)(ws + WS_PARTO); GAS float* partml = (GAS float*)(ws + WS_PARTML);
    const LAS unsigned char* ring = F.lds; const unsigned lds0 = (unsigned)(unsigned long long)(const LAS void*)F.lds;
    LAS unsigned char* wl = F.lds + 65536 + w * 8448; LAS float* impL = (LAS float*)wl; LAS int* selL = (LAS int*)(wl + 4096);
    int pend_b = -1; unsigned pend_idx = 0u, pend_val = 0u;
#pragma unroll 1
    for (int tile = 0; tile < 4; ++tile) {
        const int lane = lane_id(), col16 = lane & 15, rq = lane >> 4, head = col16 & 3, tk4 = col16 >> 2;
        const int cur = tile == 0 ? c5 : tile == 1 ? 63 - c5 : tile == 2 ? 64 + c5 : 127 - c5;
        const int oc = 8 * cur + w, t0 = 8 * oc, qrow = b * SEQ + t0;
        const int n1 = ((2 * cur + 1) >> 6) + 1, nf = cur >= 2 ? 3 : cur + 1, wb0 = cur > 8 ? cur - 8 : 0, nw = cur - wb0 + 1, nsteps = 2 * n1 + nf + nw;
#define STEP_PTR(s_) ((s_) < 2 * n1 ? cmpb + (size_t)((s_) < n1 ? (s_) : (s_) - n1) * FRAGB : (s_) < 2 * n1 + nf ? slcb + (size_t)((s_) == 2 * n1 ? 0 : ((s_) == 2 * n1 + nf - 1 ? cur : cur - 1)) * FRAGB : winb + (size_t)(wb0 + (s_) - 2 * n1 - nf) * FRAGB)
#define ISSUE(s_) do { const unsigned char* gp_ = STEP_PTR(s_) + (size_t)(2 * w) * 1024 + lane * 16; const unsigned ld_ = lds0 + (unsigned)(((s_) & 3) * 16384 + 2 * w * 1024); glds16(gp_, ld_); glds16(gp_ + 1024, ld_ + 1024); } while (0)
        bf16x8 qf[2][2]; int tcol[2];
        v4u qr[2][2];
#pragma unroll
        for (int cg = 0; cg < 2; ++cg) { tcol[cg] = t0 + 4 * cg + tk4; load_q_raw(QG, qrow + 4 * cg + tk4, g * 4 + head, rq, qr[cg][0], qr[cg][1]); }
        float gl[2][3];
#pragma unroll
        for (int cg = 0; cg < 2; ++cg) { const GAS bf16* gp = (const GAS bf16*)QG + (size_t)(qrow + 4 * cg + tk4) * QGLD + 1024 + (g * 4 + head) * 3;
#pragma unroll
            for (int br = 0; br < 3; ++br) gl[cg][br] = bf2f(gp[br]); }
#pragma unroll
        for (int cg = 0; cg < 2; ++cg) norm_q(qr[cg][0], qr[cg][1], qn, rq, qf[cg]);
        asm volatile("s_waitcnt vmcnt(0) lgkmcnt(0)\n\ts_barrier" ::: "memory");
        if (pend_b >= 0) list[(size_t)pend_b * 8192 + pend_idx] = pend_val;
        ISSUE(0); if (1 < nsteps) ISSUE(1); if (2 < nsteps) ISSUE(2);
        int hic[2]; hic[0] = ((tcol[0] + 1) >> 5) - 1; hic[1] = ((tcol[1] + 1) >> 5) - 1;
        float m[2] = {0.f, 0.f}, l[2] = {0.f, 0.f}, linv[2] = {0.f, 0.f};
        const int hmin = ((t0 + 1) >> 5) - 1;
        bool atom_out = false;
        LAS v2u* oLp = (LAS v2u*)(wl + 4352) + lane;
#if defined(PROBE_V0)
#define STEP_HEAD(s_) do { asm volatile("s_waitcnt vmcnt(0)\n\ts_barrier" ::: "memory"); if ((s_) + 3 < nsteps) ISSUE((s_) + 3); } while (0)
#else
#define STEP_HEAD(s_) do { if ((s_) + 2 < nsteps) asm volatile("s_waitcnt vmcnt(4)\n\ts_barrier" ::: "memory"); \
            else if ((s_) + 1 < nsteps) asm volatile("s_waitcnt vmcnt(2)\n\ts_barrier" ::: "memory"); \
            else if (atom_out) asm volatile("s_waitcnt vmcnt(1)\n\ts_barrier" ::: "memory"); else asm volatile("s_waitcnt vmcnt(0)\n\ts_barrier" ::: "memory"); \
            if ((s_) + 3 < nsteps) ISSUE((s_) + 3); } while (0)
#endif
#if defined(PROBE_SK)
        { for (int s2 = 0; s2 < nsteps; ++s2) { STEP_HEAD(s2); }
          asm volatile("s_waitcnt vmcnt(0) lgkmcnt(0)\n\ts_barrier" ::: "memory"); ISSUE(0); if (1 < nsteps) ISSUE(1); if (2 < nsteps) ISSUE(2); }
#endif
        int s = 0;
#pragma unroll 1
        for (; s < n1; ++s) {
            STEP_HEAD(s); const LAS unsigned char* buf = ring + (s & 3) * 16384;
            const int cb = s; bf16x8 kf[4][2];
#pragma unroll
            for (int kg = 0; kg < 4; ++kg) { kf[kg][0] = lfrag(buf, kg * 2, lane); kf[kg][1] = lfrag(buf, kg * 2 + 1, lane); }
            const bool full = 64 * cb + 63 <= hmin;
            const bool mz = __all(m[0] == 0.f && m[1] == 0.f);
#pragma unroll
            for (int cg = 0; cg < 2; ++cg) {
                typedef float f32x2v __attribute__((ext_vector_type(2)));
                f32x4 sc[4]; const float nm = -m[cg];
                if (mz) {
#pragma unroll
                    for (int kg = 0; kg < 4; ++kg) { sc[kg] = MFMA16(kf[kg][0], qf[cg][0], ((f32x4){0.f, 0.f, 0.f, 0.f})); sc[kg] = MFMA16(kf[kg][1], qf[cg][1], sc[kg]); }
                } else {
#pragma unroll
                    for (int kg = 0; kg < 4; ++kg) { sc[kg] = (f32x4){nm, nm, nm, nm}; sc[kg] = MFMA16(kf[kg][0], qf[cg][0], sc[kg]); sc[kg] = MFMA16(kf[kg][1], qf[cg][1], sc[kg]); } }
                const int rb = hic[cg] - 64 * cb - 4 * rq; const bool has = full || rb >= 0;
                f32x2v a2 = (f32x2v){0.f, 0.f};
                if (full) {
#pragma unroll
                    for (int kg = 0; kg < 4; ++kg) { f32x4 pv;
#pragma unroll
                        for (int i = 0; i < 4; ++i) pv[i] = __builtin_amdgcn_exp2f(sc[kg][i]);
                        a2 += (f32x2v){pv[0], pv[1]}; a2 += (f32x2v){pv[2], pv[3]}; }
                } else {
#pragma unroll
                    for (int kg = 0; kg < 4; ++kg) { f32x4 pv;
#pragma unroll
                        for (int i = 0; i < 4; ++i) { pv[i] = __builtin_amdgcn_exp2f(sc[kg][i]); pv[i] = (16 * kg + i) <= rb ? pv[i] : 0.f; }
                        a2 += (f32x2v){pv[0], pv[1]}; a2 += (f32x2v){pv[2], pv[3]}; } }
                float ls = a2.x + a2.y;
#if defined(PROBE_RARE)
                if (__any(ls >= 0.f)) {
#else
                if (__any(!(ls <= 4096.0f) || (has && ls < 0x1p-30f))) {
#endif
#pragma unroll
                    for (int kg = 0; kg < 4; ++kg) { sc[kg] = (f32x4){nm, nm, nm, nm}; sc[kg] = MFMA16(kf[kg][0], qf[cg][0], sc[kg]); sc[kg] = MFMA16(kf[kg][1], qf[cg][1], sc[kg]); }
#pragma unroll
                    for (int kg = 0; kg < 4; ++kg)
#pragma unroll
                        for (int i = 0; i < 4; ++i) sc[kg][i] = (16 * kg + i) <= rb ? sc[kg][i] : -INFINITY;
                    float mx = fmaxf(fmaxf(sc[0][0], sc[0][1]), fmaxf(sc[0][2], sc[0][3]));
#pragma unroll
                    for (int kg = 1; kg < 4; ++kg) mx = fmaxf(fmaxf(mx, fmaxf(sc[kg][0], sc[kg][1])), fmaxf(sc[kg][2], sc[kg][3]));
                    if (__any(mx > 8.0f || (mx < -32.0f && mx > -INFINITY))) { mx = max_x16_x32(mx); const float lc = sum_x16_x32(l[cg]); const float dl = lc > 0.f ? fmaxf(mx, 0.f) : (mx > -INFINITY ? mx : 0.f); m[cg] += dl; l[cg] *= __builtin_amdgcn_exp2f(-dl);
#pragma unroll
                        for (int kg = 0; kg < 4; ++kg) sc[kg] = sc[kg] - dl; }
                    ls = 0.f;
#pragma unroll
                    for (int kg = 0; kg < 4; ++kg)
#pragma unroll
                        for (int i = 0; i < 4; ++i) ls += __builtin_amdgcn_exp2f(sc[kg][i]);
                }
                l[cg] += ls;
            }
        }
#pragma unroll
        for (int cg = 0; cg < 2; ++cg) { float lt = l[cg]; lt = sum_x16_x32(lt); linv[cg] = lt > 0.f ? 1.0f / lt : 0.f; }
        {
            f32x4 outv[4][2];
#pragma unroll
            for (int dg = 0; dg < 4; ++dg) { outv[dg][0] = (f32x4){0.f, 0.f, 0.f, 0.f}; outv[dg][1] = (f32x4){0.f, 0.f, 0.f, 0.f}; }
#pragma unroll 1
            for (; s < 2 * n1; ++s) {
                STEP_HEAD(s); const LAS unsigned char* buf = ring + (s & 3) * 16384;
                const int cb = s - n1; bf16x8 kf[4][2], vf[2][4];
                const bool mz2 = __all(m[0] == 0.f && m[1] == 0.f);
#pragma unroll
                for (int kg = 0; kg < 4; ++kg) { kf[kg][0] = lfrag(buf, kg * 2, lane); kf[kg][1] = lfrag(buf, kg * 2 + 1, lane); }
#pragma unroll
                for (int sl = 0; sl < 2; ++sl)
#pragma unroll
                    for (int dg = 0; dg < 4; ++dg) vf[sl][dg] = lfrag(buf, 8 + sl * 4 + dg, lane);
#pragma unroll
                for (int cg = 0; cg < 2; ++cg) {
                    f32x4 sc[4];
#pragma unroll
                    for (int kg = 0; kg < 4; ++kg) { const float nm = -m[cg];
                        if (mz2) sc[kg] = MFMA16(kf[kg][0], qf[cg][0], ((f32x4){0.f, 0.f, 0.f, 0.f})); else { sc[kg] = (f32x4){nm, nm, nm, nm}; sc[kg] = MFMA16(kf[kg][0], qf[cg][0], sc[kg]); }
                        sc[kg] = MFMA16(kf[kg][1], qf[cg][1], sc[kg]); }
                    if (64 * cb + 63 > hmin) {
#pragma unroll
                        for (int kg = 0; kg < 4; ++kg)
#pragma unroll
                            for (int i = 0; i < 4; ++i) sc[kg][i] = (16 * kg + i) <= hic[cg] - 64 * cb - 4 * rq ? sc[kg][i] : -INFINITY; }
#pragma unroll
                    for (int kg = 0; kg < 4; ++kg) {
#pragma unroll
                        for (int i = 0; i < 4; ++i) sc[kg][i] = __builtin_amdgcn_exp2f(sc[kg][i]) * linv[cg];
                        float e0 = sc[kg][0] + sc[kg][1], e1 = sc[kg][2] + sc[kg][3];
                        e0 = sum4(e0); e1 = sum4(e1);
                        if (head == 0) { LAS float* ip = impL + (4 * cg + tk4) * 128 + 32 * cb + 8 * kg + 2 * rq; ip[0] = e0; ip[1] = e1; }
                    }
#pragma unroll
                    for (int sl = 0; sl < 2; ++sl) { const bf16x8 pf = pack_p(sc[2 * sl], sc[2 * sl + 1]);
#pragma unroll
                        for (int dg = 0; dg < 4; ++dg) outv[dg][cg] = MFMA16(vf[sl][dg], pf, outv[dg][cg]); }
                }
            }
#pragma unroll
            for (int cg = 0; cg < 2; ++cg) { const float gt = 1.0f / (1.0f + __expf(-gl[cg][0]));
#pragma unroll
                for (int dg = 0; dg < 4; ++dg) { const f32x4 ov = outv[dg][cg] * gt; v2u wv; wv.x = pk2(ov[0], ov[1]); wv.y = pk2(ov[2], ov[3]); oLp[(dg * 2 + cg) * 64] = wv; } }
        }
        LDS_WAIT(); asm volatile("" ::: "memory");
#if defined(PROBE_TK)
        for (int rep_ = 0; rep_ < 3; ++rep_)
#endif
        {
            const int tok = lane >> 3, j8 = lane & 7; float v[16];
#pragma unroll
            for (int k = 0; k < 16; ++k) { const int bb = 16 * j8 + k; const float x = impL[tok * 128 + bb]; v[k] = (bb >= 1 && bb <= cur - 2) ? x : -1.f; }
#pragma unroll
            for (int r = 0; r < 5; ++r) {
                float best = v[0]; int bi = 0;
#pragma unroll
                for (int k = 1; k < 16; ++k) if (v[k] > best) { best = v[k]; bi = k; }
                int gi = 16 * j8 + bi;
#pragma unroll
                for (int st_ = 0; st_ < 3; ++st_) { const float ov = st_ == 0 ? DPP_F(best, DPP_XOR1) : st_ == 1 ? DPP_F(best, DPP_XOR2) : DPP_F(best, DPP_HMIRROR);
                    const int oi = st_ == 0 ? DPP_I(gi, DPP_XOR1) : st_ == 1 ? DPP_I(gi, DPP_XOR2) : DPP_I(gi, DPP_HMIRROR); if (ov > best || (ov == best && oi < gi)) { best = ov; gi = oi; } }
                if (j8 == 0) selL[tok * 8 + r] = best >= 0.f ? gi : -1;
                if ((gi >> 4) == j8) {
#pragma unroll
                    for (int k = 0; k < 16; ++k) if ((gi & 15) == k) v[k] = -1.f; }
            }
        }
        LDS_WAIT(); asm volatile("" ::: "memory");
        int ent_b = -1; unsigned ent_idx = 0u, ent_val = 0u;
        if (lane < 40) { const int tok = lane / 5, r = lane - tok * 5, bb = selL[tok * 8 + r]; const size_t row = (size_t)(qrow + tok);
            if (bb >= 0) { ent_b = bb; ent_val = (unsigned)(t0 + tok) | ((unsigned)r << 16); }
            else {
#pragma unroll
                for (int h = 0; h < 4; ++h) { GAS float* mlp = partml + ((row * 6 + r) * 16 + g * 4 + h) * 2; mlp[0] = -1e30f; mlp[1] = 0.f; } } }
        {
            AttState st; att_init0(st);
            int lo[2] = {0, 0}, hi[2] = {tcol[0], tcol[1]};
            const int sw = 2 * n1 + nf;
            const int sa = nsteps - 3 > 2 * n1 ? nsteps - 3 : 2 * n1;
            const bool anyv = __any(ent_b >= 0);
#pragma unroll 1
            for (; s < nsteps; ++s) {
                if (s == sw) {
#pragma unroll
                    for (int cg = 0; cg < 2; ++cg) { float lt = st.l[cg]; lt = sum_x16_x32(lt); const size_t pi = ((size_t)(qrow + 4 * cg + tk4) * 6 + 5) * 16 + g * 4 + head;
                        if (rq == 0) { GAS float* mlp = partml + pi * 2; mlp[0] = st.m[cg]; mlp[1] = lt; }
#pragma unroll
                        for (int dg = 0; dg < 4; ++dg) { v2u wv; wv.x = pk2(st.o[dg][cg][0], st.o[dg][cg][1]); wv.y = pk2(st.o[dg][cg][2], st.o[dg][cg][3]); stg_put(wl, cg * 16 + col16, dg, rq, wv); } }
                    LDS_WAIT(); asm volatile("" ::: "memory");
                    { const int c_ = lane >> 1, tk_ = 4 * (c_ >> 4) + ((c_ & 15) >> 2), hd_ = c_ & 3; GAS bf16* pp = parto + ((((size_t)(qrow + tk_) * 6 + 5) * 16 + g * 4 + hd_) * 64) + (lane & 1) * 32;
#pragma unroll
                      for (int k = 0; k < 4; ++k) *(GAS v4u*)(pp + 8 * k) = stg_get(wl, lane, k); }
                    LDS_WAIT(); asm volatile("" ::: "memory");
                    att_init0(st); lo[0] = tcol[0] - 512; lo[1] = tcol[1] - 512;
                }
                STEP_HEAD(s); const LAS unsigned char* buf = ring + (s & 3) * 16384;
                if (s == sa && anyv) { if (ent_b >= 0) ent_idx = atomicAdd(cnt + ent_b * CNT_PAD, 1u); atom_out = true; }
                int blk, mode;
                if (s < sw) { const int fs = s - 2 * n1; blk = fs == 0 ? 0 : (fs == nf - 1 ? cur : cur - 1); mode = (blk == cur || blk == 0) ? 1 : 0; }
                else { blk = wb0 + (s - sw); mode = blk == cur ? 1 : (cur >= 8 && blk == wb0) ? 2 : 0; }
                if (mode != 0) att_block_lds<1>(buf, qf, 64 * blk, lo, hi, st, lane, mode == 1); else att_block_lds<0>(buf, qf, 64 * blk, lo, hi, st, lane);
            }
            v2u ow[2][4];
#pragma unroll
            for (int cg = 0; cg < 2; ++cg) { float lt = st.l[cg]; lt = sum_x16_x32(lt); const float f = (1.0f / (1.0f + __expf(-gl[cg][2]))) / lt;
#pragma unroll
                for (int dg = 0; dg < 4; ++dg) { const v2u pv = oLp[(dg * 2 + cg) * 64]; const f32x4 ov = (f32x4){bflo(pv.x), bfhi(pv.x), bflo(pv.y), bfhi(pv.y)} + st.o[dg][cg] * f;
                    ow[cg][dg].x = pk2(ov[0], ov[1]); ow[cg][dg].y = pk2(ov[2], ov[3]); } }
            LDS_WAIT(); asm volatile("" ::: "memory");
#pragma unroll
            for (int cg = 0; cg < 2; ++cg)
#pragma unroll
                for (int dg = 0; dg < 4; ++dg) stg_put(wl, cg * 16 + col16, dg, rq, ow[cg][dg]);
            LDS_WAIT(); asm volatile("" ::: "memory");
            { const int c_ = lane >> 1, tk_ = 4 * (c_ >> 4) + ((c_ & 15) >> 2), hd_ = c_ & 3; GAS bf16* op = (GAS bf16*)O + (size_t)(qrow + tk_) * A1LD + (g * 4 + hd_) * 64 + (lane & 1) * 32;
#pragma unroll
              for (int k = 0; k < 4; ++k) *(GAS v4u*)(op + 8 * k) = stg_get(wl, lane, k); }
            LDS_WAIT(); asm volatile("" ::: "memory");
        }
        pend_b = ent_b; pend_idx = ent_idx; pend_val = ent_val;
#undef STEP_HEAD
#undef STEP_PTR
#undef ISSUE
    }
    if (pend_b >= 0) list[(size_t)pend_b * 8192 + pend_idx] = pend_val;
    asm volatile("s_waitcnt vmcnt(0) lgkmcnt(0)\n\ts_barrier" ::: "memory");
}
#ifndef MK_FUSED
#define MK_FUSED 1
#endif
constexpr int NPHASE = 26;
#ifndef MK_STREAMK
#define MK_STREAMK 0
#endif
#if MK_STREAMK
#define ORDER_T pg8::StreamOrder
#define ORDER_INIT(M_, N_, K_, G_, v_, slab_, fl_, tmo_, ep_) S.init(M_, N_, K_, G_, v_, slab_, fl_, tmo_, ep_)
#else
#define ORDER_T pg8::StaticOrder
#define ORDER_INIT(M_, N_, K_, G_, v_, slab_, fl_, tmo_, ep_) S.init(M_, N_, G_, (int)blockIdx.x, K_)
#endif
__global__ void __launch_bounds__(NWAVES * 64, 2) yoco_fwd(Args args) {
    extern __shared__ __attribute__((aligned(16))) unsigned char lds[];
    Frame F;
    F.lds = (LAS unsigned char*)lds;
    F.MISC = (volatile LAS unsigned*)(F.lds + MISC_OFF);
    const int tid0 = threadIdx.x; F.wave = __builtin_amdgcn_readfirstlane(tid0 >> 6);
    { const int bx = blockIdx.x; F.vcu = (bx % 8) * (GRID / 8) + bx / 8; }

    if (tid0 < 25) { const unsigned long long* ka = (const unsigned long long*)__builtin_amdgcn_kernarg_segment_ptr();
        *(LAS unsigned long long*)(F.lds + ARGS_OFF + 8 * tid0) = ka[tid0]; }
    if (tid0 < 128) ((LAS unsigned*)(F.lds + LDSCTL_OFF))[tid0] = 0u;
    __syncthreads();
    F.ctl = (gu32*)(AWS + WS_CTL);
    XcdBarrier bar; bar.bar = (unsigned*)(F.ctl + CW_BAR); bar.x = 0; bar.st = nullptr;
    if (MK_FUSED) bar = xcd_barrier_post((unsigned*)(F.ctl + CW_BAR), F.MISC + 8);
#if MK_FUSED
    constexpr int lo = 0, hi = NPHASE;
#else
    const int lo = args.ph_lo, hi = args.ph_hi;
#endif
#if MK_FUSED && !defined(MK_PHMASK)
#define IN(k) ((k) < NPHASE)
#else
#ifndef MK_PHMASK
#define MK_PHMASK 0x3ffffff
#endif
#define IN(k) (((MK_PHMASK >> ((k) < NPHASE ? (k) : 0)) & 1) && lo <= (k) && (k) < hi)
#endif
#ifndef PROBE_REP
#define PROBE_REP -1
#endif
#define NREP(k) ((k) == PROBE_REP ? 2 : 1)
#define NREP_S(k) ((k) + 100 == PROBE_REP ? 4 : 1)
#define SEAM(k) do { if (IN(k) && IN((k) + 1)) { XcdBarrier b2_ = bar; asm volatile("" : "+s"(b2_.bar), "+s"(b2_.x)); xcd_barrier(b2_); } } while (0)
#define PHASE_PTRS unsigned char* ws = AWS; float* Y = AOUT; \
    bf16* XB = (bf16*)(ws + WS_XB); float* SSQ0 = (float*)(ws + WS_SSQ); float* SSQ1 = SSQ0 + (size_t)M * 32; \
    bf16* ACT1 = (bf16*)(ws + WS_ACT1); bf16* BIG16 = (bf16*)(ws + WS_BIG); bf16* QGB = (bf16*)(ws + WS_QG); \
    (void)XB; (void)SSQ0; (void)SSQ1; (void)ACT1; (void)BIG16; (void)QGB; (void)Y;
    typedef pg8::EpiScaleBf16<0> EpiS0; typedef pg8::EpiScaleBf16<1> EpiS1;

    if (IN(0)) { for (int rep = 0; rep < NREP(0); ++rep) { p0_prologue(F); __syncthreads(); } } SEAM(0);

    for (int l = 0; l < 2; ++l) {
        const int pb = 1 + 5 * l;
        if (IN(pb)) { PHASE_PTRS const int EPOCH = 2 * (pb) + 1;
            pg8::Gemm g{XB, (const bf16*)(ws + WS_WIN) + (size_t)l * 3072 * WLD1, MP, 3072, D, XBLD, WLD1}; ORDER_T S; ORDER_INIT(MP, 3072, D, F.G, F.vcu, (float*)(ws + WS_SLAB + (size_t)(EPOCH & 1) * 64 * MiB), (unsigned*)F.ctl + CW_SLABF, (unsigned*)F.ctl + CW_TMO, (unsigned)(EPOCH));
            pg8::PreRstd<ORDER_T> PR{(LAS float*)(F.lds + RING_BYTES), SSQ0, &S, F.wave}; EpiS0 E{BIG16, BCXLD, (const LAS float*)(F.lds + RING_BYTES)};
            for (int rep = 0; rep < NREP(pb); ++rep) pg8::gemm_phase<EpiS0, ORDER_T, true, true, pg8::NoSide, pg8::PreRstd<ORDER_T>>(F.lds, g, S, E, F.wave, pg8::NoSide(), PR);
            { pg8::SEpiScaleBf16 SE{BIG16, BCXLD, SSQ0, 0}; pg8::sgemm_phase(F.lds, g.A, g.lda, g.Bt, g.ldb, D, 3072, MP, MS, SE, F.wave, F.vcu, F.G); }
        } SEAM(pb);
        if (IN(pb + 1)) { for (int rep = 0; rep < NREP(pb + 1); ++rep) conv_phase(F, l); } SEAM(pb + 1);
        if (IN(pb + 2)) { PHASE_PTRS const int EPOCH = 2 * (pb + 2) + 1;
            pg8::Gemm g{ACT1, (const bf16*)(ws + WS_WOUT) + (size_t)l * D * WLD1, MP, D, D, A1LD, WLD1}; ORDER_T S; ORDER_INIT(MP, D, D, F.G, F.vcu, (float*)(ws + WS_SLAB + (size_t)(EPOCH & 1) * 64 * MiB), (unsigned*)F.ctl + CW_SLABF, (unsigned*)F.ctl + CW_TMO, (unsigned)(EPOCH));
            pg8::EpiRes E{l == 0 ? AIN(0) : nullptr, l == 0 ? AIN(1) : nullptr, XB, nullptr, SSQ1};
            pg8::gemm_phase<pg8::EpiRes, ORDER_T, true, true>(F.lds, g, S, E, F.wave);
            { pg8::SEpiRes SE{l == 0 ? AIN(1) - (size_t)MP * D : nullptr, XB, nullptr, SSQ1}; pg8::sgemm_phase(F.lds, g.A, g.lda, g.Bt, g.ldb, D, D, MP, MS, SE, F.wave, F.vcu, F.G); }
        } SEAM(pb + 2);
        if (IN(pb + 3)) { PHASE_PTRS const int EPOCH = 2 * (pb + 3) + 1;
            pg8::Gemm g{XB, (const bf16*)(ws + WS_WUP) + (size_t)l * FF * WLD1, MP, FF, D, XBLD, WLD1}; ORDER_T S; ORDER_INIT(MP, FF, D, F.G, F.vcu, (float*)(ws + WS_SLAB + (size_t)(EPOCH & 1) * 64 * MiB), (unsigned*)F.ctl + CW_SLABF, (unsigned*)F.ctl + CW_TMO, (unsigned)(EPOCH));
            pg8::PreRstd<ORDER_T> PR{(LAS float*)(F.lds + RING_BYTES), SSQ1, &S, F.wave}; EpiS1 E{BIG16, HLD, (const LAS float*)(F.lds + RING_BYTES)};
            for (int rep = 0; rep < NREP(pb + 3); ++rep) pg8::gemm_phase<EpiS1, ORDER_T, true, true, pg8::NoSide, pg8::PreRstd<ORDER_T>>(F.lds, g, S, E, F.wave, pg8::NoSide(), PR);
            { pg8::SEpiScaleBf16 SE{BIG16, HLD, SSQ1, 1}; for (int rep = 0; rep < NREP_S(pb + 3); ++rep) pg8::sgemm_phase(F.lds, g.A, g.lda, g.Bt, g.ldb, D, FF, MP, MS, SE, F.wave, F.vcu, F.G); }
        } SEAM(pb + 3);
        if (IN(pb + 4)) { PHASE_PTRS const int EPOCH = 2 * (pb + 4) + 1;
            pg8::Gemm g{BIG16, (const bf16*)(ws + WS_WDN) + (size_t)l * D * WLD4, MP, D, FF, HLD, WLD4}; ORDER_T S; ORDER_INIT(MP, D, FF, F.G, F.vcu, (float*)(ws + WS_SLAB + (size_t)(EPOCH & 1) * 64 * MiB), (unsigned*)F.ctl + CW_SLABF, (unsigned*)F.ctl + CW_TMO, (unsigned)(EPOCH));
            pg8::EpiRes E{nullptr, nullptr, XB, nullptr, SSQ0};
            pg8::gemm_phase<pg8::EpiRes, ORDER_T, true, true>(F.lds, g, S, E, F.wave);
            { pg8::SEpiRes SE{nullptr, XB, nullptr, SSQ0}; pg8::sgemm_phase(F.lds, g.A, g.lda, g.Bt, g.ldb, FF, D, MP, MS, SE, F.wave, F.vcu, F.G); }
        } SEAM(pb + 4);
    }
    if (IN(11)) { PHASE_PTRS
        const int sv = (int)blockIdx.x >= 128 ? (int)blockIdx.x - 128 : (1 << 28), sG = 128;
        { const int EPOCH = 23; pg8::Gemm g{XB, (const bf16*)(ws + WS_WKV), MP, 1536, D, XBLD, WLD1}; ORDER_T S; ORDER_INIT(MP, 1536, D, F.G, F.vcu, (float*)(ws + WS_SLAB + (size_t)(EPOCH & 1) * 64 * MiB), (unsigned*)F.ctl + CW_SLABF, (unsigned*)F.ctl + CW_TMO, (unsigned)(EPOCH));
          pg8::PreRstd<ORDER_T> PR{(LAS float*)(F.lds + RING_BYTES), SSQ0, &S, F.wave}; pg8::EpiScaleF32 E{(float*)(ws + WS_BIG), KVRLD, (const LAS float*)(F.lds + RING_BYTES)};
          pg8::gemm_phase<pg8::EpiScaleF32, ORDER_T, true, true, pg8::NoSide, pg8::PreRstd<ORDER_T>>(F.lds, g, S, E, F.wave, pg8::NoSide(), PR);
          pg8::SEpiScaleF32 SE{(float*)(ws + WS_BIG), KVRLD, SSQ0}; pg8::sgemm_phase(F.lds, g.A, g.lda, g.Bt, g.ldb, D, 1536, MP, MS, SE, F.wave, sv, sG); }
        { const int EPOCH = 24; pg8::Gemm g{XB, (const bf16*)(ws + WS_WQG), MP, D, D, XBLD, WLD1}; ORDER_T S; ORDER_INIT(MP, D, D, F.G, F.vcu, (float*)(ws + WS_SLAB + (size_t)(EPOCH & 1) * 64 * MiB), (unsigned*)F.ctl + CW_SLABF, (unsigned*)F.ctl + CW_TMO, (unsigned)(EPOCH));
          pg8::PreRstd<ORDER_T> PR{(LAS float*)(F.lds + RING_BYTES), SSQ0, &S, F.wave}; EpiS0 E{QGB, QGLD, (const LAS float*)(F.lds + RING_BYTES)};
          pg8::gemm_phase<EpiS0, ORDER_T, true, true, pg8::NoSide, pg8::PreRstd<ORDER_T>>(F.lds, g, S, E, F.wave, pg8::NoSide(), PR);
          pg8::SEpiScaleBf16 SE{QGB, QGLD, SSQ0, 0}; pg8::sgemm_phase(F.lds, g.A, g.lda, g.Bt, g.ldb, D, D, MP, MS, SE, F.wave, sv, sG);
          pg8::SEpiScaleBf16 SG{QGB + 1024, QGLD, SSQ0, 0}; pg8::sgemm_phase(F.lds, g.A, g.lda, g.Bt + (size_t)1024 * WLD1, g.ldb, D, 64, 0, M, SG, F.wave, sv, sG); }
    } SEAM(11);
    if (IN(12)) { for (int rep = 0; rep < NREP(12); ++rep) kvfin_phase(F); } SEAM(12);
    for (int j = 0; j < 2; ++j) {
        const int pb = 13 + 7 * j;
        if (j == 1) {
            if (IN(19)) { PHASE_PTRS const int EPOCH = 2 * (19) + 1; pg8::Gemm g{XB, (const bf16*)(ws + WS_WQG) + (size_t)NQG * WLD1, MP, D, D, XBLD, WLD1}; ORDER_T S; ORDER_INIT(MP, D, D, F.G, F.vcu, (float*)(ws + WS_SLAB + (size_t)(EPOCH & 1) * 64 * MiB), (unsigned*)F.ctl + CW_SLABF, (unsigned*)F.ctl + CW_TMO, (unsigned)(EPOCH));
                pg8::PreRstd<ORDER_T> PR{(LAS float*)(F.lds + RING_BYTES), SSQ0, &S, F.wave}; EpiS0 E{QGB, QGLD, (const LAS float*)(F.lds + RING_BYTES)};
                pg8::gemm_phase<EpiS0, ORDER_T, true, true, pg8::NoSide, pg8::PreRstd<ORDER_T>>(F.lds, g, S, E, F.wave, pg8::NoSide(), PR);
                pg8::SEpiScaleBf16 SE{QGB, QGLD, SSQ0, 0}; pg8::sgemm_phase(F.lds, g.A, g.lda, g.Bt, g.ldb, D, D, MP, MS, SE, F.wave, F.vcu, F.G);
          pg8::SEpiScaleBf16 SG{QGB + 1024, QGLD, SSQ0, 0}; pg8::sgemm_phase(F.lds, g.A, g.lda, g.Bt + (size_t)1024 * WLD1, g.ldb, D, 64, 0, M, SG, F.wave, F.vcu, F.G); }
            SEAM(19);
        }
        const int pa = pb;
        if (IN(pa)) {
#if defined(PROBE_A1)
            attn_tile_phase(F, j);
            { XcdBarrier b2_ = bar; asm volatile("" : "+s"(b2_.bar), "+s"(b2_.x)); xcd_barrier(b2_); }
            { const int t_ = (int)blockIdx.x * 512 + F.wave * 64 + lane_id(); if (t_ < 1024) ((unsigned*)F.ctl + CW_CNT + j * 1024 * CNT_PAD)[t_ * CNT_PAD] = 0u; }
            { XcdBarrier b2_ = bar; asm volatile("" : "+s"(b2_.bar), "+s"(b2_.x)); xcd_barrier(b2_); }
#endif
            attn_tile_phase(F, j); } SEAM(pa);
        if (IN(pa + 1)) {
#if defined(PROBE_A2)
#if PROBE_A2 == 2
            attn_sparse_phase(F, j);
#else
            attn_sample_part(F, j); attn_sparse_phase(F, j);
#endif
            { XcdBarrier b2_ = bar; asm volatile("" : "+s"(b2_.bar), "+s"(b2_.x)); xcd_barrier(b2_); }
            { const int t_ = F.wave * 64 + lane_id(); if (blockIdx.x == 0 && t_ < 8) ((unsigned*)F.ctl + CW_DQ)[64 * (8 * j + t_)] = 0u; if (t_ == 0) ((LAS unsigned*)(F.lds + LDSCTL_OFF + 128))[2 + j] = 0u; }
            { XcdBarrier b2_ = bar; asm volatile("" : "+s"(b2_.bar), "+s"(b2_.x)); xcd_barrier(b2_); }
#endif
            attn_sample_part(F, j); attn_sparse_phase(F, j); } SEAM(pa + 1);
        if (IN(pa + 2)) {
#if defined(PROBE_ATT) && PROBE_ATT == 2
            attn_combine_phase(F, j, true);
#endif
            attn_combine_phase(F, j); } SEAM(pa + 2);
        const int l = 2 + j;
        if (IN(pa + 3)) { PHASE_PTRS const int EPOCH = 2 * (pa + 3) + 1;
            pg8::Gemm g{ACT1, (const bf16*)(ws + WS_WO) + (size_t)j * D * WLD1, MP, D, D, A1LD, WLD1}; ORDER_T S; ORDER_INIT(MP, D, D, F.G, F.vcu, (float*)(ws + WS_SLAB + (size_t)(EPOCH & 1) * 64 * MiB), (unsigned*)F.ctl + CW_SLABF, (unsigned*)F.ctl + CW_TMO, (unsigned)(EPOCH));
            pg8::EpiRes E{nullptr, nullptr, XB, nullptr, SSQ1};
            pg8::gemm_phase<pg8::EpiRes, ORDER_T, true, true>(F.lds, g, S, E, F.wave);
            { pg8::SEpiRes SE{nullptr, XB, nullptr, SSQ1}; pg8::sgemm_phase(F.lds, g.A, g.lda, g.Bt, g.ldb, D, D, MP, MS, SE, F.wave, F.vcu, F.G); }
        } SEAM(pa + 3);
        if (IN(pa + 4)) { PHASE_PTRS const int EPOCH = 2 * (pa + 4) + 1;
            pg8::Gemm g{XB, (const bf16*)(ws + WS_WUP) + (size_t)l * FF * WLD1, MP, FF, D, XBLD, WLD1}; ORDER_T S; ORDER_INIT(MP, FF, D, F.G, F.vcu, (float*)(ws + WS_SLAB + (size_t)(EPOCH & 1) * 64 * MiB), (unsigned*)F.ctl + CW_SLABF, (unsigned*)F.ctl + CW_TMO, (unsigned)(EPOCH));
            pg8::PreRstd<ORDER_T> PR{(LAS float*)(F.lds + RING_BYTES), SSQ1, &S, F.wave}; EpiS1 E{BIG16, HLD, (const LAS float*)(F.lds + RING_BYTES)};
            pg8::gemm_phase<EpiS1, ORDER_T, true, true, pg8::NoSide, pg8::PreRstd<ORDER_T>>(F.lds, g, S, E, F.wave, pg8::NoSide(), PR);
            { pg8::SEpiScaleBf16 SE{BIG16, HLD, SSQ1, 1}; pg8::sgemm_phase(F.lds, g.A, g.lda, g.Bt, g.ldb, D, FF, MP, MS, SE, F.wave, F.vcu, F.G); }
        } SEAM(pa + 4);
        if (IN(pa + 5)) { PHASE_PTRS const int EPOCH = 2 * (pa + 5) + 1;
            pg8::Gemm g{BIG16, (const bf16*)(ws + WS_WDN) + (size_t)l * D * WLD4, MP, D, FF, HLD, WLD4}; ORDER_T S; ORDER_INIT(MP, D, FF, F.G, F.vcu, (float*)(ws + WS_SLAB + (size_t)(EPOCH & 1) * 64 * MiB), (unsigned*)F.ctl + CW_SLABF, (unsigned*)F.ctl + CW_TMO, (unsigned)(EPOCH));
            pg8::EpiRes E{nullptr, nullptr, XB, j == 1 ? Y : nullptr, SSQ0};
            pg8::gemm_phase<pg8::EpiRes, ORDER_T, true, true>(F.lds, g, S, E, F.wave);
            { pg8::SEpiRes SE{nullptr, XB, j == 1 ? Y : nullptr, SSQ0}; pg8::sgemm_phase(F.lds, g.A, g.lda, g.Bt, g.ldb, FF, D, MP, MS, SE, F.wave, F.vcu, F.G); }
        } SEAM(pa + 5);
    }
#if defined(PROBE_BARS)
    for (int pbi = 0; pbi < PROBE_BARS; ++pbi) { XcdBarrier b2_ = bar; asm volatile("" : "+s"(b2_.bar), "+s"(b2_.x)); xcd_barrier(b2_); }
#endif
#undef IN
#undef SEAM
}

extern "C" void kernel_launch(void* const* d_in, const int* in_sizes, int n_in, void* d_out, int out_size, void* d_ws, size_t ws_size, hipStream_t stream) {
    static int grid = 0;
    if (grid == 0) {
        if (n_in != 22 || out_size != (int)O_END || ws_size < WS_END) { fprintf(stderr, "kernel_launch: unexpected shapes (n_in %d, out %d, ws %zu)\n", n_in, out_size, ws_size); grid = -1; return; }
        int dev = 0, cus = 0, per_cu = 0;
        if (hipGetDevice(&dev) != hipSuccess || hipDeviceGetAttribute(&cus, hipDeviceAttributeMultiprocessorCount, dev) != hipSuccess) { grid = -1; return; }
        if (hipFuncSetAttribute((const void*)yoco_fwd, hipFuncAttributeMaxDynamicSharedMemorySize, LDS_BYTES) != hipSuccess) { fprintf(stderr, "kernel_launch: hipFuncSetAttribute failed\n"); grid = -1; return; }
        if (hipOccupancyMaxActiveBlocksPerMultiprocessor(&per_cu, (const void*)yoco_fwd, NWAVES * 64, LDS_BYTES) != hipSuccess || per_cu < 1) fprintf(stderr, "kernel_launch: occupancy query reports %d blocks per CU\n", per_cu);
        (void)hipGetLastError();
        if (cus < GRID) { fprintf(stderr, "kernel_launch: needs %d CUs, device has %d\n", GRID, cus); grid = -1; return; }
        grid = GRID;
    }
    if (grid < 0) return;
    (void)hipMemsetAsync((char*)d_ws + WS_CTL, 0, CTL_ZERO_BYTES, stream);
    Args a{};
    for (int i = 0; i < 22; ++i) a.in[i] = (const float*)d_in[i];
    a.page_table = (const int*)d_in[6];
    a.out = (float*)d_out; a.ws = (unsigned char*)d_ws;
#if MK_FUSED
    a.ph_lo = 0; a.ph_hi = NPHASE;
    hipLaunchKernelGGL(yoco_fwd, dim3(grid), dim3(NWAVES * 64), LDS_BYTES, stream, a);
#else
    for (int p = 0; p < NPHASE; ++p) { a.ph_lo = p; a.ph_hi = p + 1; hipLaunchKernelGGL(yoco_fwd, dim3(grid), dim3(NWAVES * 64), LDS_BYTES, stream, a); }
#endif
}
```
